# Optimizing an MI355X kernel written in HIP

```python
import jax, jax.numpy as jnp
from jax import lax
import numpy as np

D_MODEL = 2048
BATCH = 1
SEQ = 8192
DEPTH = 1

CHUNK = 64
N_META = 16

D_MIX = D_MODEL
D_POOL = D_MIX // 2
POOL_WINDOWS = (2, 4, 8, 16)
POOL_GROUP = D_POOL // len(POOL_WINDOWS)
D_SSM = D_MIX - D_POOL
SSM_HEAD_DIM = 64
SSM_HEADS = D_SSM // SSM_HEAD_DIM
SSM_GROUPS = 2
SSM_STATE = 128
CONV_WIDTH = 4
D_CONV = D_SSM + 2 * SSM_GROUPS * SSM_STATE
D_IN_PROJ = D_POOL + D_SSM + D_CONV + SSM_HEADS

N_EXPERTS = 32
TOP_K = 4
D_EXPERT = D_MODEL
SWIGLU_LIMIT = 7.0
SWIGLU_ALPHA = 1.702

NORM_EPS = 1e-5

kernel_name = "hymba_pool_ssd_moe_block"


def rms_norm(x, g):
    x32 = x.astype(jnp.float32)
    y = x32 * lax.rsqrt(jnp.mean(x32 * x32, axis=-1, keepdims=True) + NORM_EPS)
    return (y * g.astype(jnp.float32)).astype(x.dtype)


def multiscale_pool(u, pool_w, pool_scale):
    b, L, _ = u.shape
    u32 = u.astype(jnp.float32)
    cs = jnp.pad(jnp.cumsum(u32, axis=1), ((0, 0), (1, 0), (0, 0)))
    t = jnp.arange(L)
    diffs = []
    for g, w in enumerate(POOL_WINDOWS):
        sl = slice(g * POOL_GROUP, (g + 1) * POOL_GROUP)
        lo = jnp.maximum(t + 1 - w, 0)
        cnt = (t + 1 - lo).astype(jnp.float32)
        csg = cs[..., sl]
        mean = (csg[:, t + 1] - csg[:, lo]) / cnt[None, :, None]
        diffs.append(mean - u32[..., sl])
    d = jnp.stack(diffs, axis=2)
    y = jnp.einsum('blgc,gcd->blgd', d, pool_w.astype(jnp.float32))
    y = y.reshape(b, L, D_POOL) * pool_scale.astype(jnp.float32)
    return y.astype(u.dtype)


def causal_depthwise_conv(u, w, bias):
    C = u.shape[-1]
    out = lax.conv_general_dilated(
        u, w[:, None, :].astype(u.dtype), window_strides=(1,),
        padding=[(CONV_WIDTH - 1, 0)], dimension_numbers=('NWC', 'WIO', 'NWC'),
        feature_group_count=C)
    return out + bias.astype(u.dtype)


def ssd_chunked(xh, dt, A, Bh, Ch):
    b, L, H, P = xh.shape
    N = Bh.shape[-1]
    lead = (-N_META) % CHUNK
    tail = (-(lead + L)) % CHUNK
    pad4 = ((0, 0), (lead, tail), (0, 0), (0, 0))
    xh = jnp.pad(xh, pad4)
    Bh = jnp.pad(Bh, pad4)
    Ch = jnp.pad(Ch, pad4)
    dt = jnp.pad(dt, ((0, 0), (lead, tail), (0, 0)))
    Lp = L + lead + tail
    nc = Lp // CHUNK

    xdt = (xh * dt[..., None]).reshape(b, nc, CHUNK, H, P)
    Bc = Bh.reshape(b, nc, CHUNK, H, N)
    Cc = Ch.reshape(b, nc, CHUNK, H, N)
    dA = (dt * A).reshape(b, nc, CHUNK, H).transpose(0, 3, 1, 2)
    Acs = jnp.cumsum(dA, axis=-1)

    causal = jnp.tril(jnp.ones((CHUNK, CHUNK), dtype=bool))
    seg = Acs[..., :, None] - Acs[..., None, :]
    Lmat = jnp.exp(jnp.where(causal, seg, -jnp.inf))
    scores = jnp.einsum('bclhn,bcshn->bhcls', Cc, Bc) * Lmat
    y_diag = jnp.einsum('bhcls,bcshp->bclhp', scores, xdt)

    decay = jnp.exp(Acs[..., -1:] - Acs).transpose(0, 2, 3, 1)
    states = jnp.einsum('bclhn,bclhp->bchpn', Bc * decay[..., None], xdt)
    chunk_decay = jnp.exp(Acs[..., -1])

    def step(carry, inp):
        s_c, dec_c = inp
        return carry * dec_c[..., None, None] + s_c, carry

    init = jnp.zeros((b, H, P, N), dtype=xdt.dtype)
    _, prev = lax.scan(step, init, (states.transpose(1, 0, 2, 3, 4),
                                    chunk_decay.transpose(2, 0, 1)))
    prev = prev.transpose(1, 0, 2, 3, 4)

    in_decay = jnp.exp(Acs).transpose(0, 2, 3, 1)
    y_off = jnp.einsum('bclhn,bchpn->bclhp', Cc, prev) * in_decay[..., None]

    y = (y_diag + y_off).reshape(b, Lp, H, P)
    return y[:, lead:lead + L]


def mamba2_mixer(z, xbc, dt_raw, conv_w, conv_b, dt_bias, a_log, d_skip, norm_g):
    f32 = jnp.float32
    xbc = jax.nn.silu(causal_depthwise_conv(xbc, conv_w, conv_b))
    xs, Bm, Cm = jnp.split(xbc, [D_SSM, D_SSM + SSM_GROUPS * SSM_STATE], axis=-1)
    b, L, _ = xs.shape
    rep = SSM_HEADS // SSM_GROUPS
    dt = jax.nn.softplus(dt_raw.astype(f32) + dt_bias.astype(f32))
    A = -jnp.exp(a_log.astype(f32))
    xh = xs.astype(f32).reshape(b, L, SSM_HEADS, SSM_HEAD_DIM)
    Bh = jnp.repeat(Bm.astype(f32).reshape(b, L, SSM_GROUPS, SSM_STATE), rep, axis=2)
    Ch = jnp.repeat(Cm.astype(f32).reshape(b, L, SSM_GROUPS, SSM_STATE), rep, axis=2)
    y = ssd_chunked(xh, dt, A, Bh, Ch) + d_skip.astype(f32)[:, None] * xh
    y = y.reshape(b, L, D_SSM) * jax.nn.silu(z.astype(f32))
    yg = y.reshape(b, L, SSM_GROUPS, D_SSM // SSM_GROUPS)
    yg = yg * lax.rsqrt(jnp.mean(yg * yg, axis=-1, keepdims=True) + NORM_EPS)
    y = yg.reshape(b, L, D_SSM) * norm_g.astype(f32)
    return y.astype(z.dtype)


def moe_ffn(hn, router_w, router_b, w_gate, b_gate, w_up, b_up, w_down, b_down):
    b, S, D = hn.shape
    t = hn.reshape(-1, D)
    n = t.shape[0]
    logits = (t @ router_w + router_b).astype(jnp.float32)
    top_v, top_e = lax.top_k(logits, TOP_K)
    gates = jax.nn.softmax(top_v, axis=-1)
    flat_e = top_e.reshape(-1)
    order = jnp.argsort(flat_e)
    e_sorted = flat_e[order]
    tok = order // TOP_K
    xs = t[tok]
    sizes = jnp.bincount(flat_e, length=N_EXPERTS).astype(jnp.int32)
    g = lax.ragged_dot(xs, w_gate, sizes) + b_gate[e_sorted]
    u = lax.ragged_dot(xs, w_up, sizes) + b_up[e_sorted]
    g = jnp.minimum(g, SWIGLU_LIMIT)
    u = jnp.clip(u, -SWIGLU_LIMIT, SWIGLU_LIMIT)
    a = (u + 1.0) * (g * jax.nn.sigmoid(SWIGLU_ALPHA * g))
    o = lax.ragged_dot(a, w_down, sizes) + b_down[e_sorted]
    o = o * gates.reshape(-1)[order][:, None].astype(o.dtype)
    y = jnp.zeros((n, D), dtype=o.dtype).at[tok].add(o)
    return y.reshape(b, S, D).astype(hn.dtype)


def setup_inputs(seed: int = 0) -> dict:
    key = jax.random.key(seed)
    ks = jax.random.split(key, 24)
    f32 = jnp.float32

    def nrm(k, shape, scale):
        return jax.random.normal(k, shape, f32) * scale

    def gain(k, shape):
        return 1.0 + 0.02 * jax.random.normal(k, shape, f32)

    dt0 = jnp.exp(jax.random.uniform(ks[9], (DEPTH, SSM_HEADS), f32)
                  * (np.log(0.1) - np.log(0.001)) + np.log(0.001)).astype(f32)
    dt_bias = dt0 + jnp.log(-jnp.expm1(-dt0))
    a_log = jnp.log(jax.random.uniform(ks[10], (DEPTH, SSM_HEADS), f32, 1.0, 16.0))

    return {
        "x": nrm(ks[0], (BATCH, SEQ, D_MODEL), 1.0),
        "meta_tokens": nrm(ks[1], (N_META, D_MODEL), 1.0),
        "norm1_g": gain(ks[2], (DEPTH, D_MODEL)),
        "w_in": nrm(ks[3], (DEPTH, D_MODEL, D_IN_PROJ), D_MODEL ** -0.5),
        "pool_w": nrm(ks[4], (DEPTH, len(POOL_WINDOWS), POOL_GROUP, POOL_GROUP), POOL_GROUP ** -0.5),
        "pool_scale": gain(ks[5], (DEPTH, D_POOL)),
        "conv_w": nrm(ks[6], (DEPTH, CONV_WIDTH, D_CONV), CONV_WIDTH ** -0.5),
        "conv_b": nrm(ks[7], (DEPTH, D_CONV), 0.02),
        "dt_bias": dt_bias,
        "a_log": a_log,
        "d_skip": gain(ks[11], (DEPTH, SSM_HEADS)),
        "ssm_norm_g": gain(ks[12], (DEPTH, D_SSM)),
        "w_out": nrm(ks[13], (DEPTH, D_MIX, D_MODEL), D_MIX ** -0.5),
        "norm2_g": gain(ks[14], (DEPTH, D_MODEL)),
        "router_w": nrm(ks[15], (DEPTH, D_MODEL, N_EXPERTS), D_MODEL ** -0.5),
        "router_b": nrm(ks[16], (DEPTH, N_EXPERTS), 0.01),
        "w_gate": nrm(ks[17], (DEPTH, N_EXPERTS, D_MODEL, D_EXPERT), D_MODEL ** -0.5),
        "b_gate": nrm(ks[18], (DEPTH, N_EXPERTS, D_EXPERT), 0.02),
        "w_up": nrm(ks[19], (DEPTH, N_EXPERTS, D_MODEL, D_EXPERT), D_MODEL ** -0.5),
        "b_up": nrm(ks[20], (DEPTH, N_EXPERTS, D_EXPERT), 0.02),
        "w_down": nrm(ks[21], (DEPTH, N_EXPERTS, D_EXPERT, D_MODEL), D_EXPERT ** -0.5),
        "b_down": nrm(ks[22], (DEPTH, N_EXPERTS, D_MODEL), 0.02),
        "final_g": gain(ks[23], (D_MODEL,)),
    }


def reference(x, meta_tokens, norm1_g, w_in, pool_w, pool_scale, conv_w, conv_b,
              dt_bias, a_log, d_skip, ssm_norm_g, w_out, norm2_g, router_w, router_b,
              w_gate, b_gate, w_up, b_up, w_down, b_down, final_g):
    b = x.shape[0]
    meta = jnp.broadcast_to(meta_tokens[None].astype(x.dtype), (b, N_META, D_MODEL))
    h = jnp.concatenate([meta, x], axis=1)
    splits = [D_POOL, D_POOL + D_SSM, D_POOL + D_SSM + D_CONV]
    for i in range(DEPTH):
        hn = rms_norm(h, norm1_g[i])
        proj = hn @ w_in[i]
        u_pool, z, xbc, dt_raw = jnp.split(proj, splits, axis=-1)
        y_pool = multiscale_pool(u_pool, pool_w[i], pool_scale[i])
        y_ssm = mamba2_mixer(z, xbc, dt_raw, conv_w[i], conv_b[i], dt_bias[i],
                             a_log[i], d_skip[i], ssm_norm_g[i])
        h = h + jnp.concatenate([y_pool, y_ssm], axis=-1) @ w_out[i]
        if i == DEPTH - 1:
            h = h[:, N_META:]
        h = h + moe_ffn(rms_norm(h, norm2_g[i]), router_w[i], router_b[i], w_gate[i],
                        b_gate[i], w_up[i], b_up[i], w_down[i], b_down[i])
    return rms_norm(h, final_g)
```

```cpp
#include <hip/hip_runtime.h>
#include <cstdio>
#include <cstdint>
namespace pg8 {
#define PG8_LAS __attribute__((address_space(3)))
typedef unsigned short bf16_t;
typedef short bf16x8 __attribute__((ext_vector_type(8)));
typedef float f32x4 __attribute__((ext_vector_type(4)));
typedef unsigned u32x4 __attribute__((ext_vector_type(4)));
constexpr int BM = 256, BK = 64, HALF = 128, HTB = HALF * BK * 2  , STAGE_BYTES = 8 * HTB, NXCD = 8, WGM = 8;

__host__ __device__ __forceinline__ int lds_byte(int r, int c) { const int st = (r >> 4) * 2 + (c >> 5), rr = r & 15, cc = c & 31, ob = rr * 64 + cc * 2; return st * 1024 + (ob ^ (((ob >> 9) & 1) << 5)); }
__host__ __device__ __forceinline__ void stage_rc(int b, int& R, int& C) { const int st = b / 1024, sb = b % 1024, swz = sb ^ (((sb >> 9) & 1) << 5); R = (st >> 1) * 16 + swz / 64; C = (st & 1) * 32 + (swz % 64) / 2; }
__host__ __device__ __forceinline__ int perm32(int rho) { const int n = rho >> 4, i = rho & 15; return 8 * (i >> 2) + 4 * n + (i & 3); }

struct Unit { int pm, pn; };
struct Gemm { const bf16_t* A; const bf16_t* Bt; int M, N, K; };

struct StaticOrder {
    int nM, nN, nwg, G, c;
    __host__ __device__ void init(int M, int N, int G_, int c_) { nM = M / BM; nN = N / BM; nwg = nM * nN; G = G_; c = c_; }
    __host__ __device__ bool next(int i, Unit& u) const {
        const long L = (long)i * G + c; if (L >= nwg) return false;
        int wgid = (int)L; { const int q = nwg / NXCD, r = nwg % NXCD, xcd = wgid % NXCD, off = wgid / NXCD; wgid = (xcd < r ? xcd * (q + 1) : r * (q + 1) + (xcd - r) * q) + off; }
        const int nig = WGM * nN, gid = wgid / nig, fm = gid * WGM, gsz = (nM - fm) < WGM ? (nM - fm) : WGM;
        u.pm = fm + ((wgid % nig) % gsz); u.pn = (wgid % nig) / gsz; return true;
    }
    __device__ __forceinline__ void a_ready(const Unit&) const {}
    __device__ __forceinline__ void done(const Unit&) const {}
};

__device__ __forceinline__ unsigned cvt_pk_bf16(float lo, float hi) { unsigned r; asm volatile("v_cvt_pk_bf16_f32 %0, %1, %2" : "=v"(r) : "v"(lo), "v"(hi)); return r; }
template <class Epi, class Sched, bool ALIGN_EPI = false, bool SP2 = false>
__device__ __forceinline__ void gemm_phase(PG8_LAS unsigned char* lds, const Gemm g, const Sched& S, const Epi& E) {
    const int tid = threadIdx.x, wid = __builtin_amdgcn_readfirstlane(tid >> 6), lane = tid & 63, wr = wid >> 2, wc = wid & 3, fr = lane & 15, fq = lane >> 4;
    const int K = g.K, nt = K / BK;
    unsigned voffA[2], voffB[2];
#pragma unroll
    for (int i = 0; i < 2; ++i) { int R, C; stage_rc(tid * 16 + i * 8192, R, C); const int Rb = Epi::PERM ? ((R & ~31) + perm32(R & 31)) : R;
        voffA[i] = (unsigned)(R * K + C) * 2u; voffB[i] = (unsigned)(Rb * K + C) * 2u; }
    const size_t kstep = (size_t)(BK * 2);
    const size_t hstep = (size_t)HALF * K * 2;
    const size_t tstep = 2 * hstep;
    const unsigned ldsw = (unsigned)wid * 1024u;
    const int aoff = lds_byte(wr * 64 + fr, fq * 8), boff = lds_byte(wc * 32 + fr, fq * 8);
#define PG8_SA(b, h) (((b) * 2 + (h)) * HTB)
#define PG8_SB(b, h) ((4 + (b) * 2 + (h)) * HTB)
#define PG8_STAGE(bufoff, gbase, voff) do { _Pragma("unroll") for (int _i = 0; _i < 2; ++_i) \
        __builtin_amdgcn_global_load_lds((const unsigned*)((const char*)(gbase) + (voff)[_i]), (PG8_LAS unsigned*)(lds + (bufoff) + ldsw + _i * 8192), 16, 0, 0); } while (0)
#define PG8_LDA(dst, b, h) do { _Pragma("unroll") for (int m = 0; m < 4; ++m) _Pragma("unroll") for (int k = 0; k < 2; ++k) dst[m][k] = *(const PG8_LAS bf16x8*)(lds + PG8_SA(b, h) + aoff + m * 2048 + k * 1024); } while (0)
#define PG8_LDB(dst, b, h) do { _Pragma("unroll") for (int n = 0; n < 2; ++n) _Pragma("unroll") for (int k = 0; k < 2; ++k) dst[n][k] = *(const PG8_LAS bf16x8*)(lds + PG8_SB(b, h) + boff + n * 2048 + k * 1024); } while (0)
#define PG8_MMA(ai, bj, At, Bt) do { __builtin_amdgcn_s_setprio(1); _Pragma("unroll") for (int m = 0; m < 4; ++m) _Pragma("unroll") for (int n = 0; n < 2; ++n) _Pragma("unroll") for (int k = 0; k < 2; ++k) \
        acc[ai][bj][m][n] = __builtin_amdgcn_mfma_f32_16x16x32_bf16(Bt[n][k], At[m][k], acc[ai][bj][m][n], 0, 0, 0); __builtin_amdgcn_s_setprio(0); } while (0)
#define PG8_WAIT_V(n) asm volatile("s_waitcnt vmcnt(" #n ")" ::: "memory")
#define PG8_WAIT_L(n) asm volatile("s_waitcnt lgkmcnt(" #n ")" ::: "memory")
#define PG8_BAR __builtin_amdgcn_s_barrier()
#define PG8_SCHED __builtin_amdgcn_sched_barrier(0)
    Unit cur, nxt; int ui = 0;
    if (!S.next(0, cur)) return;
    f32x4 acc[2][2][4][2];
#pragma unroll
    for (int a = 0; a < 2; ++a)
#pragma unroll
        for (int b = 0; b < 2; ++b)
#pragma unroll
            for (int m = 0; m < 4; ++m)
#pragma unroll
                for (int n = 0; n < 2; ++n) acc[a][b][m][n] = (f32x4){0.f, 0.f, 0.f, 0.f};
    bf16x8 At[4][2], B0[2][2], B1[2][2];
    const char* cA = (const char*)g.A + (size_t)cur.pm * tstep; const char* cB = (const char*)g.Bt + (size_t)cur.pn * tstep;
    S.a_ready(cur);
    if constexpr (SP2) {
        PG8_STAGE(PG8_SB(0, 0), cB, voffB); PG8_STAGE(PG8_SB(0, 1), cB + hstep, voffB); PG8_STAGE(PG8_SA(0, 0), cA, voffA); PG8_STAGE(PG8_SA(0, 1), cA + hstep, voffA);
        if (wr == 1) PG8_BAR;
        PG8_WAIT_V(2); PG8_BAR;
        PG8_STAGE(PG8_SB(1, 0), cB + kstep, voffB); PG8_STAGE(PG8_SA(1, 0), cA + kstep, voffA); PG8_STAGE(PG8_SB(1, 1), cB + hstep + kstep, voffB);
        PG8_WAIT_V(6); PG8_BAR;
    } else {
        PG8_STAGE(PG8_SB(0, 0), cB, voffB); PG8_STAGE(PG8_SA(0, 0), cA, voffA); PG8_STAGE(PG8_SB(0, 1), cB + hstep, voffB); PG8_STAGE(PG8_SA(0, 1), cA + hstep, voffA);
        if (wr == 1) PG8_BAR;
        PG8_WAIT_V(4); PG8_BAR;
        PG8_STAGE(PG8_SB(1, 0), cB + kstep, voffB); PG8_STAGE(PG8_SA(1, 0), cA + kstep, voffA); PG8_STAGE(PG8_SB(1, 1), cB + hstep + kstep, voffB);
        PG8_WAIT_V(6); PG8_BAR;
    }
    for (;;) {
        const bool has_next = S.next(ui + 1, nxt);
        const char* nA = has_next ? (const char*)g.A + (size_t)nxt.pm * tstep : cA; const char* nB = has_next ? (const char*)g.Bt + (size_t)nxt.pn * tstep : cB;
        for (int t = 0; t < nt; t += 2) {
            const bool last = (t == nt - 2);
            const char* a1 = cA + (size_t)(t + 1) * kstep;
            const char* a2 = last ? nA : cA + (size_t)(t + 2) * kstep; const char* b2 = last ? nB : cB + (size_t)(t + 2) * kstep;
            const char* a3 = a2 + kstep; const char* b3 = b2 + kstep;
            if (last && has_next) S.a_ready(nxt);
            if constexpr (SP2) {
            PG8_LDB(B0, 0, 0); PG8_LDB(B1, 0, 1); PG8_SCHED; PG8_LDA(At, 0, 0); PG8_STAGE(PG8_SA(1, 1), a1 + hstep, voffA);
            PG8_WAIT_V(8); PG8_WAIT_L(0); PG8_BAR; PG8_MMA(0, 0, At, B0); PG8_MMA(0, 1, At, B1); PG8_BAR; PG8_SCHED;
            PG8_LDA(At, 0, 1); PG8_STAGE(PG8_SB(0, 0), b2, voffB); PG8_STAGE(PG8_SB(0, 1), b2 + hstep, voffB); PG8_STAGE(PG8_SA(0, 0), a2, voffA);
            PG8_WAIT_V(8); PG8_WAIT_L(0); PG8_BAR; PG8_MMA(1, 0, At, B0); PG8_MMA(1, 1, At, B1); PG8_BAR; PG8_SCHED;
            PG8_LDB(B0, 1, 0); PG8_LDB(B1, 1, 1); PG8_SCHED; PG8_LDA(At, 1, 0); PG8_STAGE(PG8_SA(0, 1), a2 + hstep, voffA);
            PG8_WAIT_V(8); PG8_WAIT_L(0); PG8_BAR; PG8_MMA(0, 0, At, B0); PG8_MMA(0, 1, At, B1); PG8_BAR; PG8_SCHED;
            PG8_LDA(At, 1, 1); PG8_STAGE(PG8_SB(1, 0), b3, voffB); PG8_STAGE(PG8_SB(1, 1), b3 + hstep, voffB); PG8_STAGE(PG8_SA(1, 0), a3, voffA);
            PG8_WAIT_V(8); PG8_WAIT_L(0); PG8_BAR; PG8_MMA(1, 0, At, B0); PG8_MMA(1, 1, At, B1); PG8_BAR; PG8_SCHED;
            } else {
            PG8_LDB(B0, 0, 0); PG8_SCHED; PG8_LDA(At, 0, 0); PG8_STAGE(PG8_SA(1, 1), a1 + hstep, voffA);
            PG8_WAIT_L(8); PG8_BAR; PG8_WAIT_L(0); PG8_MMA(0, 0, At, B0); PG8_BAR; PG8_SCHED;
            PG8_LDB(B1, 0, 1); PG8_STAGE(PG8_SB(0, 0), b2, voffB);
            PG8_BAR; PG8_WAIT_L(0); PG8_MMA(0, 1, At, B1); PG8_BAR;
            PG8_LDA(At, 0, 1); PG8_STAGE(PG8_SA(0, 0), a2, voffA);
            PG8_BAR; PG8_WAIT_L(0); PG8_MMA(1, 0, At, B0); PG8_BAR; PG8_SCHED;
            PG8_STAGE(PG8_SB(0, 1), b2 + hstep, voffB);
            PG8_WAIT_V(6); PG8_BAR; PG8_MMA(1, 1, At, B1); PG8_BAR;
            PG8_LDB(B0, 1, 0); PG8_SCHED; PG8_LDA(At, 1, 0); PG8_STAGE(PG8_SA(0, 1), a2 + hstep, voffA);
            PG8_WAIT_L(8); PG8_BAR; PG8_WAIT_L(0); PG8_MMA(0, 0, At, B0); PG8_BAR; PG8_SCHED;
            PG8_LDB(B1, 1, 1); PG8_STAGE(PG8_SB(1, 0), b3, voffB);
            PG8_BAR; PG8_WAIT_L(0); PG8_MMA(0, 1, At, B1); PG8_BAR;
            PG8_LDA(At, 1, 1); PG8_STAGE(PG8_SA(1, 0), a3, voffA);
            PG8_BAR; PG8_WAIT_L(0); PG8_MMA(1, 0, At, B0); PG8_BAR; PG8_SCHED;
            PG8_STAGE(PG8_SB(1, 1), b3 + hstep, voffB);
            PG8_WAIT_V(6); PG8_BAR; PG8_MMA(1, 1, At, B1); PG8_BAR;
            }
        }
        if constexpr (ALIGN_EPI) { if (wr == 0) PG8_BAR; }
        if constexpr (!Epi::AFTER_DRAIN) { E(acc, cur, wr, wc, fr, fq); S.done(cur); }
        if (!has_next) break;
#pragma unroll
        for (int a = 0; a < 2; ++a)
#pragma unroll
            for (int b = 0; b < 2; ++b)
#pragma unroll
                for (int m = 0; m < 4; ++m)
#pragma unroll
                    for (int n = 0; n < 2; ++n) acc[a][b][m][n] = (f32x4){0.f, 0.f, 0.f, 0.f};
        cur = nxt; cA = nA; cB = nB; ++ui;
        if constexpr (ALIGN_EPI) { if (wr == 1) PG8_BAR; }
    }
    PG8_WAIT_V(0);
    if constexpr (!ALIGN_EPI) { if (wr == 0) PG8_BAR; }
    PG8_BAR;
    if constexpr (Epi::AFTER_DRAIN) { E.fused(acc, cur, wr, wc, fr, fq, lds, wid, lane); S.done(cur); }
#undef PG8_SA
#undef PG8_SB
#undef PG8_STAGE
#undef PG8_LDA
#undef PG8_LDB
#undef PG8_MMA
#undef PG8_WAIT_V
#undef PG8_WAIT_L
#undef PG8_BAR
#undef PG8_SCHED
}
}
#define LAS __attribute__((address_space(3)))
#define XB_TMO      128
#define XB_XCNT(j)  (256  + 64 * (j))
#define XB_XSUB(j)  (1280 + 64 * (j))
#define XB_XGEN(j)  (2304 + 64 * (j))
#define XB_TOP      3328
#define XB_TOPGEN   3392
#define XCD_BAR_WORDS 3456
#define XB_SPIN_CAP (1u << 18)

__device__ __forceinline__ unsigned xb_ld(unsigned* p)              { return __hip_atomic_load(p, __ATOMIC_RELAXED, __HIP_MEMORY_SCOPE_AGENT); }
__device__ __forceinline__ unsigned xb_add(unsigned* p, unsigned v) { return __hip_atomic_fetch_add(p, v, __ATOMIC_RELAXED, __HIP_MEMORY_SCOPE_AGENT); }
__device__ __forceinline__ unsigned xb_xcc_id() { return (unsigned)__builtin_amdgcn_s_getreg((3 << 11) | 20) & 0xFu; }
#define XB_SPIN(cond, bar) do { unsigned _sp = 0; while (cond) { __builtin_amdgcn_s_sleep(1); \
    if ((++_sp & 255u) == 0u) { if (xb_ld(&(bar)[XB_TMO])) break; if (_sp > XB_SPIN_CAP) { atomicAdd(&(bar)[XB_TMO], 1u); break; } } } } while (0)

struct XcdBarrier {
    unsigned* bar; unsigned x;
    volatile LAS unsigned* st;
};

__device__ __forceinline__ XcdBarrier xcd_barrier_post(unsigned* bar, volatile LAS unsigned* st) {
    XcdBarrier b; b.bar = bar; b.x = xb_xcc_id(); b.st = st;
    if (threadIdx.x == 0) (void)xb_add(&bar[XB_XCNT(b.x)], 1u);
    return b;
}
__device__ __forceinline__ void xcd_barrier_complete(unsigned* bar, unsigned x, unsigned& nloc, unsigned& nx) {
    const unsigned G = gridDim.x * gridDim.y * gridDim.z;
    unsigned sum, cnt, mine, sp = 0u;
    for (;;) {
        sum = 0u; cnt = 0u; mine = 0u;
#pragma unroll
        for (unsigned j = 0; j < 16; ++j) { const unsigned c = xb_ld(&bar[XB_XCNT(j)]); sum += c; cnt += (c > 0u) ? 1u : 0u; mine = (j == x) ? c : mine; }
        if (sum == G) break;
        __builtin_amdgcn_s_sleep(1);
        if ((++sp & 255u) == 0u) { if (xb_ld(&bar[XB_TMO])) break; if (sp > XB_SPIN_CAP) { atomicAdd(&bar[XB_TMO], 1u); break; } }
    }
    nloc = mine > 0u ? mine : 1u; nx = cnt > 0u ? cnt : 1u;
}

__device__ __forceinline__ void xcd_barrier(const XcdBarrier& b) {
    asm volatile("s_waitcnt vmcnt(0)" ::: "memory");
    __syncthreads();
    if (threadIdx.x == 0) {
        unsigned* bar = b.bar;
        __builtin_amdgcn_s_waitcnt(0);
        unsigned nloc = b.st[0], nx = b.st[1];
        if (nloc == 0u) { xcd_barrier_complete(bar, b.x, nloc, nx); b.st[0] = nloc; b.st[1] = nx; }
        const unsigned old = xb_add(&bar[XB_XSUB(b.x)], 1u);
        const unsigned gen = old / nloc;
        if (old + 1u == (gen + 1u) * nloc) {
            __builtin_amdgcn_fence(__ATOMIC_RELEASE, "agent");
            asm volatile("s_waitcnt vmcnt(0)" ::: "memory");
            const unsigned og = xb_add(&bar[XB_TOP], 1u);
            const unsigned tg = og / nx;
            if (og + 1u == (tg + 1u) * nx) xb_add(&bar[XB_TOPGEN], 1u);
            else XB_SPIN(xb_ld(&bar[XB_TOPGEN]) == tg, bar);
            __builtin_amdgcn_fence(__ATOMIC_ACQUIRE, "agent");
            xb_add(&bar[XB_XGEN(b.x)], 1u);
            asm volatile("s_waitcnt vmcnt(0)" ::: "memory");
        } else {
            XB_SPIN(xb_ld(&bar[XB_XGEN(b.x)]) == gen, bar);
            __builtin_amdgcn_fence(__ATOMIC_ACQUIRE, "agent");
            asm volatile("s_waitcnt vmcnt(0)" ::: "memory");
        }
    }
    __syncthreads();
}
constexpr int D = 2048, SEQ = 8192, NMETA = 16, LEAD = 48, NP = 8256  , MP = 8448  ;
constexpr int NPROJ = 3840, C_Z = 1024, C_X = 2048, C_B = 3072, C_C = 3328, C_DT = 3584, NINPROJ = 3600;
constexpr int NE = 32, DCONV = 1536;
constexpr int RTILES = 160, RPAD = RTILES * 256;
constexpr float EPS = 1e-5f;
constexpr int NWAVES = 8, NPH = 12;
#ifndef MK_ONE_LAUNCH
#define MK_ONE_LAUNCH 1
#endif

constexpr size_t WS_CTL = 0, CTL_BYTES = 1u << 20;
constexpr size_t WS_HN = CTL_BYTES;
constexpr size_t WS_BT1 = WS_HN + (size_t)MP * D * 2;
constexpr size_t WS_BT2 = WS_BT1 + (size_t)NPROJ * D * 2;
constexpr size_t WS_PROJ = WS_BT2 + (size_t)D * D * 2;
constexpr size_t WS_XT = WS_PROJ + (size_t)MP * NPROJ * 2;
constexpr size_t WS_BTT = WS_XT + (size_t)1024 * NP * 2;
constexpr size_t WS_BC = WS_BTT + (size_t)256 * NP * 2;
constexpr size_t WS_CC = WS_BC + (size_t)NP * 256 * 2;
constexpr size_t WS_DT = WS_CC + (size_t)NP * 256 * 2;
constexpr size_t WS_ST = WS_DT + (size_t)NP * 16 * 4;
constexpr size_t WS_DEC = WS_ST + (size_t)128 * 131072 * 4;
constexpr size_t WS_PREV = WS_DEC + 128 * 16 * 4;
constexpr size_t WS_YCAT = WS_PREV + (size_t)128 * 131072 * 2;
constexpr size_t WS_H2 = WS_YCAT + (size_t)SEQ * D * 2;
constexpr size_t WS_HN2 = WS_H2 + (size_t)SEQ * D * 4;
constexpr size_t WS_WR = WS_HN2 + (size_t)SEQ * D * 2;
constexpr size_t WS_TKE = WS_WR + (size_t)D * NE * 4;
constexpr size_t WS_TKG = WS_TKE + (size_t)SEQ * 16;
constexpr size_t WS_POS = WS_TKG + (size_t)SEQ * 16;
constexpr size_t WS_CNT = WS_POS + (size_t)SEQ * 16;
constexpr size_t WS_TILE = WS_CNT + 256 * 32 * 4;
constexpr size_t WS_XS = WS_TILE + 1024;
constexpr size_t WS_A = WS_XS + (size_t)RPAD * D * 2;
constexpr size_t WS_BTGU = WS_A + (size_t)RPAD * D * 2;
constexpr size_t WS_BTD = WS_BTGU + (size_t)NE * 4096 * D * 2;
constexpr size_t WS_END = WS_BTD + (size_t)NE * D * D * 2;
constexpr int CW_BAR = 4096;
static_assert((CW_BAR + XCD_BAR_WORDS) * 4 <= (int)CTL_BYTES, "ctl");

constexpr int RING_BYTES = 131072, SCR_BYTES = 135168, MISC_OFF = SCR_BYTES, LDS_BYTES = 147456;

#define DI __device__ __forceinline__
typedef unsigned short bf16;
typedef unsigned v4u __attribute__((ext_vector_type(4)));
typedef unsigned v2u __attribute__((ext_vector_type(2)));
typedef float f32x4 __attribute__((ext_vector_type(4)));
typedef float f32x16 __attribute__((ext_vector_type(16)));
typedef short bf16x8 __attribute__((ext_vector_type(8)));
#define LDS_WAIT() asm volatile("s_waitcnt lgkmcnt(0)" ::: "memory")
#define MFMA32(a, b, c) __builtin_amdgcn_mfma_f32_32x32x16_bf16((a), (b), (c), 0, 0, 0)
DI float bf_lo(unsigned w) { return __uint_as_float(w << 16); }
DI float bf_hi(unsigned w) { return __uint_as_float(w & 0xffff0000u); }
DI float bf2f(bf16 v) { return __uint_as_float(((unsigned)v) << 16); }
DI unsigned pk2(float lo, float hi) { return pg8::cvt_pk_bf16(lo, hi); }
DI bf16 f2bf(float f) { return (bf16)(pk2(f, 0.f) & 0xffffu); }
DI float wave_sum(float v) {
#pragma unroll
    for (int o = 1; o < 64; o <<= 1) v += __shfl_xor(v, o);
    return v;
}
DI float wave_incl_scan(float v, int lane) {
#pragma unroll
    for (int o = 1; o < 64; o <<= 1) { const float t = __shfl_up(v, o); if (lane >= o) v += t; }
    return v;
}
DI float silu_f(float x) { return x * __builtin_amdgcn_rcpf(1.f + __expf(-x)); }

struct Frame {
    LAS unsigned char* lds;
    int tid, lane, wave, gw, ngw;
    const float *x, *meta, *g1, *w_in, *pool_w, *pool_scale, *conv_w, *conv_b, *dt_bias, *a_log, *d_skip, *ssm_g, *w_out, *g2, *router_w, *router_b,
        *w_gate, *b_gate, *w_up, *b_up, *w_down, *b_down, *final_g;
    float* out;
    bf16 *hn, *Bt1, *Bt2, *proj, *xT, *BT, *Bc, *Cc, *prev, *ycat, *hn2, *xs, *abuf, *obuf, *Btgu, *Btd;
    float *dtv, *states, *decay, *h2, *Wr, *tkg;
    int *tke, *pos, *cnt, *tile;
};

DI void p0_norm(Frame& F) {
    for (int P = F.gw; P < NP; P += F.ngw) {
        unsigned long long* o8 = (unsigned long long*)(F.hn + (size_t)P * D) + F.lane;
        if (P < LEAD) {
#pragma unroll
            for (int j = 0; j < 8; ++j) o8[64 * j] = 0ull;
            continue;
        }
        const int t = P - LEAD;
        const float* src = t < NMETA ? F.meta + (size_t)t * D : F.x + (size_t)(t - NMETA) * D;
        const f32x4* xr = (const f32x4*)src + F.lane; const f32x4* gr = (const f32x4*)F.g1 + F.lane;
        f32x4 v[8]; float s = 0.f;
#pragma unroll
        for (int j = 0; j < 8; ++j) { v[j] = xr[64 * j]; s += (v[j].x * v[j].x + v[j].y * v[j].y) + (v[j].z * v[j].z + v[j].w * v[j].w); }
        const float rstd = rsqrtf(wave_sum(s) * (1.f / D) + EPS);
#pragma unroll
        for (int j = 0; j < 8; ++j) { const f32x4 g = gr[64 * j];
            o8[64 * j] = (unsigned long long)pk2(v[j].x * rstd * g.x, v[j].y * rstd * g.y) | ((unsigned long long)pk2(v[j].z * rstd * g.z, v[j].w * rstd * g.w) << 32); }
    }
}
DI void tr_item(const float* W, size_t ldw, int nvalid, bf16* WT, size_t ldt, LAS float* scr, int lane) {
#pragma unroll 16
    for (int kk = 0; kk < 64; ++kk) scr[kk * 65 + lane] = (lane < nvalid) ? W[(size_t)kk * ldw + lane] : 0.f;
    LDS_WAIT();
    const int c = lane & 7;
#pragma unroll
    for (int j = 0; j < 8; ++j) { const int n = (lane >> 3) + 8 * j; const LAS float* s = scr + (8 * c) * 65 + n;
        v4u o; o.x = pk2(s[0], s[65]); o.y = pk2(s[130], s[195]); o.z = pk2(s[260], s[325]); o.w = pk2(s[390], s[455]);
        if (n < nvalid) *(v4u*)(WT + (size_t)n * ldt + 8 * c) = o; }
    LDS_WAIT();
}
DI void p0_weights(Frame& F) {
    LAS float* scr = (LAS float*)(F.lds + F.wave * 16640);
    constexpr int I_IN = 32 * 57, I_OUT = 16 * 32, I_MOE = NE * 3 * 32 * 32, NITEMS = I_IN + I_OUT + I_MOE;
    for (int it = F.gw; it < NITEMS; it += F.ngw) {
        int r = it;
        if (r < I_IN) { const int kb = r / 57, nb = r % 57; const int nv = (nb == 56) ? 16 : 64;
            tr_item(F.w_in + (size_t)(64 * kb) * NINPROJ + 64 * nb, NINPROJ, nv, F.Bt1 + (size_t)(64 * nb) * D + 64 * kb, D, scr, F.lane); continue; }
        r -= I_IN;
        if (r < I_OUT) { const int kb = r >> 5, nb = r & 31;
            tr_item(F.w_out + (size_t)(1024 + 64 * kb) * D + 64 * nb, D, 64, F.Bt2 + (size_t)(64 * nb) * D + 1024 + 64 * kb, D, scr, F.lane); continue; }
        r -= I_OUT;
        const int nb = r & 31, kb = (r >> 5) & 31, em = r >> 10, mat = em % 3, e = em / 3;
        if (mat == 2) {
            tr_item(F.w_down + (size_t)e * D * D + (size_t)(64 * kb) * D + 64 * nb, D, 64, F.Btd + ((size_t)e * D + 64 * nb) * D + 64 * kb, D, scr, F.lane);
        } else {
            const float* W = (mat == 0 ? F.w_gate : F.w_up) + (size_t)e * D * D + (size_t)(64 * kb) * D + 64 * nb;
            const int row = 256 * (nb >> 1) + 64 * (nb & 1) + 128 * mat;
            tr_item(W, D, 64, F.Btgu + ((size_t)e * 4096 + row) * D + 64 * kb, D, scr, F.lane);
        }
    }
}
DI void p0_weff(Frame& F) {
    for (int task = F.gw; task < 2048; task += F.ngw) {
        const int g = task >> 9, rem = task & 511, cb = rem >> 5, nb = rem & 31, n = 64 * nb + F.lane;
        float acc[16];
#pragma unroll
        for (int j = 0; j < 16; ++j) acc[j] = 0.f;
        const float* pw = F.pool_w + (size_t)(g * 256 + 16 * cb) * 256;
        const float* wo = F.w_out + (size_t)(256 * g) * D + n;
        const float* ps = F.pool_scale + 256 * g;
#pragma unroll 4
        for (int d = 0; d < 256; ++d) {
            const float wv = wo[(size_t)d * D] * ps[d];
#pragma unroll
            for (int j = 0; j < 16; ++j) acc[j] += pw[j * 256 + d] * wv;
        }
        v4u o0, o1;
        o0.x = pk2(acc[0], acc[1]); o0.y = pk2(acc[2], acc[3]); o0.z = pk2(acc[4], acc[5]); o0.w = pk2(acc[6], acc[7]);
        o1.x = pk2(acc[8], acc[9]); o1.y = pk2(acc[10], acc[11]); o1.z = pk2(acc[12], acc[13]); o1.w = pk2(acc[14], acc[15]);
        bf16* dst = F.Bt2 + (size_t)n * D + 256 * g + 16 * cb;
        *(v4u*)dst = o0; *(v4u*)(dst + 8) = o1;
    }
}
DI void p0_router_fold(Frame& F) {
    for (int i = blockIdx.x * 512 + F.tid; i < D * NE; i += gridDim.x * 512) F.Wr[i] = F.g2[i >> 5] * F.router_w[i];
}

DI void e_conv_tile(Frame& F, int c, int pcol, int cch, bf16* outT, bf16* outR, int rcol) {
    const int lane = F.lane, ch = cch + lane;
    const float w0 = F.conv_w[ch], w1 = F.conv_w[DCONV + ch], w2 = F.conv_w[2 * DCONV + ch], w3 = F.conv_w[3 * DCONV + ch], b = F.conv_b[ch];
    const bf16* src = F.proj + pcol + lane;
    const int P0 = 64 * c;
    float v[19];
#pragma unroll
    for (int i = 0; i < 3; ++i) v[i] = (P0 - 3 + i >= 0) ? bf2f(src[(size_t)(P0 - 3 + i) * NPROJ]) : 0.f;
#pragma unroll
    for (int sb = 0; sb < 4; ++sb) {
#pragma unroll
        for (int i = 0; i < 16; ++i) v[3 + i] = bf2f(src[(size_t)(P0 + 16 * sb + i) * NPROJ]);
        float o[16];
#pragma unroll
        for (int i = 0; i < 16; ++i) { const float a = b + w0 * v[i] + w1 * v[i + 1] + w2 * v[i + 2] + w3 * v[i + 3];
            o[i] = (P0 + 16 * sb + i >= LEAD) ? silu_f(a) : 0.f; }
        if (outT) { v4u q0, q1;
            q0.x = pk2(o[0], o[1]); q0.y = pk2(o[2], o[3]); q0.z = pk2(o[4], o[5]); q0.w = pk2(o[6], o[7]);
            q1.x = pk2(o[8], o[9]); q1.y = pk2(o[10], o[11]); q1.z = pk2(o[12], o[13]); q1.w = pk2(o[14], o[15]);
            bf16* dst = outT + (size_t)lane * NP + P0 + 16 * sb; *(v4u*)dst = q0; *(v4u*)(dst + 8) = q1; }
        if (outR) {
#pragma unroll
            for (int i = 0; i < 16; ++i) outR[(size_t)(P0 + 16 * sb + i) * 256 + rcol + lane] = f2bf(o[i]); }
        v[0] = v[16]; v[1] = v[17]; v[2] = v[18];
    }
}
template <int W> DI void e_pool_tile(Frame& F, int c, int colbase) {
    const int lane = F.lane; const bf16* src = F.proj + colbase + lane; const int P0 = 64 * c;
#pragma unroll
    for (int sb = 0; sb < 4; ++sb) {
        float v[16 + W - 1];
#pragma unroll
        for (int i = 0; i < 16 + W - 1; ++i) v[i] = bf2f(src[(size_t)(P0 + 16 * sb - (W - 1) + i) * NPROJ]);
#pragma unroll
        for (int i = 0; i < 16; ++i) { float s = 0.f;
#pragma unroll
            for (int j = 0; j < W; ++j) s += v[i + j];
            F.ycat[(size_t)(P0 - 64 + 16 * sb + i) * D + colbase + lane] = f2bf(s * (1.f / W) - v[i + W - 1]); }
    }
}
DI void e_dt_tile(Frame& F, int c) {
    const int P = 64 * c + F.lane;
    const v4u* src = (const v4u*)(F.proj + (size_t)P * NPROJ + C_DT);
    const v4u r0 = src[0], r1 = src[1];
    const unsigned w[8] = {r0.x, r0.y, r0.z, r0.w, r1.x, r1.y, r1.z, r1.w};
    float o[16];
#pragma unroll
    for (int i = 0; i < 8; ++i) { o[2 * i] = bf_lo(w[i]); o[2 * i + 1] = bf_hi(w[i]); }
#pragma unroll
    for (int h = 0; h < 16; ++h) { const float x = o[h] + F.dt_bias[h]; const float sp = fmaxf(x, 0.f) + log1pf(__expf(-fabsf(x))); o[h] = (P >= LEAD) ? sp : 0.f; }
    f32x4* dst = (f32x4*)(F.dtv + (size_t)P * 16);
#pragma unroll
    for (int q = 0; q < 4; ++q) dst[q] = (f32x4){o[4 * q], o[4 * q + 1], o[4 * q + 2], o[4 * q + 3]};
}
DI void p2_elem(Frame& F) {
    constexpr int NT = 129 * 41;
    for (int task = F.gw; task < NT; task += F.ngw) {
        const int c = task / 41, j = task % 41;
        if (j < 16) { if (c == 0) continue; const int g = j >> 2;
            if (g == 0) e_pool_tile<2>(F, c, 64 * j); else if (g == 1) e_pool_tile<4>(F, c, 64 * j); else if (g == 2) e_pool_tile<8>(F, c, 64 * j); else e_pool_tile<16>(F, c, 64 * j); }
        else if (j < 32) e_conv_tile(F, c, C_X + 64 * (j - 16), 64 * (j - 16), F.xT + (size_t)(64 * (j - 16)) * NP, nullptr, 0);
        else if (j < 36) e_conv_tile(F, c, C_B + 64 * (j - 32), 1024 + 64 * (j - 32), F.BT + (size_t)(64 * (j - 32)) * NP, F.Bc, 64 * (j - 32));
        else if (j < 40) e_conv_tile(F, c, C_C + 64 * (j - 36), 1280 + 64 * (j - 36), nullptr, F.Cc, 64 * (j - 36));
        else e_dt_tile(F, c);
    }
}

DI int crow16(int reg, int hf) { return (reg & 3) + 8 * (reg >> 2) + 4 * hf; }
DI void p3_states(Frame& F) {
    const int lane = F.lane, r = lane & 31, hf = lane >> 5;
    LAS float* wsm = (LAS float*)(F.lds + F.wave * 256);
    for (int u = blockIdx.x; u < 256; u += gridDim.x) {
        const int c = u >> 1, g = u & 1, h = 8 * g + F.wave;
        const float A = -__expf(F.a_log[h]);
        const float dtl = F.dtv[(size_t)(64 * c + lane) * 16 + h];
        const float acs = wave_incl_scan(dtl * A, lane);
        const float tot = __shfl(acs, 63);
        wsm[lane] = dtl * __expf(tot - acs);
        if (lane == 0) F.decay[c * 16 + h] = __expf(tot);
        LDS_WAIT();
        f32x16 acc[2][4];
#pragma unroll
        for (int mt = 0; mt < 2; ++mt)
#pragma unroll
            for (int nt = 0; nt < 4; ++nt)
#pragma unroll
                for (int i = 0; i < 16; ++i) acc[mt][nt][i] = 0.f;
#pragma unroll
        for (int ks = 0; ks < 4; ++ks) {
            const f32x4 wa = *(const LAS f32x4*)(wsm + 16 * ks + 8 * hf), wb = *(const LAS f32x4*)(wsm + 16 * ks + 8 * hf + 4);
            bf16x8 af[2], bfr[4];
#pragma unroll
            for (int mt = 0; mt < 2; ++mt) {
                const v4u raw = *(const v4u*)(F.xT + (size_t)(h * 64 + 32 * mt + r) * NP + 64 * c + 16 * ks + 8 * hf);
                v4u sc; sc.x = pk2(bf_lo(raw.x) * wa.x, bf_hi(raw.x) * wa.y); sc.y = pk2(bf_lo(raw.y) * wa.z, bf_hi(raw.y) * wa.w);
                sc.z = pk2(bf_lo(raw.z) * wb.x, bf_hi(raw.z) * wb.y); sc.w = pk2(bf_lo(raw.w) * wb.z, bf_hi(raw.w) * wb.w);
                af[mt] = __builtin_bit_cast(bf16x8, sc);
            }
#pragma unroll
            for (int nt = 0; nt < 4; ++nt) bfr[nt] = *(const bf16x8*)(F.BT + (size_t)(g * 128 + 32 * nt + r) * NP + 64 * c + 16 * ks + 8 * hf);
#pragma unroll
            for (int mt = 0; mt < 2; ++mt)
#pragma unroll
                for (int nt = 0; nt < 4; ++nt) acc[mt][nt] = MFMA32(af[mt], bfr[nt], acc[mt][nt]);
        }
        float* st = F.states + ((size_t)(c * 16 + h) * 64) * 128;
#pragma unroll
        for (int mt = 0; mt < 2; ++mt)
#pragma unroll
            for (int nt = 0; nt < 4; ++nt)
#pragma unroll
                for (int i = 0; i < 16; ++i) st[(32 * mt + crow16(i, hf)) * 128 + 32 * nt + r] = acc[mt][nt][i];
        LDS_WAIT();
    }
}
DI void p4_scan(Frame& F) {
    for (int e = blockIdx.x * 512 + F.tid; e < 131072; e += gridDim.x * 512) {
        const int h = e >> 13; float carry = 0.f;
        for (int c0 = 0; c0 < 128; c0 += 8) {
            float s[8], dc[8];
#pragma unroll
            for (int i = 0; i < 8; ++i) { s[i] = F.states[(size_t)(c0 + i) * 131072 + e]; dc[i] = F.decay[(c0 + i) * 16 + h]; }
#pragma unroll
            for (int i = 0; i < 8; ++i) { carry = carry * dc[i] + s[i]; F.prev[(size_t)(c0 + i) * 131072 + e] = f2bf(carry); }
        }
    }
}
DI bf16x8 pack8(const f32x16& x, int s) {
    v4u p; p.x = pk2(x[8 * s], x[8 * s + 1]); p.y = pk2(x[8 * s + 2], x[8 * s + 3]); p.z = pk2(x[8 * s + 4], x[8 * s + 5]); p.w = pk2(x[8 * s + 6], x[8 * s + 7]);
    return __builtin_bit_cast(bf16x8, p);
}
DI void p5_out(Frame& F) {
    const int lane = F.lane, r = lane & 31, hf = lane >> 5;
    LAS float* acs_s = (LAS float*)(F.lds + F.wave * 512);
    LAS float* dt_s = acs_s + 64;
    LAS float* red = (LAS float*)(F.lds + 8192);
    for (int u = blockIdx.x; u < 256; u += gridDim.x) {
        const int c = 1 + (u >> 1), g = u & 1, h = 8 * g + F.wave;
        const float A = -__expf(F.a_log[h]), Dh = F.d_skip[h];
        const float dtl = F.dtv[(size_t)(64 * c + lane) * 16 + h];
        const float acs = wave_incl_scan(dtl * A, lane);
        acs_s[lane] = acs; dt_s[lane] = dtl;
        float acs_l[2]; acs_l[0] = __shfl(acs, r); acs_l[1] = __shfl(acs, 32 + r);
        LDS_WAIT();
        f32x16 yT[2][2], sT[3];
#pragma unroll
        for (int i = 0; i < 16; ++i) { yT[0][0][i] = 0.f; yT[0][1][i] = 0.f; yT[1][0][i] = 0.f; yT[1][1][i] = 0.f; sT[0][i] = 0.f; sT[1][i] = 0.f; sT[2][i] = 0.f; }
        const bf16* prevp = F.prev + ((size_t)(c - 1) * 16 + h) * 8192;
#pragma unroll 2
        for (int ks = 0; ks < 8; ++ks) {
            bf16x8 cf[2], pf[2], bg[2];
#pragma unroll
            for (int t = 0; t < 2; ++t) {
                cf[t] = *(const bf16x8*)(F.Cc + (size_t)(64 * c + 32 * t + r) * 256 + g * 128 + 16 * ks + 8 * hf);
                bg[t] = *(const bf16x8*)(F.Bc + (size_t)(64 * c + 32 * t + r) * 256 + g * 128 + 16 * ks + 8 * hf);
                pf[t] = *(const bf16x8*)(prevp + (32 * t + r) * 128 + 16 * ks + 8 * hf);
            }
            yT[0][0] = MFMA32(pf[0], cf[0], yT[0][0]); yT[0][1] = MFMA32(pf[0], cf[1], yT[0][1]);
            yT[1][0] = MFMA32(pf[1], cf[0], yT[1][0]); yT[1][1] = MFMA32(pf[1], cf[1], yT[1][1]);
            sT[0] = MFMA32(bg[0], cf[0], sT[0]); sT[1] = MFMA32(bg[0], cf[1], sT[1]); sT[2] = MFMA32(bg[1], cf[1], sT[2]);
        }
        { const float e0 = __expf(acs_l[0]), e1 = __expf(acs_l[1]);
#pragma unroll
          for (int i = 0; i < 16; ++i) { yT[0][0][i] *= e0; yT[1][0][i] *= e0; yT[0][1][i] *= e1; yT[1][1][i] *= e1; } }
#pragma unroll
        for (int t = 0; t < 3; ++t) {
            const int st = (t == 2) ? 1 : 0, lt = (t == 0) ? 0 : 1;
            const int l = 32 * lt + r;
#pragma unroll
            for (int q = 0; q < 4; ++q) {
                const f32x4 a4 = *(const LAS f32x4*)(acs_s + 32 * st + 8 * q + 4 * hf), d4 = *(const LAS f32x4*)(dt_s + 32 * st + 8 * q + 4 * hf);
#pragma unroll
                for (int e = 0; e < 4; ++e) { const int s = 32 * st + 8 * q + 4 * hf + e;
                    float val = sT[t][4 * q + e] * __expf(acs_l[lt] - a4[e]) * d4[e];
                    val = (s <= l) ? val : 0.f; val = (s == l) ? val + Dh : val;
                    sT[t][4 * q + e] = val; }
            }
        }
#pragma unroll
        for (int st = 0; st < 2; ++st)
#pragma unroll
            for (int sp = 0; sp < 2; ++sp) {
                bf16x8 xa[2];
#pragma unroll
                for (int pt = 0; pt < 2; ++pt) { const bf16* xp = F.xT + (size_t)(h * 64 + 32 * pt + r) * NP + 64 * c + 32 * st + 16 * sp + 4 * hf;
                    const v2u lo = *(const v2u*)xp, hi = *(const v2u*)(xp + 8); v4u w; w.x = lo.x; w.y = lo.y; w.z = hi.x; w.w = hi.y; xa[pt] = __builtin_bit_cast(bf16x8, w); }
                if (st == 0) { const bf16x8 m0 = pack8(sT[0], sp), m1 = pack8(sT[1], sp);
                    yT[0][0] = MFMA32(xa[0], m0, yT[0][0]); yT[1][0] = MFMA32(xa[1], m0, yT[1][0]);
                    yT[0][1] = MFMA32(xa[0], m1, yT[0][1]); yT[1][1] = MFMA32(xa[1], m1, yT[1][1]);
                } else { const bf16x8 m2 = pack8(sT[2], sp);
                    yT[0][1] = MFMA32(xa[0], m2, yT[0][1]); yT[1][1] = MFMA32(xa[1], m2, yT[1][1]); }
            }
        float ss[2] = {0.f, 0.f};
#pragma unroll
        for (int pt = 0; pt < 2; ++pt)
#pragma unroll
            for (int lt = 0; lt < 2; ++lt) {
                const bf16* zp = F.proj + (size_t)(64 * c + 32 * lt + r) * NPROJ + C_Z + h * 64 + 32 * pt + 4 * hf;
#pragma unroll
                for (int q = 0; q < 4; ++q) { const v2u zw = *(const v2u*)(zp + 8 * q);
                    const float z0 = bf_lo(zw.x), z1 = bf_hi(zw.x), z2 = bf_lo(zw.y), z3 = bf_hi(zw.y);
                    float y0 = yT[pt][lt][4 * q] * silu_f(z0), y1 = yT[pt][lt][4 * q + 1] * silu_f(z1), y2 = yT[pt][lt][4 * q + 2] * silu_f(z2), y3 = yT[pt][lt][4 * q + 3] * silu_f(z3);
                    yT[pt][lt][4 * q] = y0; yT[pt][lt][4 * q + 1] = y1; yT[pt][lt][4 * q + 2] = y2; yT[pt][lt][4 * q + 3] = y3;
                    ss[lt] += (y0 * y0 + y1 * y1) + (y2 * y2 + y3 * y3); }
            }
        ss[0] += __shfl_xor(ss[0], 32); ss[1] += __shfl_xor(ss[1], 32);
        if (hf == 0) { red[F.wave * 64 + r] = ss[0]; red[F.wave * 64 + 32 + r] = ss[1]; }
        LDS_WAIT(); __syncthreads();
        float rstd[2];
#pragma unroll
        for (int lt = 0; lt < 2; ++lt) { float t = 0.f;
#pragma unroll
            for (int w = 0; w < 8; ++w) t += red[w * 64 + 32 * lt + r];
            rstd[lt] = rsqrtf(t * (1.f / 512.f) + EPS); }
#pragma unroll
        for (int pt = 0; pt < 2; ++pt)
#pragma unroll
            for (int lt = 0; lt < 2; ++lt) {
                bf16* op = F.ycat + (size_t)(64 * (c - 1) + 32 * lt + r) * D + 1024 + h * 64 + 32 * pt + 4 * hf;
                const float* gp = F.ssm_g + h * 64 + 32 * pt + 4 * hf;
#pragma unroll
                for (int q = 0; q < 4; ++q) { const f32x4 gg = *(const f32x4*)(gp + 8 * q); v2u w;
                    w.x = pk2(yT[pt][lt][4 * q] * rstd[lt] * gg.x, yT[pt][lt][4 * q + 1] * rstd[lt] * gg.y);
                    w.y = pk2(yT[pt][lt][4 * q + 2] * rstd[lt] * gg.z, yT[pt][lt][4 * q + 3] * rstd[lt] * gg.w);
                    *(v2u*)(op + 8 * q) = w; }
            }
        __syncthreads();
    }
}

DI void p7_router(Frame& F) {
    LAS float* rs = (LAS float*)F.lds;
    LAS float* part = rs + 64;
    LAS float* lg = part + 8 * 1024;
    LAS int* hist = (LAS int*)(lg + 32 * 33 + 8);
    const int lane = F.lane, wave = F.wave;
    for (int blk = blockIdx.x; blk < 256; blk += gridDim.x) {
        const int r0 = 32 * blk;
#pragma unroll 1
        for (int i = 0; i < 4; ++i) {
            const int rr = r0 + 4 * wave + i;
            const f32x4* xr = (const f32x4*)(F.h2 + (size_t)rr * D) + lane; const f32x4* gr = (const f32x4*)F.g2 + lane;
            unsigned long long* o8 = (unsigned long long*)(F.hn2 + (size_t)rr * D) + lane;
            f32x4 v[8]; float s = 0.f;
#pragma unroll
            for (int j = 0; j < 8; ++j) { v[j] = xr[64 * j]; s += (v[j].x * v[j].x + v[j].y * v[j].y) + (v[j].z * v[j].z + v[j].w * v[j].w); }
            const float rstd = rsqrtf(wave_sum(s) * (1.f / D) + EPS);
#pragma unroll
            for (int j = 0; j < 8; ++j) { const f32x4 g = gr[64 * j];
                o8[64 * j] = (unsigned long long)pk2(v[j].x * rstd * g.x, v[j].y * rstd * g.y) | ((unsigned long long)pk2(v[j].z * rstd * g.z, v[j].w * rstd * g.w) << 32); }
            if (lane == 0) rs[4 * wave + i] = rstd;
        }
        f32x16 acc;
#pragma unroll
        for (int i = 0; i < 16; ++i) acc[i] = 0.f;
        { const int ri = lane & 31, kh = lane >> 5;
          const float* arow = F.h2 + (size_t)(r0 + ri) * D + 256 * wave + 4 * kh;
          const float* wp = F.Wr + (size_t)(256 * wave + 4 * kh) * 32 + ri;
#pragma unroll 4
          for (int jj = 0; jj < 32; ++jj) {
              const f32x4 a = *(const f32x4*)(arow + 8 * jj);
              const float b0 = wp[(8 * jj) * 32], b1 = wp[(8 * jj + 1) * 32], b2 = wp[(8 * jj + 2) * 32], b3 = wp[(8 * jj + 3) * 32];
              acc = __builtin_amdgcn_mfma_f32_32x32x2f32(a.x, b0, acc, 0, 0, 0);
              acc = __builtin_amdgcn_mfma_f32_32x32x2f32(a.y, b1, acc, 0, 0, 0);
              acc = __builtin_amdgcn_mfma_f32_32x32x2f32(a.z, b2, acc, 0, 0, 0);
              acc = __builtin_amdgcn_mfma_f32_32x32x2f32(a.w, b3, acc, 0, 0, 0);
          }
#pragma unroll
          for (int i = 0; i < 16; ++i) part[wave * 1024 + crow16(i, kh) * 32 + ri] = acc[i];
        }
        if (F.tid < 32) hist[F.tid] = 0;
        LDS_WAIT(); __syncthreads();
        for (int idx = F.tid; idx < 1024; idx += 512) { float s = 0.f;
#pragma unroll
            for (int w = 0; w < 8; ++w) s += part[w * 1024 + idx];
            lg[(idx >> 5) * 33 + (idx & 31)] = s * rs[idx >> 5] + F.router_b[idx & 31]; }
        LDS_WAIT(); __syncthreads();
        if (F.tid < 32) {
            const int i = F.tid; float tv[4]; int te[4];
#pragma unroll
            for (int k = 0; k < 4; ++k) { float best = -3.0e38f; int be = 0;
                for (int e = 0; e < 32; ++e) { const float x = lg[i * 33 + e]; if (x > best) { best = x; be = e; } }
                tv[k] = best; te[k] = be; lg[i * 33 + be] = -3.4e38f; }
            const float e1 = __expf(tv[1] - tv[0]), e2 = __expf(tv[2] - tv[0]), e3 = __expf(tv[3] - tv[0]);
            const float inv = 1.f / (1.f + e1 + e2 + e3);
            *(f32x4*)(F.tkg + (size_t)(r0 + i) * 4) = (f32x4){inv, e1 * inv, e2 * inv, e3 * inv};
            int* tk = F.tke + (size_t)(r0 + i) * 4; tk[0] = te[0]; tk[1] = te[1]; tk[2] = te[2]; tk[3] = te[3];
#pragma unroll
            for (int k = 0; k < 4; ++k) __hip_atomic_fetch_add(hist + te[k], 1, __ATOMIC_RELAXED, __HIP_MEMORY_SCOPE_WORKGROUP);
        }
        LDS_WAIT(); __syncthreads();
        if (F.tid < 32) F.cnt[blk * 32 + F.tid] = hist[F.tid];
        __syncthreads();
    }
}
DI void p8_route(Frame& F) {
    LAS int* tot = (LAS int*)F.lds; LAS int* pre = tot + 32; LAS int* base = tot + 64; LAS int* run = tot + 96; LAS int* posl = tot + 128;
    for (int blk = blockIdx.x; blk < 256; blk += gridDim.x) {
        const int r0 = 32 * blk;
        if (F.tid < 32) { const int e = F.tid; int t = 0, p = 0;
            for (int w = 0; w < 256; ++w) { const int v = F.cnt[w * 32 + e]; p += (w < blk) ? v : 0; t += v; }
            tot[e] = t; pre[e] = p; run[e] = 0; }
        LDS_WAIT(); __syncthreads();
        if (F.tid == 0) {
            int accp = 0, nt = 0;
            for (int e = 0; e < 32; ++e) { base[e] = accp; const int tiles = (tot[e] + 255) >> 8;
                if (blk == 0) for (int j = 0; j < tiles; ++j) F.tile[nt + j] = e;
                nt += tiles; accp += tiles * 256; }
            if (blk == 0) F.tile[255] = nt;
            for (int j = 0; j < 128; ++j) { const int e = F.tke[(size_t)r0 * 4 + j]; const int q = run[e]; run[e] = q + 1; const int p = base[e] + pre[e] + q; posl[j] = p; F.pos[(size_t)r0 * 4 + j] = p; }
        }
        LDS_WAIT(); __syncthreads();
        for (int j = F.wave; j < 128; j += 8) {
            const v4u* src = (const v4u*)(F.hn2 + (size_t)(r0 + (j >> 2)) * D) + F.lane; v4u* dst = (v4u*)(F.xs + (size_t)posl[j] * D) + F.lane;
            const v4u a = src[0], b = src[64], c = src[128], d = src[192];
            dst[0] = a; dst[64] = b; dst[128] = c; dst[192] = d;
        }
        __syncthreads();
    }
}
DI void p11_final(Frame& F) {
    const int lane = F.lane;
    for (int rr = F.gw; rr < SEQ; rr += F.ngw) {
        const int* pp = F.pos + (size_t)rr * 4; const f32x4 gt = *(const f32x4*)(F.tkg + (size_t)rr * 4);
        const float gk[4] = {gt.x, gt.y, gt.z, gt.w};
        const f32x4* xr = (const f32x4*)(F.h2 + (size_t)rr * D) + lane;
        f32x4 v[8];
#pragma unroll
        for (int j = 0; j < 8; ++j) v[j] = xr[64 * j];
#pragma unroll
        for (int k = 0; k < 4; ++k) { const v2u* orow = (const v2u*)(F.obuf + (size_t)pp[k] * D) + lane;
#pragma unroll
            for (int j = 0; j < 8; ++j) { const v2u w = orow[64 * j]; v[j].x += gk[k] * bf_lo(w.x); v[j].y += gk[k] * bf_hi(w.x); v[j].z += gk[k] * bf_lo(w.y); v[j].w += gk[k] * bf_hi(w.y); } }
        float s = 0.f;
#pragma unroll
        for (int j = 0; j < 8; ++j) s += (v[j].x * v[j].x + v[j].y * v[j].y) + (v[j].z * v[j].z + v[j].w * v[j].w);
        const float rstd = rsqrtf(wave_sum(s) * (1.f / D) + EPS);
        const f32x4* gr = (const f32x4*)F.final_g + lane; f32x4* op = (f32x4*)(F.out + (size_t)rr * D) + lane;
#pragma unroll
        for (int j = 0; j < 8; ++j) { const f32x4 g = gr[64 * j]; op[64 * j] = (f32x4){v[j].x * rstd * g.x, v[j].y * rstd * g.y, v[j].z * rstd * g.z, v[j].w * rstd * g.w}; }
    }
}

using pg8::Unit; using pg8::HALF; using pg8::BM;
struct EpiProj {
    static constexpr bool PERM = true, AFTER_DRAIN = false;
    bf16* O;
    DI void operator()(const f32x4 (&acc)[2][2][4][2], const Unit& u, int wr, int wc, int fr, int fq) const {
        const int row0 = u.pm * BM + wr * 64 + fr, col0 = u.pn * BM + wc * 32 + 8 * fq;
#pragma unroll
        for (int ai = 0; ai < 2; ++ai)
#pragma unroll
            for (int m = 0; m < 4; ++m) { bf16* rowp = O + (size_t)(row0 + ai * HALF + m * 16) * NPROJ + col0;
#pragma unroll
                for (int bj = 0; bj < 2; ++bj) { const f32x4 v0 = acc[ai][bj][m][0], v1 = acc[ai][bj][m][1];
                    v4u w; w.x = pk2(v0[0], v0[1]); w.y = pk2(v0[2], v0[3]); w.z = pk2(v1[0], v1[1]); w.w = pk2(v1[2], v1[3]);
                    *(v4u*)(rowp + bj * HALF) = w; } }
    }
};
struct EpiH2 {
    static constexpr bool PERM = false, AFTER_DRAIN = false;
    const float* X; float* H;
    DI void operator()(const f32x4 (&acc)[2][2][4][2], const Unit& u, int wr, int wc, int fr, int fq) const {
        const int row0 = u.pm * BM + wr * 64 + fr, col0 = u.pn * BM + wc * 32 + 4 * fq;
#pragma unroll
        for (int ai = 0; ai < 2; ++ai)
#pragma unroll
            for (int m = 0; m < 4; ++m) { const size_t off = (size_t)(row0 + ai * HALF + m * 16) * D + col0;
#pragma unroll
                for (int bj = 0; bj < 2; ++bj)
#pragma unroll
                    for (int n = 0; n < 2; ++n) { const f32x4 xv = *(const f32x4*)(X + off + bj * HALF + n * 16); *(f32x4*)(H + off + bj * HALF + n * 16) = xv + acc[ai][bj][m][n]; } }
    }
};
DI float swiglu(float g, float u) {
    g = fminf(g, 7.f); u = fminf(fmaxf(u, -7.f), 7.f);
    return (u + 1.f) * g * __builtin_amdgcn_rcpf(1.f + __expf(-1.702f * g));
}
struct EpiGU {
    static constexpr bool PERM = true, AFTER_DRAIN = false;
    bf16* O; const float* bgate; const float* bup;
    DI void operator()(const f32x4 (&acc)[2][2][4][2], const Unit& u, int wr, int wc, int fr, int fq) const {
        const int e = u.pn >> 4, pnl = u.pn & 15;
        const int row0 = u.pm * BM + wr * 64 + fr, colb = 128 * pnl + wc * 32 + 8 * fq;
        f32x4 bg[2], bu[2];
#pragma unroll
        for (int n = 0; n < 2; ++n) { bg[n] = *(const f32x4*)(bgate + e * D + colb + 4 * n); bu[n] = *(const f32x4*)(bup + e * D + colb + 4 * n); }
#pragma unroll
        for (int ai = 0; ai < 2; ++ai)
#pragma unroll
            for (int m = 0; m < 4; ++m) { bf16* rowp = O + (size_t)(row0 + ai * HALF + m * 16) * D + colb;
                const f32x4 g0 = acc[ai][0][m][0] + bg[0], g1 = acc[ai][0][m][1] + bg[1], u0 = acc[ai][1][m][0] + bu[0], u1 = acc[ai][1][m][1] + bu[1];
                v4u w; w.x = pk2(swiglu(g0[0], u0[0]), swiglu(g0[1], u0[1])); w.y = pk2(swiglu(g0[2], u0[2]), swiglu(g0[3], u0[3]));
                w.z = pk2(swiglu(g1[0], u1[0]), swiglu(g1[1], u1[1])); w.w = pk2(swiglu(g1[2], u1[2]), swiglu(g1[3], u1[3]));
                *(v4u*)rowp = w; }
    }
};
struct EpiDown {
    static constexpr bool PERM = true, AFTER_DRAIN = false;
    bf16* O; const float* bias;
    DI void operator()(const f32x4 (&acc)[2][2][4][2], const Unit& u, int wr, int wc, int fr, int fq) const {
        const int e = u.pn >> 3, pnl = u.pn & 7;
        const int row0 = u.pm * BM + wr * 64 + fr, col0 = 256 * pnl + wc * 32 + 8 * fq;
        f32x4 bv[2][2];
#pragma unroll
        for (int bj = 0; bj < 2; ++bj)
#pragma unroll
            for (int n = 0; n < 2; ++n) bv[bj][n] = *(const f32x4*)(bias + e * D + col0 + bj * HALF + 4 * n);
#pragma unroll
        for (int ai = 0; ai < 2; ++ai)
#pragma unroll
            for (int m = 0; m < 4; ++m) { bf16* rowp = O + (size_t)(row0 + ai * HALF + m * 16) * D + col0;
#pragma unroll
                for (int bj = 0; bj < 2; ++bj) { const f32x4 v0 = acc[ai][bj][m][0] + bv[bj][0], v1 = acc[ai][bj][m][1] + bv[bj][1];
                    v4u w; w.x = pk2(v0[0], v0[1]); w.y = pk2(v0[2], v0[3]); w.z = pk2(v1[0], v1[1]); w.w = pk2(v1[2], v1[3]);
                    *(v4u*)(rowp + bj * HALF) = w; } }
    }
};
struct MoeOrder {
    const int* tile_e; int nM, nN, nwg, G, c;
    DI void init(const int* te, int ntiles, int nN_, int G_, int c_) { tile_e = te; nM = ntiles; nN = nN_; nwg = nM * nN; G = G_; c = c_; }
    DI bool next(int i, Unit& u) const {
        const long L = (long)i * G + c; if (L >= nwg) return false;
        int wgid = (int)L; { const int q = nwg / pg8::NXCD, r = nwg % pg8::NXCD, xcd = wgid % pg8::NXCD, off = wgid / pg8::NXCD; wgid = (xcd < r ? xcd * (q + 1) : r * (q + 1) + (xcd - r) * q) + off; }
        const int nig = pg8::WGM * nN, gid = wgid / nig, fm = gid * pg8::WGM, gsz = (nM - fm) < pg8::WGM ? (nM - fm) : pg8::WGM;
        u.pm = fm + ((wgid % nig) % gsz); const int pnl = (wgid % nig) / gsz;
        u.pn = __builtin_amdgcn_readfirstlane(tile_e[u.pm]) * nN + pnl; return true;
    }
    DI void a_ready(const Unit&) const {}
    DI void done(const Unit&) const {}
};

struct Args { const float* in[23]; float* out; unsigned char* ws; int ph_lo, ph_hi; };
__global__ void __launch_bounds__(NWAVES * 64, 2) fwd(Args args) {
    extern __shared__ __attribute__((aligned(16))) unsigned char lds_raw[];
    Frame F;
    F.lds = (LAS unsigned char*)lds_raw;
    F.tid = threadIdx.x; F.lane = F.tid & 63; F.wave = __builtin_amdgcn_readfirstlane(F.tid >> 6);
    F.gw = blockIdx.x * NWAVES + F.wave; F.ngw = gridDim.x * NWAVES;
    unsigned char* ws = args.ws;
    F.x = args.in[0]; F.meta = args.in[1]; F.g1 = args.in[2]; F.w_in = args.in[3]; F.pool_w = args.in[4]; F.pool_scale = args.in[5]; F.conv_w = args.in[6]; F.conv_b = args.in[7];
    F.dt_bias = args.in[8]; F.a_log = args.in[9]; F.d_skip = args.in[10]; F.ssm_g = args.in[11]; F.w_out = args.in[12]; F.g2 = args.in[13]; F.router_w = args.in[14]; F.router_b = args.in[15];
    F.w_gate = args.in[16]; F.b_gate = args.in[17]; F.w_up = args.in[18]; F.b_up = args.in[19]; F.w_down = args.in[20]; F.b_down = args.in[21]; F.final_g = args.in[22];
    F.out = args.out;
    F.hn = (bf16*)(ws + WS_HN); F.Bt1 = (bf16*)(ws + WS_BT1); F.Bt2 = (bf16*)(ws + WS_BT2); F.proj = (bf16*)(ws + WS_PROJ); F.xT = (bf16*)(ws + WS_XT); F.BT = (bf16*)(ws + WS_BTT);
    F.Bc = (bf16*)(ws + WS_BC); F.Cc = (bf16*)(ws + WS_CC); F.prev = (bf16*)(ws + WS_PREV); F.ycat = (bf16*)(ws + WS_YCAT); F.hn2 = (bf16*)(ws + WS_HN2); F.xs = (bf16*)(ws + WS_XS);
    F.abuf = (bf16*)(ws + WS_A); F.obuf = (bf16*)(ws + WS_XS); F.Btgu = (bf16*)(ws + WS_BTGU); F.Btd = (bf16*)(ws + WS_BTD);
    F.dtv = (float*)(ws + WS_DT); F.states = (float*)(ws + WS_ST); F.decay = (float*)(ws + WS_DEC); F.h2 = (float*)(ws + WS_H2); F.Wr = (float*)(ws + WS_WR); F.tkg = (float*)(ws + WS_TKG);
    F.tke = (int*)(ws + WS_TKE); F.pos = (int*)(ws + WS_POS); F.cnt = (int*)(ws + WS_CNT); F.tile = (int*)(ws + WS_TILE);

    volatile LAS unsigned* MISC = (volatile LAS unsigned*)(F.lds + MISC_OFF);
    if (F.tid < 32) MISC[F.tid] = 0u;
    __syncthreads();
    const int lo = args.ph_lo, hi = args.ph_hi;
    XcdBarrier bar; bar.bar = (unsigned*)(ws + WS_CTL) + CW_BAR; bar.x = 0; bar.st = nullptr;
    if (hi - lo > 1) bar = xcd_barrier_post((unsigned*)(ws + WS_CTL) + CW_BAR, MISC + 8);
#define IN(k) (lo <= (k) && (k) < hi)
#define SEAM(k) do { if (IN(k) && IN((k) + 1)) xcd_barrier(bar); } while (0)

    if (IN(0)) { p0_norm(F); p0_weff(F); p0_router_fold(F); p0_weights(F); __syncthreads(); }
    SEAM(0);
    if (IN(1)) { pg8::Gemm g{F.hn, F.Bt1, MP, NPROJ, D}; pg8::StaticOrder S; S.init(MP, NPROJ, (int)gridDim.x, (int)blockIdx.x);
        EpiProj E{F.proj}; pg8::gemm_phase<EpiProj, pg8::StaticOrder, true, true>(F.lds, g, S, E); }
    SEAM(1);
    if (IN(2)) { p2_elem(F); }
    SEAM(2);
    if (IN(3)) { p3_states(F); }
    SEAM(3);
    if (IN(4)) { p4_scan(F); }
    SEAM(4);
    if (IN(5)) { p5_out(F); }
    SEAM(5);
    if (IN(6)) { pg8::Gemm g{F.ycat, F.Bt2, SEQ, D, D}; pg8::StaticOrder S; S.init(SEQ, D, (int)gridDim.x, (int)blockIdx.x);
        EpiH2 E{F.x, F.h2}; pg8::gemm_phase<EpiH2, pg8::StaticOrder, true, true>(F.lds, g, S, E); }
    SEAM(6);
    if (IN(7)) { p7_router(F); }
    SEAM(7);
    if (IN(8)) { p8_route(F); }
    SEAM(8);
    if (IN(9)) { const int ntiles = __builtin_amdgcn_readfirstlane(F.tile[255]);
        pg8::Gemm g{F.xs, F.Btgu, RPAD, NE * 4096, D}; MoeOrder S; S.init(F.tile, ntiles, 16, (int)gridDim.x, (int)blockIdx.x);
        EpiGU E{F.abuf, F.b_gate, F.b_up}; pg8::gemm_phase<EpiGU, MoeOrder, true, true>(F.lds, g, S, E); }
    SEAM(9);
    if (IN(10)) { const int ntiles = __builtin_amdgcn_readfirstlane(F.tile[255]);
        pg8::Gemm g{F.abuf, F.Btd, RPAD, NE * D, D}; MoeOrder S; S.init(F.tile, ntiles, 8, (int)gridDim.x, (int)blockIdx.x);
        EpiDown E{F.obuf, F.b_down}; pg8::gemm_phase<EpiDown, MoeOrder, true, true>(F.lds, g, S, E); }
    SEAM(10);
    if (IN(11)) { p11_final(F); }
#undef IN
#undef SEAM
}

extern "C" void kernel_launch(void* const* d_in, const int* in_sizes, int n_in, void* d_out, int out_size, void* d_ws, size_t ws_size, hipStream_t stream) {
    static int grid = 0;
    if (grid == 0) {
        if (n_in != 23 || out_size != SEQ * D || ws_size < WS_END) { fprintf(stderr, "kernel_launch: unexpected shapes (n_in %d out %d ws %zu need %zu)\n", n_in, out_size, ws_size, (size_t)WS_END); grid = -1; return; }
        int dev = 0, cus = 0, per_cu = 0;
        if (hipGetDevice(&dev) != hipSuccess || hipDeviceGetAttribute(&cus, hipDeviceAttributeMultiprocessorCount, dev) != hipSuccess) { grid = -1; return; }
        if (hipFuncSetAttribute((const void*)fwd, hipFuncAttributeMaxDynamicSharedMemorySize, LDS_BYTES) != hipSuccess) { fprintf(stderr, "kernel_launch: hipFuncSetAttribute failed\n"); grid = -1; return; }
        if (hipOccupancyMaxActiveBlocksPerMultiprocessor(&per_cu, (const void*)fwd, NWAVES * 64, LDS_BYTES) != hipSuccess || per_cu < 1) fprintf(stderr, "kernel_launch: occupancy query says %d\n", per_cu);
        (void)hipGetLastError();
        grid = cus > 256 ? 256 : cus;
    }
    if (grid < 0) return;
    Args a{};
    for (int i = 0; i < 23; ++i) a.in[i] = (const float*)d_in[i];
    a.out = (float*)d_out; a.ws = (unsigned char*)d_ws;
#if MK_ONE_LAUNCH
    hipMemsetAsync((char*)d_ws + WS_CTL, 0, CTL_BYTES, stream);
    a.ph_lo = 0; a.ph_hi = NPH;
    hipLaunchKernelGGL(fwd, dim3(grid), dim3(NWAVES * 64), LDS_BYTES, stream, a);
#else
    for (int p = 0; p < NPH; ++p) { a.ph_lo = p; a.ph_hi = p + 1; hipLaunchKernelGGL(fwd, dim3(grid), dim3(NWAVES * 64), LDS_BYTES, stream, a); }
#endif
}
```

```cpp
#include <hip/hip_runtime.h>
#include <cstdio>
#include <cstdint>
namespace pg8 {
#define PG8_LAS __attribute__((address_space(3)))
typedef unsigned short bf16_t;
typedef short bf16x8 __attribute__((ext_vector_type(8)));
typedef float f32x4 __attribute__((ext_vector_type(4)));
typedef unsigned u32x4 __attribute__((ext_vector_type(4)));
constexpr int BM = 256, BK = 64, HALF = 128, HTB = HALF * BK * 2  , STAGE_BYTES = 8 * HTB, NXCD = 8, WGM = 8;

__host__ __device__ __forceinline__ int lds_byte(int r, int c) { const int st = (r >> 4) * 2 + (c >> 5), rr = r & 15, cc = c & 31, ob = rr * 64 + cc * 2; return st * 1024 + (ob ^ (((ob >> 9) & 1) << 5)); }
__host__ __device__ __forceinline__ void stage_rc(int b, int& R, int& C) { const int st = b / 1024, sb = b % 1024, swz = sb ^ (((sb >> 9) & 1) << 5); R = (st >> 1) * 16 + swz / 64; C = (st & 1) * 32 + (swz % 64) / 2; }
__host__ __device__ __forceinline__ int perm32(int rho) { const int n = rho >> 4, i = rho & 15; return 8 * (i >> 2) + 4 * n + (i & 3); }

struct Unit { int pm, pn; };
struct Gemm { const bf16_t* A; const bf16_t* Bt; int M, N, K; };

struct StaticOrder {
    int nM, nN, nwg, G, c;
    __host__ __device__ void init(int M, int N, int G_, int c_) { nM = M / BM; nN = N / BM; nwg = nM * nN; G = G_; c = c_; }
    __host__ __device__ bool next(int i, Unit& u) const {
        const long L = (long)i * G + c; if (L >= nwg) return false;
        int wgid = (int)L; { const int q = nwg / NXCD, r = nwg % NXCD, xcd = wgid % NXCD, off = wgid / NXCD; wgid = (xcd < r ? xcd * (q + 1) : r * (q + 1) + (xcd - r) * q) + off; }
        const int nig = WGM * nN, gid = wgid / nig, fm = gid * WGM, gsz = (nM - fm) < WGM ? (nM - fm) : WGM;
        u.pm = fm + ((wgid % nig) % gsz); u.pn = (wgid % nig) / gsz; return true;
    }
    __device__ __forceinline__ void a_ready(const Unit&) const {}
    __device__ __forceinline__ void done(const Unit&) const {}
};

__device__ __forceinline__ unsigned cvt_pk_bf16(float lo, float hi) { unsigned r; asm volatile("v_cvt_pk_bf16_f32 %0, %1, %2" : "=v"(r) : "v"(lo), "v"(hi)); return r; }
template <class Epi, class Sched, bool ALIGN_EPI = false, bool SP2 = false>
__device__ __forceinline__ void gemm_phase(PG8_LAS unsigned char* lds, const Gemm g, const Sched& S, const Epi& E) {
    const int tid = threadIdx.x, wid = __builtin_amdgcn_readfirstlane(tid >> 6), lane = tid & 63, wr = wid >> 2, wc = wid & 3, fr = lane & 15, fq = lane >> 4;
    const int K = g.K, nt = K / BK;
    unsigned voffA[2], voffB[2];
#pragma unroll
    for (int i = 0; i < 2; ++i) { int R, C; stage_rc(tid * 16 + i * 8192, R, C); const int Rb = Epi::PERM ? ((R & ~31) + perm32(R & 31)) : R;
        voffA[i] = (unsigned)(R * K + C) * 2u; voffB[i] = (unsigned)(Rb * K + C) * 2u; }
    const size_t kstep = (size_t)(BK * 2);
    const size_t hstep = (size_t)HALF * K * 2;
    const size_t tstep = 2 * hstep;
    const unsigned ldsw = (unsigned)wid * 1024u;
    const int aoff = lds_byte(wr * 64 + fr, fq * 8), boff = lds_byte(wc * 32 + fr, fq * 8);
#define PG8_SA(b, h) (((b) * 2 + (h)) * HTB)
#define PG8_SB(b, h) ((4 + (b) * 2 + (h)) * HTB)
#define PG8_STAGE(bufoff, gbase, voff) do { _Pragma("unroll") for (int _i = 0; _i < 2; ++_i) \
        __builtin_amdgcn_global_load_lds((const unsigned*)((const char*)(gbase) + (voff)[_i]), (PG8_LAS unsigned*)(lds + (bufoff) + ldsw + _i * 8192), 16, 0, 0); } while (0)
#define PG8_LDA(dst, b, h) do { _Pragma("unroll") for (int m = 0; m < 4; ++m) _Pragma("unroll") for (int k = 0; k < 2; ++k) dst[m][k] = *(const PG8_LAS bf16x8*)(lds + PG8_SA(b, h) + aoff + m * 2048 + k * 1024); } while (0)
#define PG8_LDB(dst, b, h) do { _Pragma("unroll") for (int n = 0; n < 2; ++n) _Pragma("unroll") for (int k = 0; k < 2; ++k) dst[n][k] = *(const PG8_LAS bf16x8*)(lds + PG8_SB(b, h) + boff + n * 2048 + k * 1024); } while (0)
#define PG8_MMA(ai, bj, At, Bt) do { __builtin_amdgcn_s_setprio(1); _Pragma("unroll") for (int m = 0; m < 4; ++m) _Pragma("unroll") for (int n = 0; n < 2; ++n) _Pragma("unroll") for (int k = 0; k < 2; ++k) \
        acc[ai][bj][m][n] = __builtin_amdgcn_mfma_f32_16x16x32_bf16(Bt[n][k], At[m][k], acc[ai][bj][m][n], 0, 0, 0); __builtin_amdgcn_s_setprio(0); } while (0)
#define PG8_WAIT_V(n) asm volatile("s_waitcnt vmcnt(" #n ")" ::: "memory")
#define PG8_WAIT_L(n) asm volatile("s_waitcnt lgkmcnt(" #n ")" ::: "memory")
#define PG8_BAR __builtin_amdgcn_s_barrier()
#define PG8_SCHED __builtin_amdgcn_sched_barrier(0)
    Unit cur, nxt; int ui = 0;
    if (!S.next(0, cur)) return;
    f32x4 acc[2][2][4][2];
#pragma unroll
    for (int a = 0; a < 2; ++a)
#pragma unroll
        for (int b = 0; b < 2; ++b)
#pragma unroll
            for (int m = 0; m < 4; ++m)
#pragma unroll
                for (int n = 0; n < 2; ++n) acc[a][b][m][n] = (f32x4){0.f, 0.f, 0.f, 0.f};
    bf16x8 At[4][2], B0[2][2], B1[2][2];
    const char* cA = (const char*)g.A + (size_t)cur.pm * tstep; const char* cB = (const char*)g.Bt + (size_t)cur.pn * tstep;
    S.a_ready(cur);
    if constexpr (SP2) {
        PG8_STAGE(PG8_SB(0, 0), cB, voffB); PG8_STAGE(PG8_SB(0, 1), cB + hstep, voffB); PG8_STAGE(PG8_SA(0, 0), cA, voffA); PG8_STAGE(PG8_SA(0, 1), cA + hstep, voffA);
        if (wr == 1) PG8_BAR;
        PG8_WAIT_V(2); PG8_BAR;
        PG8_STAGE(PG8_SB(1, 0), cB + kstep, voffB); PG8_STAGE(PG8_SA(1, 0), cA + kstep, voffA); PG8_STAGE(PG8_SB(1, 1), cB + hstep + kstep, voffB);
        PG8_WAIT_V(6); PG8_BAR;
    } else {
        PG8_STAGE(PG8_SB(0, 0), cB, voffB); PG8_STAGE(PG8_SA(0, 0), cA, voffA); PG8_STAGE(PG8_SB(0, 1), cB + hstep, voffB); PG8_STAGE(PG8_SA(0, 1), cA + hstep, voffA);
        if (wr == 1) PG8_BAR;
        PG8_WAIT_V(4); PG8_BAR;
        PG8_STAGE(PG8_SB(1, 0), cB + kstep, voffB); PG8_STAGE(PG8_SA(1, 0), cA + kstep, voffA); PG8_STAGE(PG8_SB(1, 1), cB + hstep + kstep, voffB);
        PG8_WAIT_V(6); PG8_BAR;
    }
    for (;;) {
        const bool has_next = S.next(ui + 1, nxt);
        const char* nA = has_next ? (const char*)g.A + (size_t)nxt.pm * tstep : cA; const char* nB = has_next ? (const char*)g.Bt + (size_t)nxt.pn * tstep : cB;
        for (int t = 0; t < nt; t += 2) {
            const bool last = (t == nt - 2);
            const char* a1 = cA + (size_t)(t + 1) * kstep;
            const char* a2 = last ? nA : cA + (size_t)(t + 2) * kstep; const char* b2 = last ? nB : cB + (size_t)(t + 2) * kstep;
            const char* a3 = a2 + kstep; const char* b3 = b2 + kstep;
            if (last && has_next) S.a_ready(nxt);
            if constexpr (SP2) {
            PG8_LDB(B0, 0, 0); PG8_LDB(B1, 0, 1); PG8_SCHED; PG8_LDA(At, 0, 0); PG8_STAGE(PG8_SA(1, 1), a1 + hstep, voffA);
            PG8_WAIT_V(8); PG8_WAIT_L(0); PG8_BAR; PG8_MMA(0, 0, At, B0); PG8_MMA(0, 1, At, B1); PG8_BAR; PG8_SCHED;
            PG8_LDA(At, 0, 1); PG8_STAGE(PG8_SB(0, 0), b2, voffB); PG8_STAGE(PG8_SB(0, 1), b2 + hstep, voffB); PG8_STAGE(PG8_SA(0, 0), a2, voffA);
            PG8_WAIT_V(8); PG8_WAIT_L(0); PG8_BAR; PG8_MMA(1, 0, At, B0); PG8_MMA(1, 1, At, B1); PG8_BAR; PG8_SCHED;
            PG8_LDB(B0, 1, 0); PG8_LDB(B1, 1, 1); PG8_SCHED; PG8_LDA(At, 1, 0); PG8_STAGE(PG8_SA(0, 1), a2 + hstep, voffA);
            PG8_WAIT_V(8); PG8_WAIT_L(0); PG8_BAR; PG8_MMA(0, 0, At, B0); PG8_MMA(0, 1, At, B1); PG8_BAR; PG8_SCHED;
            PG8_LDA(At, 1, 1); PG8_STAGE(PG8_SB(1, 0), b3, voffB); PG8_STAGE(PG8_SB(1, 1), b3 + hstep, voffB); PG8_STAGE(PG8_SA(1, 0), a3, voffA);
            PG8_WAIT_V(8); PG8_WAIT_L(0); PG8_BAR; PG8_MMA(1, 0, At, B0); PG8_MMA(1, 1, At, B1); PG8_BAR; PG8_SCHED;
            } else {
            PG8_LDB(B0, 0, 0); PG8_SCHED; PG8_LDA(At, 0, 0); PG8_STAGE(PG8_SA(1, 1), a1 + hstep, voffA);
            PG8_WAIT_L(8); PG8_BAR; PG8_WAIT_L(0); PG8_MMA(0, 0, At, B0); PG8_BAR; PG8_SCHED;
            PG8_LDB(B1, 0, 1); PG8_STAGE(PG8_SB(0, 0), b2, voffB);
            PG8_BAR; PG8_WAIT_L(0); PG8_MMA(0, 1, At, B1); PG8_BAR;
            PG8_LDA(At, 0, 1); PG8_STAGE(PG8_SA(0, 0), a2, voffA);
            PG8_BAR; PG8_WAIT_L(0); PG8_MMA(1, 0, At, B0); PG8_BAR; PG8_SCHED;
            PG8_STAGE(PG8_SB(0, 1), b2 + hstep, voffB);
            PG8_WAIT_V(6); PG8_BAR; PG8_MMA(1, 1, At, B1); PG8_BAR;
            PG8_LDB(B0, 1, 0); PG8_SCHED; PG8_LDA(At, 1, 0); PG8_STAGE(PG8_SA(0, 1), a2 + hstep, voffA);
            PG8_WAIT_L(8); PG8_BAR; PG8_WAIT_L(0); PG8_MMA(0, 0, At, B0); PG8_BAR; PG8_SCHED;
            PG8_LDB(B1, 1, 1); PG8_STAGE(PG8_SB(1, 0), b3, voffB);
            PG8_BAR; PG8_WAIT_L(0); PG8_MMA(0, 1, At, B1); PG8_BAR;
            PG8_LDA(At, 1, 1); PG8_STAGE(PG8_SA(1, 0), a3, voffA);
            PG8_BAR; PG8_WAIT_L(0); PG8_MMA(1, 0, At, B0); PG8_BAR; PG8_SCHED;
            PG8_STAGE(PG8_SB(1, 1), b3 + hstep, voffB);
            PG8_WAIT_V(6); PG8_BAR; PG8_MMA(1, 1, At, B1); PG8_BAR;
            }
        }
        if constexpr (ALIGN_EPI) { if (wr == 0) PG8_BAR; }
        if constexpr (!Epi::AFTER_DRAIN) { E(acc, cur, wr, wc, fr, fq); S.done(cur); }
        if (!has_next) break;
#pragma unroll
        for (int a = 0; a < 2; ++a)
#pragma unroll
            for (int b = 0; b < 2; ++b)
#pragma unroll
                for (int m = 0; m < 4; ++m)
#pragma unroll
                    for (int n = 0; n < 2; ++n) acc[a][b][m][n] = (f32x4){0.f, 0.f, 0.f, 0.f};
        cur = nxt; cA = nA; cB = nB; ++ui;
        if constexpr (ALIGN_EPI) { if (wr == 1) PG8_BAR; }
    }
    PG8_WAIT_V(0);
    if constexpr (!ALIGN_EPI) { if (wr == 0) PG8_BAR; }
    PG8_BAR;
    if constexpr (Epi::AFTER_DRAIN) { E.fused(acc, cur, wr, wc, fr, fq, lds, wid, lane); S.done(cur); }
#undef PG8_SA
#undef PG8_SB
#undef PG8_STAGE
#undef PG8_LDA
#undef PG8_LDB
#undef PG8_MMA
#undef PG8_WAIT_V
#undef PG8_WAIT_L
#undef PG8_BAR
#undef PG8_SCHED
}
}
#define LAS __attribute__((address_space(3)))
#define XB_TMO      128
#define XB_XCNT(j)  (256  + 64 * (j))
#define XB_XSUB(j)  (1280 + 64 * (j))
#define XB_XGEN(j)  (2304 + 64 * (j))
#define XB_TOP      3328
#define XB_TOPGEN   3392
#define XCD_BAR_WORDS 3456
#define XB_SPIN_CAP (1u << 18)

__device__ __forceinline__ unsigned xb_ld(unsigned* p)              { return __hip_atomic_load(p, __ATOMIC_RELAXED, __HIP_MEMORY_SCOPE_AGENT); }
__device__ __forceinline__ unsigned xb_add(unsigned* p, unsigned v) { return __hip_atomic_fetch_add(p, v, __ATOMIC_RELAXED, __HIP_MEMORY_SCOPE_AGENT); }
__device__ __forceinline__ unsigned xb_xcc_id() { return (unsigned)__builtin_amdgcn_s_getreg((3 << 11) | 20) & 0xFu; }
#define XB_SPIN(cond, bar) do { unsigned _sp = 0; while (cond) { __builtin_amdgcn_s_sleep(1); \
    if ((++_sp & 255u) == 0u) { if (xb_ld(&(bar)[XB_TMO])) break; if (_sp > XB_SPIN_CAP) { atomicAdd(&(bar)[XB_TMO], 1u); break; } } } } while (0)

struct XcdBarrier {
    unsigned* bar; unsigned x;
    volatile LAS unsigned* st;
};

__device__ __forceinline__ XcdBarrier xcd_barrier_post(unsigned* bar, volatile LAS unsigned* st) {
    XcdBarrier b; b.bar = bar; b.x = xb_xcc_id(); b.st = st;
    if (threadIdx.x == 0) (void)xb_add(&bar[XB_XCNT(b.x)], 1u);
    return b;
}
__device__ __forceinline__ void xcd_barrier_complete(unsigned* bar, unsigned x, unsigned& nloc, unsigned& nx) {
    const unsigned G = gridDim.x * gridDim.y * gridDim.z;
    unsigned sum, cnt, mine, sp = 0u;
    for (;;) {
        sum = 0u; cnt = 0u; mine = 0u;
#pragma unroll
        for (unsigned j = 0; j < 16; ++j) { const unsigned c = xb_ld(&bar[XB_XCNT(j)]); sum += c; cnt += (c > 0u) ? 1u : 0u; mine = (j == x) ? c : mine; }
        if (sum == G) break;
        __builtin_amdgcn_s_sleep(1);
        if ((++sp & 255u) == 0u) { if (xb_ld(&bar[XB_TMO])) break; if (sp > XB_SPIN_CAP) { atomicAdd(&bar[XB_TMO], 1u); break; } }
    }
    nloc = mine > 0u ? mine : 1u; nx = cnt > 0u ? cnt : 1u;
}

__device__ __forceinline__ void xcd_barrier(const XcdBarrier& b) {
    asm volatile("s_waitcnt vmcnt(0)" ::: "memory");
    __syncthreads();
    if (threadIdx.x == 0) {
        unsigned* bar = b.bar;
        __builtin_amdgcn_s_waitcnt(0);
        unsigned nloc = b.st[0], nx = b.st[1];
        if (nloc == 0u) { xcd_barrier_complete(bar, b.x, nloc, nx); b.st[0] = nloc; b.st[1] = nx; }
        const unsigned old = xb_add(&bar[XB_XSUB(b.x)], 1u);
        const unsigned gen = old / nloc;
        if (old + 1u == (gen + 1u) * nloc) {
            __builtin_amdgcn_fence(__ATOMIC_RELEASE, "agent");
            asm volatile("s_waitcnt vmcnt(0)" ::: "memory");
            const unsigned og = xb_add(&bar[XB_TOP], 1u);
            const unsigned tg = og / nx;
            if (og + 1u == (tg + 1u) * nx) xb_add(&bar[XB_TOPGEN], 1u);
            else XB_SPIN(xb_ld(&bar[XB_TOPGEN]) == tg, bar);
            __builtin_amdgcn_fence(__ATOMIC_ACQUIRE, "agent");
            xb_add(&bar[XB_XGEN(b.x)], 1u);
            asm volatile("s_waitcnt vmcnt(0)" ::: "memory");
        } else {
            XB_SPIN(xb_ld(&bar[XB_XGEN(b.x)]) == gen, bar);
            __builtin_amdgcn_fence(__ATOMIC_ACQUIRE, "agent");
            asm volatile("s_waitcnt vmcnt(0)" ::: "memory");
        }
    }
    __syncthreads();
}
constexpr int D = 2048, SEQ = 8192, NMETA = 16, LEAD = 48, NP = 8256  , MP = 8448  ;
constexpr int NPROJ = 3840, C_Z = 1024, C_X = 2048, C_B = 3072, C_C = 3328, C_DT = 3584, NINPROJ = 3600;
constexpr int NE = 32, DCONV = 1536;
constexpr int RTILES = 160, RPAD = RTILES * 256;
constexpr float EPS = 1e-5f;
constexpr int NWAVES = 8, NPH = 12;
#ifndef MK_ONE_LAUNCH
#define MK_ONE_LAUNCH 1
#endif

constexpr size_t WS_CTL = 0, CTL_BYTES = 1u << 20;
constexpr size_t WS_HN = CTL_BYTES;
constexpr size_t WS_BT1 = WS_HN + (size_t)MP * D * 2;
constexpr size_t WS_BT2 = WS_BT1 + (size_t)NPROJ * D * 2;
constexpr size_t WS_PROJ = WS_BT2 + (size_t)D * D * 2;
constexpr size_t WS_XT = WS_PROJ + (size_t)MP * NPROJ * 2;
constexpr size_t WS_BTT = WS_XT + (size_t)1024 * NP * 2;
constexpr size_t WS_BC = WS_BTT + (size_t)256 * NP * 2;
constexpr size_t WS_CC = WS_BC + (size_t)NP * 256 * 2;
constexpr size_t WS_DT = WS_CC + (size_t)NP * 256 * 2;
constexpr size_t WS_ST = WS_DT + (size_t)NP * 16 * 4;
constexpr size_t WS_DEC = WS_ST + (size_t)128 * 131072 * 4;
constexpr size_t WS_PREV = WS_DEC + 128 * 16 * 4;
constexpr size_t WS_YCAT = WS_PREV + (size_t)128 * 131072 * 2;
constexpr size_t WS_H2 = WS_YCAT + (size_t)SEQ * D * 2;
constexpr size_t WS_HN2 = WS_H2 + (size_t)SEQ * D * 4;
constexpr size_t WS_WR = WS_HN2 + (size_t)SEQ * D * 2;
constexpr size_t WS_TKE = WS_WR + (size_t)D * NE * 4;
constexpr size_t WS_TKG = WS_TKE + (size_t)SEQ * 16;
constexpr size_t WS_POS = WS_TKG + (size_t)SEQ * 16;
constexpr size_t WS_CNT = WS_POS + (size_t)SEQ * 16;
constexpr size_t WS_TILE = WS_CNT + 256 * 32 * 4;
constexpr size_t WS_XS = WS_TILE + 1024;
constexpr size_t WS_A = WS_XS + (size_t)RPAD * D * 2;
constexpr size_t WS_BTGU = WS_A + (size_t)RPAD * D * 2;
constexpr size_t WS_BTD = WS_BTGU + (size_t)NE * 4096 * D * 2;
constexpr size_t WS_END = WS_BTD + (size_t)NE * D * D * 2;
constexpr int CW_BAR = 4096;
static_assert((CW_BAR + XCD_BAR_WORDS) * 4 <= (int)CTL_BYTES, "ctl");

constexpr int RING_BYTES = 131072, SCR_BYTES = 135168, MISC_OFF = SCR_BYTES, LDS_BYTES = 147456;

#define DI __device__ __forceinline__
typedef unsigned short bf16;
typedef unsigned v4u __attribute__((ext_vector_type(4)));
typedef unsigned v2u __attribute__((ext_vector_type(2)));
typedef float f32x4 __attribute__((ext_vector_type(4)));
typedef float f32x16 __attribute__((ext_vector_type(16)));
typedef short bf16x8 __attribute__((ext_vector_type(8)));
#define LDS_WAIT() asm volatile("s_waitcnt lgkmcnt(0)" ::: "memory")
#define MFMA32(a, b, c) __builtin_amdgcn_mfma_f32_32x32x16_bf16((a), (b), (c), 0, 0, 0)
DI float bf_lo(unsigned w) { return __uint_as_float(w << 16); }
DI float bf_hi(unsigned w) { return __uint_as_float(w & 0xffff0000u); }
DI float bf2f(bf16 v) { return __uint_as_float(((unsigned)v) << 16); }
DI unsigned pk2(float lo, float hi) { return pg8::cvt_pk_bf16(lo, hi); }
DI bf16 f2bf(float f) { return (bf16)(pk2(f, 0.f) & 0xffffu); }
DI float wave_sum(float v) {
#pragma unroll
    for (int o = 1; o < 64; o <<= 1) v += __shfl_xor(v, o);
    return v;
}
DI float wave_incl_scan(float v, int lane) {
#pragma unroll
    for (int o = 1; o < 64; o <<= 1) { const float t = __shfl_up(v, o); if (lane >= o) v += t; }
    return v;
}
DI float silu_f(float x) { return x * __builtin_amdgcn_rcpf(1.f + __expf(-x)); }

struct Frame {
    LAS unsigned char* lds;
    int tid, lane, wave, gw, ngw;
    const float *x, *meta, *g1, *w_in, *pool_w, *pool_scale, *conv_w, *conv_b, *dt_bias, *a_log, *d_skip, *ssm_g, *w_out, *g2, *router_w, *router_b,
        *w_gate, *b_gate, *w_up, *b_up, *w_down, *b_down, *final_g;
    float* out;
    bf16 *hn, *Bt1, *Bt2, *proj, *xT, *BT, *Bc, *Cc, *prev, *ycat, *hn2, *xs, *abuf, *obuf, *Btgu, *Btd;
    float *dtv, *states, *decay, *h2, *Wr, *tkg;
    int *tke, *pos, *cnt, *tile;
};

DI void p0_norm(Frame& F) {
    for (int P = F.gw; P < NP; P += F.ngw) {
        unsigned long long* o8 = (unsigned long long*)(F.hn + (size_t)P * D) + F.lane;
        if (P < LEAD) {
#pragma unroll
            for (int j = 0; j < 8; ++j) o8[64 * j] = 0ull;
            continue;
        }
        const int t = P - LEAD;
        const float* src = t < NMETA ? F.meta + (size_t)t * D : F.x + (size_t)(t - NMETA) * D;
        const f32x4* xr = (const f32x4*)src + F.lane; const f32x4* gr = (const f32x4*)F.g1 + F.lane;
        f32x4 v[8]; float s = 0.f;
#pragma unroll
        for (int j = 0; j < 8; ++j) { v[j] = xr[64 * j]; s += (v[j].x * v[j].x + v[j].y * v[j].y) + (v[j].z * v[j].z + v[j].w * v[j].w); }
        const float rstd = rsqrtf(wave_sum(s) * (1.f / D) + EPS);
#pragma unroll
        for (int j = 0; j < 8; ++j) { const f32x4 g = gr[64 * j];
            o8[64 * j] = (unsigned long long)pk2(v[j].x * rstd * g.x, v[j].y * rstd * g.y) | ((unsigned long long)pk2(v[j].z * rstd * g.z, v[j].w * rstd * g.w) << 32); }
    }
}
DI void tr_load(float (&v)[64], const float* W, size_t ldw, int nvalid, int lane) {
    const float* wp = W + lane;
    if (lane < nvalid) {
#pragma unroll
        for (int kk = 0; kk < 64; ++kk) v[kk] = __builtin_nontemporal_load(wp + (size_t)kk * ldw);
    } else {
#pragma unroll
        for (int kk = 0; kk < 64; ++kk) v[kk] = 0.f;
    }
}
DI void tr_store(const float (&v)[64], int nvalid, bf16* WT, size_t ldt, LAS float* scr, int lane) {
#pragma unroll
    for (int kk = 0; kk < 64; ++kk) scr[kk * 65 + lane] = v[kk];
    LDS_WAIT();
    const int c = lane & 7;
#pragma unroll
    for (int j = 0; j < 8; ++j) { const int n = (lane >> 3) + 8 * j; const LAS float* s = scr + (8 * c) * 65 + n;
        v4u o; o.x = pk2(s[0], s[65]); o.y = pk2(s[130], s[195]); o.z = pk2(s[260], s[325]); o.w = pk2(s[390], s[455]);
        if (n < nvalid) *(v4u*)(WT + (size_t)n * ldt + 8 * c) = o; }
    LDS_WAIT();
}
struct TrItem { const float* W; bf16* WT; int ldw, nv; };
constexpr int I_IN = 32 * 57, I_OUT = 16 * 32, I_MOE = NE * 3 * 32 * 32, NITEMS = I_IN + I_OUT + I_MOE;
DI TrItem tr_get(Frame& F, int it) {
    TrItem t; int r = it;
    if (r < I_MOE) {
        const int nb = r & 31, kb = (r >> 5) & 31, em = r >> 10, mat = em % 3, e = em / 3;
        t.ldw = D; t.nv = 64;
        if (mat == 2) { t.W = F.w_down + (size_t)e * D * D + (size_t)(64 * kb) * D + 64 * nb; t.WT = F.Btd + ((size_t)e * D + 64 * nb) * D + 64 * kb; }
        else { t.W = (mat == 0 ? F.w_gate : F.w_up) + (size_t)e * D * D + (size_t)(64 * kb) * D + 64 * nb;
               const int row = 256 * (nb >> 1) + 64 * (nb & 1) + 128 * mat; t.WT = F.Btgu + ((size_t)e * 4096 + row) * D + 64 * kb; }
        return t;
    }
    r -= I_MOE;
    if (r < I_IN) { const int kb = r / 57, nb = r % 57; t.ldw = NINPROJ; t.nv = (nb == 56) ? 16 : 64;
        t.W = F.w_in + (size_t)(64 * kb) * NINPROJ + 64 * nb; t.WT = F.Bt1 + (size_t)(64 * nb) * D + 64 * kb; return t; }
    r -= I_IN;
    { const int kb = r >> 5, nb = r & 31; t.ldw = D; t.nv = 64;
      t.W = F.w_out + (size_t)(1024 + 64 * kb) * D + 64 * nb; t.WT = F.Bt2 + (size_t)(64 * nb) * D + 1024 + 64 * kb; return t; }
}
DI void p0_weights(Frame& F) {
    LAS float* scr = (LAS float*)(F.lds + F.wave * 16640);
    float va[64], vb[64];
    int it = F.gw;
    if (it >= NITEMS) return;
    TrItem ta = tr_get(F, it), tb = ta;
    tr_load(va, ta.W, ta.ldw, ta.nv, F.lane);
    for (;;) {
        const bool hb = it + F.ngw < NITEMS;
        if (hb) { tb = tr_get(F, it + F.ngw); tr_load(vb, tb.W, tb.ldw, tb.nv, F.lane); }
        tr_store(va, ta.nv, ta.WT, D, scr, F.lane);
        if (!hb) break;
        it += F.ngw;
        const bool ha = it + F.ngw < NITEMS;
        if (ha) { ta = tr_get(F, it + F.ngw); tr_load(va, ta.W, ta.ldw, ta.nv, F.lane); }
        tr_store(vb, tb.nv, tb.WT, D, scr, F.lane);
        if (!ha) break;
        it += F.ngw;
    }
}
DI void p0_weff(Frame& F) {
    for (int task = F.gw; task < 2048; task += F.ngw) {
        const int g = task >> 9, rem = task & 511, cb = rem >> 5, nb = rem & 31, n = 64 * nb + F.lane;
        float acc[16];
#pragma unroll
        for (int j = 0; j < 16; ++j) acc[j] = 0.f;
        const float* pw = F.pool_w + (size_t)(g * 256 + 16 * cb) * 256;
        const float* wo = F.w_out + (size_t)(256 * g) * D + n;
        const float* ps = F.pool_scale + 256 * g;
#pragma unroll 4
        for (int d = 0; d < 256; ++d) {
            const float wv = wo[(size_t)d * D] * ps[d];
#pragma unroll
            for (int j = 0; j < 16; ++j) acc[j] += pw[j * 256 + d] * wv;
        }
        v4u o0, o1;
        o0.x = pk2(acc[0], acc[1]); o0.y = pk2(acc[2], acc[3]); o0.z = pk2(acc[4], acc[5]); o0.w = pk2(acc[6], acc[7]);
        o1.x = pk2(acc[8], acc[9]); o1.y = pk2(acc[10], acc[11]); o1.z = pk2(acc[12], acc[13]); o1.w = pk2(acc[14], acc[15]);
        bf16* dst = F.Bt2 + (size_t)n * D + 256 * g + 16 * cb;
        *(v4u*)dst = o0; *(v4u*)(dst + 8) = o1;
    }
}
DI void p0_router_fold(Frame& F) {
    for (int i = blockIdx.x * 512 + F.tid; i < D * NE; i += gridDim.x * 512) F.Wr[i] = F.g2[i >> 5] * F.router_w[i];
}

DI void e_conv_tile(Frame& F, int c, int pcol, int cch, bf16* outT, bf16* outR, int rcol) {
    const int lane = F.lane, ch = cch + lane;
    const float w0 = F.conv_w[ch], w1 = F.conv_w[DCONV + ch], w2 = F.conv_w[2 * DCONV + ch], w3 = F.conv_w[3 * DCONV + ch], b = F.conv_b[ch];
    const bf16* src = F.proj + pcol + lane;
    const int P0 = 64 * c;
    float v[19];
#pragma unroll
    for (int i = 0; i < 3; ++i) v[i] = (P0 - 3 + i >= 0) ? bf2f(src[(size_t)(P0 - 3 + i) * NPROJ]) : 0.f;
#pragma unroll
    for (int sb = 0; sb < 4; ++sb) {
#pragma unroll
        for (int i = 0; i < 16; ++i) v[3 + i] = bf2f(src[(size_t)(P0 + 16 * sb + i) * NPROJ]);
        float o[16];
#pragma unroll
        for (int i = 0; i < 16; ++i) { const float a = b + w0 * v[i] + w1 * v[i + 1] + w2 * v[i + 2] + w3 * v[i + 3];
            o[i] = (P0 + 16 * sb + i >= LEAD) ? silu_f(a) : 0.f; }
        if (outT) { v4u q0, q1;
            q0.x = pk2(o[0], o[1]); q0.y = pk2(o[2], o[3]); q0.z = pk2(o[4], o[5]); q0.w = pk2(o[6], o[7]);
            q1.x = pk2(o[8], o[9]); q1.y = pk2(o[10], o[11]); q1.z = pk2(o[12], o[13]); q1.w = pk2(o[14], o[15]);
            bf16* dst = outT + (size_t)lane * NP + P0 + 16 * sb; *(v4u*)dst = q0; *(v4u*)(dst + 8) = q1; }
        if (outR) {
#pragma unroll
            for (int i = 0; i < 16; ++i) outR[(size_t)(P0 + 16 * sb + i) * 256 + rcol + lane] = f2bf(o[i]); }
        v[0] = v[16]; v[1] = v[17]; v[2] = v[18];
    }
}
template <int W> DI void e_pool_tile(Frame& F, int c, int colbase) {
    const int lane = F.lane; const bf16* src = F.proj + colbase + lane; const int P0 = 64 * c;
#pragma unroll
    for (int sb = 0; sb < 4; ++sb) {
        float v[16 + W - 1];
#pragma unroll
        for (int i = 0; i < 16 + W - 1; ++i) v[i] = bf2f(src[(size_t)(P0 + 16 * sb - (W - 1) + i) * NPROJ]);
#pragma unroll
        for (int i = 0; i < 16; ++i) { float s = 0.f;
#pragma unroll
            for (int j = 0; j < W; ++j) s += v[i + j];
            F.ycat[(size_t)(P0 - 64 + 16 * sb + i) * D + colbase + lane] = f2bf(s * (1.f / W) - v[i + W - 1]); }
    }
}
DI void e_dt_tile(Frame& F, int c) {
    const int P = 64 * c + F.lane;
    const v4u* src = (const v4u*)(F.proj + (size_t)P * NPROJ + C_DT);
    const v4u r0 = src[0], r1 = src[1];
    const unsigned w[8] = {r0.x, r0.y, r0.z, r0.w, r1.x, r1.y, r1.z, r1.w};
    float o[16];
#pragma unroll
    for (int i = 0; i < 8; ++i) { o[2 * i] = bf_lo(w[i]); o[2 * i + 1] = bf_hi(w[i]); }
#pragma unroll
    for (int h = 0; h < 16; ++h) { const float x = o[h] + F.dt_bias[h]; const float sp = fmaxf(x, 0.f) + log1pf(__expf(-fabsf(x))); o[h] = (P >= LEAD) ? sp : 0.f; }
    f32x4* dst = (f32x4*)(F.dtv + (size_t)P * 16);
#pragma unroll
    for (int q = 0; q < 4; ++q) dst[q] = (f32x4){o[4 * q], o[4 * q + 1], o[4 * q + 2], o[4 * q + 3]};
}
DI void p2_elem(Frame& F) {
    constexpr int NT = 129 * 41;
    for (int task = F.gw; task < NT; task += F.ngw) {
        const int c = task / 41, j = task % 41;
        if (j < 16) { if (c == 0) continue; const int g = j >> 2;
            if (g == 0) e_pool_tile<2>(F, c, 64 * j); else if (g == 1) e_pool_tile<4>(F, c, 64 * j); else if (g == 2) e_pool_tile<8>(F, c, 64 * j); else e_pool_tile<16>(F, c, 64 * j); }
        else if (j < 32) e_conv_tile(F, c, C_X + 64 * (j - 16), 64 * (j - 16), F.xT + (size_t)(64 * (j - 16)) * NP, nullptr, 0);
        else if (j < 36) e_conv_tile(F, c, C_B + 64 * (j - 32), 1024 + 64 * (j - 32), F.BT + (size_t)(64 * (j - 32)) * NP, F.Bc, 64 * (j - 32));
        else if (j < 40) e_conv_tile(F, c, C_C + 64 * (j - 36), 1280 + 64 * (j - 36), nullptr, F.Cc, 64 * (j - 36));
        else e_dt_tile(F, c);
    }
}

DI int crow16(int reg, int hf) { return (reg & 3) + 8 * (reg >> 2) + 4 * hf; }
DI void p3_states(Frame& F) {
    const int lane = F.lane, r = lane & 31, hf = lane >> 5;
    LAS float* wsm = (LAS float*)(F.lds + F.wave * 256);
    for (int u = blockIdx.x; u < 256; u += gridDim.x) {
        const int c = u >> 1, g = u & 1, h = 8 * g + F.wave;
        const float A = -__expf(F.a_log[h]);
        const float dtl = F.dtv[(size_t)(64 * c + lane) * 16 + h];
        const float acs = wave_incl_scan(dtl * A, lane);
        const float tot = __shfl(acs, 63);
        wsm[lane] = dtl * __expf(tot - acs);
        if (lane == 0) F.decay[c * 16 + h] = __expf(tot);
        LDS_WAIT();
        f32x16 acc[2][4];
#pragma unroll
        for (int mt = 0; mt < 2; ++mt)
#pragma unroll
            for (int nt = 0; nt < 4; ++nt)
#pragma unroll
                for (int i = 0; i < 16; ++i) acc[mt][nt][i] = 0.f;
#pragma unroll
        for (int ks = 0; ks < 4; ++ks) {
            const f32x4 wa = *(const LAS f32x4*)(wsm + 16 * ks + 8 * hf), wb = *(const LAS f32x4*)(wsm + 16 * ks + 8 * hf + 4);
            bf16x8 af[2], bfr[4];
#pragma unroll
            for (int mt = 0; mt < 2; ++mt) {
                const v4u raw = *(const v4u*)(F.xT + (size_t)(h * 64 + 32 * mt + r) * NP + 64 * c + 16 * ks + 8 * hf);
                v4u sc; sc.x = pk2(bf_lo(raw.x) * wa.x, bf_hi(raw.x) * wa.y); sc.y = pk2(bf_lo(raw.y) * wa.z, bf_hi(raw.y) * wa.w);
                sc.z = pk2(bf_lo(raw.z) * wb.x, bf_hi(raw.z) * wb.y); sc.w = pk2(bf_lo(raw.w) * wb.z, bf_hi(raw.w) * wb.w);
                af[mt] = __builtin_bit_cast(bf16x8, sc);
            }
#pragma unroll
            for (int nt = 0; nt < 4; ++nt) bfr[nt] = *(const bf16x8*)(F.BT + (size_t)(g * 128 + 32 * nt + r) * NP + 64 * c + 16 * ks + 8 * hf);
#pragma unroll
            for (int mt = 0; mt < 2; ++mt)
#pragma unroll
                for (int nt = 0; nt < 4; ++nt) acc[mt][nt] = MFMA32(af[mt], bfr[nt], acc[mt][nt]);
        }
        float* st = F.states + ((size_t)(c * 16 + h) * 64) * 128;
#pragma unroll
        for (int mt = 0; mt < 2; ++mt)
#pragma unroll
            for (int nt = 0; nt < 4; ++nt)
#pragma unroll
                for (int i = 0; i < 16; ++i) st[(32 * mt + crow16(i, hf)) * 128 + 32 * nt + r] = acc[mt][nt][i];
        LDS_WAIT();
    }
}
DI void p4_scan(Frame& F) {
    for (int e = blockIdx.x * 512 + F.tid; e < 131072; e += gridDim.x * 512) {
        const int h = e >> 13; float carry = 0.f;
        for (int c0 = 0; c0 < 128; c0 += 8) {
            float s[8], dc[8];
#pragma unroll
            for (int i = 0; i < 8; ++i) { s[i] = F.states[(size_t)(c0 + i) * 131072 + e]; dc[i] = F.decay[(c0 + i) * 16 + h]; }
#pragma unroll
            for (int i = 0; i < 8; ++i) { carry = carry * dc[i] + s[i]; F.prev[(size_t)(c0 + i) * 131072 + e] = f2bf(carry); }
        }
    }
}
DI bf16x8 pack8(const f32x16& x, int s) {
    v4u p; p.x = pk2(x[8 * s], x[8 * s + 1]); p.y = pk2(x[8 * s + 2], x[8 * s + 3]); p.z = pk2(x[8 * s + 4], x[8 * s + 5]); p.w = pk2(x[8 * s + 6], x[8 * s + 7]);
    return __builtin_bit_cast(bf16x8, p);
}
DI void p5_out(Frame& F) {
    const int lane = F.lane, r = lane & 31, hf = lane >> 5;
    LAS float* acs_s = (LAS float*)(F.lds + F.wave * 512);
    LAS float* dt_s = acs_s + 64;
    LAS float* red = (LAS float*)(F.lds + 8192);
    for (int u = blockIdx.x; u < 256; u += gridDim.x) {
        const int c = 1 + (u >> 1), g = u & 1, h = 8 * g + F.wave;
        const float A = -__expf(F.a_log[h]), Dh = F.d_skip[h];
        const float dtl = F.dtv[(size_t)(64 * c + lane) * 16 + h];
        const float acs = wave_incl_scan(dtl * A, lane);
        acs_s[lane] = acs; dt_s[lane] = dtl;
        float acs_l[2]; acs_l[0] = __shfl(acs, r); acs_l[1] = __shfl(acs, 32 + r);
        LDS_WAIT();
        f32x16 yT[2][2], sT[3];
#pragma unroll
        for (int i = 0; i < 16; ++i) { yT[0][0][i] = 0.f; yT[0][1][i] = 0.f; yT[1][0][i] = 0.f; yT[1][1][i] = 0.f; sT[0][i] = 0.f; sT[1][i] = 0.f; sT[2][i] = 0.f; }
        const bf16* prevp = F.prev + ((size_t)(c - 1) * 16 + h) * 8192;
#pragma unroll 2
        for (int ks = 0; ks < 8; ++ks) {
            bf16x8 cf[2], pf[2], bg[2];
#pragma unroll
            for (int t = 0; t < 2; ++t) {
                cf[t] = *(const bf16x8*)(F.Cc + (size_t)(64 * c + 32 * t + r) * 256 + g * 128 + 16 * ks + 8 * hf);
                bg[t] = *(const bf16x8*)(F.Bc + (size_t)(64 * c + 32 * t + r) * 256 + g * 128 + 16 * ks + 8 * hf);
                pf[t] = *(const bf16x8*)(prevp + (32 * t + r) * 128 + 16 * ks + 8 * hf);
            }
            yT[0][0] = MFMA32(pf[0], cf[0], yT[0][0]); yT[0][1] = MFMA32(pf[0], cf[1], yT[0][1]);
            yT[1][0] = MFMA32(pf[1], cf[0], yT[1][0]); yT[1][1] = MFMA32(pf[1], cf[1], yT[1][1]);
            sT[0] = MFMA32(bg[0], cf[0], sT[0]); sT[1] = MFMA32(bg[0], cf[1], sT[1]); sT[2] = MFMA32(bg[1], cf[1], sT[2]);
        }
        { const float e0 = __expf(acs_l[0]), e1 = __expf(acs_l[1]);
#pragma unroll
          for (int i = 0; i < 16; ++i) { yT[0][0][i] *= e0; yT[1][0][i] *= e0; yT[0][1][i] *= e1; yT[1][1][i] *= e1; } }
#pragma unroll
        for (int t = 0; t < 3; ++t) {
            const int st = (t == 2) ? 1 : 0, lt = (t == 0) ? 0 : 1;
            const int l = 32 * lt + r;
#pragma unroll
            for (int q = 0; q < 4; ++q) {
                const f32x4 a4 = *(const LAS f32x4*)(acs_s + 32 * st + 8 * q + 4 * hf), d4 = *(const LAS f32x4*)(dt_s + 32 * st + 8 * q + 4 * hf);
#pragma unroll
                for (int e = 0; e < 4; ++e) { const int s = 32 * st + 8 * q + 4 * hf + e;
                    float val = sT[t][4 * q + e] * __expf(acs_l[lt] - a4[e]) * d4[e];
                    val = (s <= l) ? val : 0.f; val = (s == l) ? val + Dh : val;
                    sT[t][4 * q + e] = val; }
            }
        }
#pragma unroll
        for (int st = 0; st < 2; ++st)
#pragma unroll
            for (int sp = 0; sp < 2; ++sp) {
                bf16x8 xa[2];
#pragma unroll
                for (int pt = 0; pt < 2; ++pt) { const bf16* xp = F.xT + (size_t)(h * 64 + 32 * pt + r) * NP + 64 * c + 32 * st + 16 * sp + 4 * hf;
                    const v2u lo = *(const v2u*)xp, hi = *(const v2u*)(xp + 8); v4u w; w.x = lo.x; w.y = lo.y; w.z = hi.x; w.w = hi.y; xa[pt] = __builtin_bit_cast(bf16x8, w); }
                if (st == 0) { const bf16x8 m0 = pack8(sT[0], sp), m1 = pack8(sT[1], sp);
                    yT[0][0] = MFMA32(xa[0], m0, yT[0][0]); yT[1][0] = MFMA32(xa[1], m0, yT[1][0]);
                    yT[0][1] = MFMA32(xa[0], m1, yT[0][1]); yT[1][1] = MFMA32(xa[1], m1, yT[1][1]);
                } else { const bf16x8 m2 = pack8(sT[2], sp);
                    yT[0][1] = MFMA32(xa[0], m2, yT[0][1]); yT[1][1] = MFMA32(xa[1], m2, yT[1][1]); }
            }
        float ss[2] = {0.f, 0.f};
#pragma unroll
        for (int pt = 0; pt < 2; ++pt)
#pragma unroll
            for (int lt = 0; lt < 2; ++lt) {
                const bf16* zp = F.proj + (size_t)(64 * c + 32 * lt + r) * NPROJ + C_Z + h * 64 + 32 * pt + 4 * hf;
#pragma unroll
                for (int q = 0; q < 4; ++q) { const v2u zw = *(const v2u*)(zp + 8 * q);
                    const float z0 = bf_lo(zw.x), z1 = bf_hi(zw.x), z2 = bf_lo(zw.y), z3 = bf_hi(zw.y);
                    float y0 = yT[pt][lt][4 * q] * silu_f(z0), y1 = yT[pt][lt][4 * q + 1] * silu_f(z1), y2 = yT[pt][lt][4 * q + 2] * silu_f(z2), y3 = yT[pt][lt][4 * q + 3] * silu_f(z3);
                    yT[pt][lt][4 * q] = y0; yT[pt][lt][4 * q + 1] = y1; yT[pt][lt][4 * q + 2] = y2; yT[pt][lt][4 * q + 3] = y3;
                    ss[lt] += (y0 * y0 + y1 * y1) + (y2 * y2 + y3 * y3); }
            }
        ss[0] += __shfl_xor(ss[0], 32); ss[1] += __shfl_xor(ss[1], 32);
        if (hf == 0) { red[F.wave * 64 + r] = ss[0]; red[F.wave * 64 + 32 + r] = ss[1]; }
        LDS_WAIT(); __syncthreads();
        float rstd[2];
#pragma unroll
        for (int lt = 0; lt < 2; ++lt) { float t = 0.f;
#pragma unroll
            for (int w = 0; w < 8; ++w) t += red[w * 64 + 32 * lt + r];
            rstd[lt] = rsqrtf(t * (1.f / 512.f) + EPS); }
#pragma unroll
        for (int pt = 0; pt < 2; ++pt)
#pragma unroll
            for (int lt = 0; lt < 2; ++lt) {
                bf16* op = F.ycat + (size_t)(64 * (c - 1) + 32 * lt + r) * D + 1024 + h * 64 + 32 * pt + 4 * hf;
                const float* gp = F.ssm_g + h * 64 + 32 * pt + 4 * hf;
#pragma unroll
                for (int q = 0; q < 4; ++q) { const f32x4 gg = *(const f32x4*)(gp + 8 * q); v2u w;
                    w.x = pk2(yT[pt][lt][4 * q] * rstd[lt] * gg.x, yT[pt][lt][4 * q + 1] * rstd[lt] * gg.y);
                    w.y = pk2(yT[pt][lt][4 * q + 2] * rstd[lt] * gg.z, yT[pt][lt][4 * q + 3] * rstd[lt] * gg.w);
                    *(v2u*)(op + 8 * q) = w; }
            }
        __syncthreads();
    }
}

DI void p7_router(Frame& F) {
    LAS float* rs = (LAS float*)F.lds;
    LAS float* part = rs + 64;
    LAS float* lg = part + 8 * 1024;
    LAS int* hist = (LAS int*)(lg + 32 * 33 + 8);
    const int lane = F.lane, wave = F.wave;
    for (int blk = blockIdx.x; blk < 256; blk += gridDim.x) {
        const int r0 = 32 * blk;
#pragma unroll 1
        for (int i = 0; i < 4; ++i) {
            const int rr = r0 + 4 * wave + i;
            const f32x4* xr = (const f32x4*)(F.h2 + (size_t)rr * D) + lane; const f32x4* gr = (const f32x4*)F.g2 + lane;
            unsigned long long* o8 = (unsigned long long*)(F.hn2 + (size_t)rr * D) + lane;
            f32x4 v[8]; float s = 0.f;
#pragma unroll
            for (int j = 0; j < 8; ++j) { v[j] = xr[64 * j]; s += (v[j].x * v[j].x + v[j].y * v[j].y) + (v[j].z * v[j].z + v[j].w * v[j].w); }
            const float rstd = rsqrtf(wave_sum(s) * (1.f / D) + EPS);
#pragma unroll
            for (int j = 0; j < 8; ++j) { const f32x4 g = gr[64 * j];
                o8[64 * j] = (unsigned long long)pk2(v[j].x * rstd * g.x, v[j].y * rstd * g.y) | ((unsigned long long)pk2(v[j].z * rstd * g.z, v[j].w * rstd * g.w) << 32); }
            if (lane == 0) rs[4 * wave + i] = rstd;
        }
        f32x16 acc;
#pragma unroll
        for (int i = 0; i < 16; ++i) acc[i] = 0.f;
        { const int ri = lane & 31, kh = lane >> 5;
          const float* arow = F.h2 + (size_t)(r0 + ri) * D + 256 * wave + 4 * kh;
          const float* wp = F.Wr + (size_t)(256 * wave + 4 * kh) * 32 + ri;
#pragma unroll 4
          for (int jj = 0; jj < 32; ++jj) {
              const f32x4 a = *(const f32x4*)(arow + 8 * jj);
              const float b0 = wp[(8 * jj) * 32], b1 = wp[(8 * jj + 1) * 32], b2 = wp[(8 * jj + 2) * 32], b3 = wp[(8 * jj + 3) * 32];
              acc = __builtin_amdgcn_mfma_f32_32x32x2f32(a.x, b0, acc, 0, 0, 0);
              acc = __builtin_amdgcn_mfma_f32_32x32x2f32(a.y, b1, acc, 0, 0, 0);
              acc = __builtin_amdgcn_mfma_f32_32x32x2f32(a.z, b2, acc, 0, 0, 0);
              acc = __builtin_amdgcn_mfma_f32_32x32x2f32(a.w, b3, acc, 0, 0, 0);
          }
#pragma unroll
          for (int i = 0; i < 16; ++i) part[wave * 1024 + crow16(i, kh) * 32 + ri] = acc[i];
        }
        if (F.tid < 32) hist[F.tid] = 0;
        LDS_WAIT(); __syncthreads();
        for (int idx = F.tid; idx < 1024; idx += 512) { float s = 0.f;
#pragma unroll
            for (int w = 0; w < 8; ++w) s += part[w * 1024 + idx];
            lg[(idx >> 5) * 33 + (idx & 31)] = s * rs[idx >> 5] + F.router_b[idx & 31]; }
        LDS_WAIT(); __syncthreads();
        if (F.tid < 32) {
            const int i = F.tid; float tv[4]; int te[4];
#pragma unroll
            for (int k = 0; k < 4; ++k) { float best = -3.0e38f; int be = 0;
                for (int e = 0; e < 32; ++e) { const float x = lg[i * 33 + e]; if (x > best) { best = x; be = e; } }
                tv[k] = best; te[k] = be; lg[i * 33 + be] = -3.4e38f; }
            const float e1 = __expf(tv[1] - tv[0]), e2 = __expf(tv[2] - tv[0]), e3 = __expf(tv[3] - tv[0]);
            const float inv = 1.f / (1.f + e1 + e2 + e3);
            *(f32x4*)(F.tkg + (size_t)(r0 + i) * 4) = (f32x4){inv, e1 * inv, e2 * inv, e3 * inv};
            int* tk = F.tke + (size_t)(r0 + i) * 4; tk[0] = te[0]; tk[1] = te[1]; tk[2] = te[2]; tk[3] = te[3];
#pragma unroll
            for (int k = 0; k < 4; ++k) __hip_atomic_fetch_add(hist + te[k], 1, __ATOMIC_RELAXED, __HIP_MEMORY_SCOPE_WORKGROUP);
        }
        LDS_WAIT(); __syncthreads();
        if (F.tid < 32) F.cnt[blk * 32 + F.tid] = hist[F.tid];
        __syncthreads();
    }
}
DI void p8_route(Frame& F) {
    LAS int* tot = (LAS int*)F.lds; LAS int* pre = tot + 32; LAS int* base = tot + 64; LAS int* posl = tot + 128; LAS int* tkl = tot + 256; LAS int* ptot = tot + 512; LAS int* ppre = ptot + 512;
    for (int blk = blockIdx.x; blk < 256; blk += gridDim.x) {
        const int r0 = 32 * blk;
        { const int e = F.tid & 31, wq = F.tid >> 5; int t = 0, p = 0;
#pragma unroll
          for (int i = 0; i < 16; ++i) { const int w = wq + 16 * i; const int v = F.cnt[w * 32 + e]; p += (w < blk) ? v : 0; t += v; }
          ptot[wq * 32 + e] = t; ppre[wq * 32 + e] = p; }
        if (F.tid < 128) tkl[F.tid] = F.tke[(size_t)r0 * 4 + F.tid];
        LDS_WAIT(); __syncthreads();
        if (F.tid < 32) { int t = 0, p = 0;
#pragma unroll
            for (int i = 0; i < 16; ++i) { t += ptot[i * 32 + F.tid]; p += ppre[i * 32 + F.tid]; }
            tot[F.tid] = t; pre[F.tid] = p; }
        LDS_WAIT(); __syncthreads();
        if (F.tid < 32) { int accp = 0; for (int e = 0; e < F.tid; ++e) accp += ((tot[e] + 255) >> 8) << 8; base[F.tid] = accp; }
        if (blk == 0 && F.tid == 64) { int nt = 0;
            for (int e = 0; e < 32; ++e) { const int tiles = (tot[e] + 255) >> 8; for (int j = 0; j < tiles; ++j) F.tile[nt + j] = e; nt += tiles; }
            F.tile[255] = nt; }
        LDS_WAIT(); __syncthreads();
        if (F.tid < 128) { const int e = tkl[F.tid]; int q = 0; for (int j = 0; j < F.tid; ++j) q += (tkl[j] == e) ? 1 : 0;
            const int p = base[e] + pre[e] + q; posl[F.tid] = p; F.pos[(size_t)r0 * 4 + F.tid] = p; }
        LDS_WAIT(); __syncthreads();
        for (int j = F.wave; j < 128; j += 8) {
            const v4u* src = (const v4u*)(F.hn2 + (size_t)(r0 + (j >> 2)) * D) + F.lane; v4u* dst = (v4u*)(F.xs + (size_t)posl[j] * D) + F.lane;
            const v4u a = src[0], b = src[64], c = src[128], d = src[192];
            dst[0] = a; dst[64] = b; dst[128] = c; dst[192] = d;
        }
        __syncthreads();
    }
}
DI void p11_final(Frame& F) {
    const int lane = F.lane;
    for (int rr = F.gw; rr < SEQ; rr += F.ngw) {
        const int* pp = F.pos + (size_t)rr * 4; const f32x4 gt = *(const f32x4*)(F.tkg + (size_t)rr * 4);
        const float gk[4] = {gt.x, gt.y, gt.z, gt.w};
        const f32x4* xr = (const f32x4*)(F.h2 + (size_t)rr * D) + lane;
        f32x4 v[8];
#pragma unroll
        for (int j = 0; j < 8; ++j) v[j] = xr[64 * j];
#pragma unroll
        for (int k = 0; k < 4; ++k) { const v2u* orow = (const v2u*)(F.obuf + (size_t)pp[k] * D) + lane;
#pragma unroll
            for (int j = 0; j < 8; ++j) { const v2u w = orow[64 * j]; v[j].x += gk[k] * bf_lo(w.x); v[j].y += gk[k] * bf_hi(w.x); v[j].z += gk[k] * bf_lo(w.y); v[j].w += gk[k] * bf_hi(w.y); } }
        float s = 0.f;
#pragma unroll
        for (int j = 0; j < 8; ++j) s += (v[j].x * v[j].x + v[j].y * v[j].y) + (v[j].z * v[j].z + v[j].w * v[j].w);
        const float rstd = rsqrtf(wave_sum(s) * (1.f / D) + EPS);
        const f32x4* gr = (const f32x4*)F.final_g + lane; f32x4* op = (f32x4*)(F.out + (size_t)rr * D) + lane;
#pragma unroll
        for (int j = 0; j < 8; ++j) { const f32x4 g = gr[64 * j]; op[64 * j] = (f32x4){v[j].x * rstd * g.x, v[j].y * rstd * g.y, v[j].z * rstd * g.z, v[j].w * rstd * g.w}; }
    }
}

using pg8::Unit; using pg8::HALF; using pg8::BM;
struct EpiProj {
    static constexpr bool PERM = true, AFTER_DRAIN = false;
    bf16* O;
    DI void operator()(const f32x4 (&acc)[2][2][4][2], const Unit& u, int wr, int wc, int fr, int fq) const {
        const int row0 = u.pm * BM + wr * 64 + fr, col0 = u.pn * BM + wc * 32 + 8 * fq;
#pragma unroll
        for (int ai = 0; ai < 2; ++ai)
#pragma unroll
            for (int m = 0; m < 4; ++m) { bf16* rowp = O + (size_t)(row0 + ai * HALF + m * 16) * NPROJ + col0;
#pragma unroll
                for (int bj = 0; bj < 2; ++bj) { const f32x4 v0 = acc[ai][bj][m][0], v1 = acc[ai][bj][m][1];
                    v4u w; w.x = pk2(v0[0], v0[1]); w.y = pk2(v0[2], v0[3]); w.z = pk2(v1[0], v1[1]); w.w = pk2(v1[2], v1[3]);
                    *(v4u*)(rowp + bj * HALF) = w; } }
    }
};
struct EpiH2 {
    static constexpr bool PERM = false, AFTER_DRAIN = false;
    const float* X; float* H;
    DI void operator()(const f32x4 (&acc)[2][2][4][2], const Unit& u, int wr, int wc, int fr, int fq) const {
        const int row0 = u.pm * BM + wr * 64 + fr, col0 = u.pn * BM + wc * 32 + 4 * fq;
#pragma unroll
        for (int ai = 0; ai < 2; ++ai)
#pragma unroll
            for (int m = 0; m < 4; ++m) { const size_t off = (size_t)(row0 + ai * HALF + m * 16) * D + col0;
#pragma unroll
                for (int bj = 0; bj < 2; ++bj)
#pragma unroll
                    for (int n = 0; n < 2; ++n) { const f32x4 xv = *(const f32x4*)(X + off + bj * HALF + n * 16); *(f32x4*)(H + off + bj * HALF + n * 16) = xv + acc[ai][bj][m][n]; } }
    }
};
DI float swiglu(float g, float u) {
    g = fminf(g, 7.f); u = fminf(fmaxf(u, -7.f), 7.f);
    return (u + 1.f) * g * __builtin_amdgcn_rcpf(1.f + __expf(-1.702f * g));
}
struct EpiGU {
    static constexpr bool PERM = true, AFTER_DRAIN = false;
    bf16* O; const float* bgate; const float* bup;
    DI void operator()(const f32x4 (&acc)[2][2][4][2], const Unit& u, int wr, int wc, int fr, int fq) const {
        const int e = u.pn >> 4, pnl = u.pn & 15;
        const int row0 = u.pm * BM + wr * 64 + fr, colb = 128 * pnl + wc * 32 + 8 * fq;
        f32x4 bg[2], bu[2];
#pragma unroll
        for (int n = 0; n < 2; ++n) { bg[n] = *(const f32x4*)(bgate + e * D + colb + 4 * n); bu[n] = *(const f32x4*)(bup + e * D + colb + 4 * n); }
#pragma unroll
        for (int ai = 0; ai < 2; ++ai)
#pragma unroll
            for (int m = 0; m < 4; ++m) { bf16* rowp = O + (size_t)(row0 + ai * HALF + m * 16) * D + colb;
                const f32x4 g0 = acc[ai][0][m][0] + bg[0], g1 = acc[ai][0][m][1] + bg[1], u0 = acc[ai][1][m][0] + bu[0], u1 = acc[ai][1][m][1] + bu[1];
                v4u w; w.x = pk2(swiglu(g0[0], u0[0]), swiglu(g0[1], u0[1])); w.y = pk2(swiglu(g0[2], u0[2]), swiglu(g0[3], u0[3]));
                w.z = pk2(swiglu(g1[0], u1[0]), swiglu(g1[1], u1[1])); w.w = pk2(swiglu(g1[2], u1[2]), swiglu(g1[3], u1[3]));
                *(v4u*)rowp = w; }
    }
};
struct EpiDown {
    static constexpr bool PERM = true, AFTER_DRAIN = false;
    bf16* O; const float* bias;
    DI void operator()(const f32x4 (&acc)[2][2][4][2], const Unit& u, int wr, int wc, int fr, int fq) const {
        const int e = u.pn >> 3, pnl = u.pn & 7;
        const int row0 = u.pm * BM + wr * 64 + fr, col0 = 256 * pnl + wc * 32 + 8 * fq;
        f32x4 bv[2][2];
#pragma unroll
        for (int bj = 0; bj < 2; ++bj)
#pragma unroll
            for (int n = 0; n < 2; ++n) bv[bj][n] = *(const f32x4*)(bias + e * D + col0 + bj * HALF + 4 * n);
#pragma unroll
        for (int ai = 0; ai < 2; ++ai)
#pragma unroll
            for (int m = 0; m < 4; ++m) { bf16* rowp = O + (size_t)(row0 + ai * HALF + m * 16) * D + col0;
#pragma unroll
                for (int bj = 0; bj < 2; ++bj) { const f32x4 v0 = acc[ai][bj][m][0] + bv[bj][0], v1 = acc[ai][bj][m][1] + bv[bj][1];
                    v4u w; w.x = pk2(v0[0], v0[1]); w.y = pk2(v0[2], v0[3]); w.z = pk2(v1[0], v1[1]); w.w = pk2(v1[2], v1[3]);
                    *(v4u*)(rowp + bj * HALF) = w; } }
    }
};
struct MoeOrder {
    const int* tile_e; int nM, nN, nwg, G, c;
    DI void init(const int* te, int ntiles, int nN_, int G_, int c_) { tile_e = te; nM = ntiles; nN = nN_; nwg = nM * nN; G = G_; c = c_; }
    DI bool next(int i, Unit& u) const {
        const long L = (long)i * G + c; if (L >= nwg) return false;
        int wgid = (int)L; { const int q = nwg / pg8::NXCD, r = nwg % pg8::NXCD, xcd = wgid % pg8::NXCD, off = wgid / pg8::NXCD; wgid = (xcd < r ? xcd * (q + 1) : r * (q + 1) + (xcd - r) * q) + off; }
        const int nig = pg8::WGM * nN, gid = wgid / nig, fm = gid * pg8::WGM, gsz = (nM - fm) < pg8::WGM ? (nM - fm) : pg8::WGM;
        u.pm = fm + ((wgid % nig) % gsz); const int pnl = (wgid % nig) / gsz;
        u.pn = __builtin_amdgcn_readfirstlane(tile_e[u.pm]) * nN + pnl; return true;
    }
    DI void a_ready(const Unit&) const {}
    DI void done(const Unit&) const {}
};

struct Args { const float* in[23]; float* out; unsigned char* ws; int ph_lo, ph_hi; };
__global__ void __launch_bounds__(NWAVES * 64, 2) fwd(Args args) {
    extern __shared__ __attribute__((aligned(16))) unsigned char lds_raw[];
    Frame F;
    F.lds = (LAS unsigned char*)lds_raw;
    F.tid = threadIdx.x; F.lane = F.tid & 63; F.wave = __builtin_amdgcn_readfirstlane(F.tid >> 6);
    F.gw = blockIdx.x * NWAVES + F.wave; F.ngw = gridDim.x * NWAVES;
    unsigned char* ws = args.ws;
    F.x = args.in[0]; F.meta = args.in[1]; F.g1 = args.in[2]; F.w_in = args.in[3]; F.pool_w = args.in[4]; F.pool_scale = args.in[5]; F.conv_w = args.in[6]; F.conv_b = args.in[7];
    F.dt_bias = args.in[8]; F.a_log = args.in[9]; F.d_skip = args.in[10]; F.ssm_g = args.in[11]; F.w_out = args.in[12]; F.g2 = args.in[13]; F.router_w = args.in[14]; F.router_b = args.in[15];
    F.w_gate = args.in[16]; F.b_gate = args.in[17]; F.w_up = args.in[18]; F.b_up = args.in[19]; F.w_down = args.in[20]; F.b_down = args.in[21]; F.final_g = args.in[22];
    F.out = args.out;
    F.hn = (bf16*)(ws + WS_HN); F.Bt1 = (bf16*)(ws + WS_BT1); F.Bt2 = (bf16*)(ws + WS_BT2); F.proj = (bf16*)(ws + WS_PROJ); F.xT = (bf16*)(ws + WS_XT); F.BT = (bf16*)(ws + WS_BTT);
    F.Bc = (bf16*)(ws + WS_BC); F.Cc = (bf16*)(ws + WS_CC); F.prev = (bf16*)(ws + WS_PREV); F.ycat = (bf16*)(ws + WS_YCAT); F.hn2 = (bf16*)(ws + WS_HN2); F.xs = (bf16*)(ws + WS_XS);
    F.abuf = (bf16*)(ws + WS_A); F.obuf = (bf16*)(ws + WS_XS); F.Btgu = (bf16*)(ws + WS_BTGU); F.Btd = (bf16*)(ws + WS_BTD);
    F.dtv = (float*)(ws + WS_DT); F.states = (float*)(ws + WS_ST); F.decay = (float*)(ws + WS_DEC); F.h2 = (float*)(ws + WS_H2); F.Wr = (float*)(ws + WS_WR); F.tkg = (float*)(ws + WS_TKG);
    F.tke = (int*)(ws + WS_TKE); F.pos = (int*)(ws + WS_POS); F.cnt = (int*)(ws + WS_CNT); F.tile = (int*)(ws + WS_TILE);

    volatile LAS unsigned* MISC = (volatile LAS unsigned*)(F.lds + MISC_OFF);
    if (F.tid < 32) MISC[F.tid] = 0u;
    __syncthreads();
    const int lo = args.ph_lo, hi = args.ph_hi;
    XcdBarrier bar; bar.bar = (unsigned*)(ws + WS_CTL) + CW_BAR; bar.x = 0; bar.st = nullptr;
    if (hi - lo > 1) bar = xcd_barrier_post((unsigned*)(ws + WS_CTL) + CW_BAR, MISC + 8);
#define IN(k) (lo <= (k) && (k) < hi)
#define SEAM(k) do { if (IN(k) && IN((k) + 1)) xcd_barrier(bar); } while (0)

    if (IN(0)) { p0_norm(F); p0_weff(F); p0_router_fold(F); p0_weights(F); __syncthreads(); }
    SEAM(0);
    if (IN(1)) { pg8::Gemm g{F.hn, F.Bt1, MP, NPROJ, D}; pg8::StaticOrder S; S.init(MP, NPROJ, (int)gridDim.x, (int)blockIdx.x);
        EpiProj E{F.proj}; pg8::gemm_phase<EpiProj, pg8::StaticOrder, true, true>(F.lds, g, S, E); }
    SEAM(1);
    if (IN(2)) { p2_elem(F); }
    SEAM(2);
    if (IN(3)) { p3_states(F); }
    SEAM(3);
    if (IN(4)) { p4_scan(F); }
    SEAM(4);
    if (IN(5)) { p5_out(F); }
    SEAM(5);
    if (IN(6)) { pg8::Gemm g{F.ycat, F.Bt2, SEQ, D, D}; pg8::StaticOrder S; S.init(SEQ, D, (int)gridDim.x, (int)blockIdx.x);
        EpiH2 E{F.x, F.h2}; pg8::gemm_phase<EpiH2, pg8::StaticOrder, true, true>(F.lds, g, S, E); }
    SEAM(6);
    if (IN(7)) { p7_router(F); }
    SEAM(7);
    if (IN(8)) { p8_route(F); }
    SEAM(8);
    if (IN(9)) { const int ntiles = __builtin_amdgcn_readfirstlane(F.tile[255]);
        pg8::Gemm g{F.xs, F.Btgu, RPAD, NE * 4096, D}; MoeOrder S; S.init(F.tile, ntiles, 16, (int)gridDim.x, (int)blockIdx.x);
        EpiGU E{F.abuf, F.b_gate, F.b_up}; pg8::gemm_phase<EpiGU, MoeOrder, true, true>(F.lds, g, S, E); }
    SEAM(9);
    if (IN(10)) { const int ntiles = __builtin_amdgcn_readfirstlane(F.tile[255]);
        pg8::Gemm g{F.abuf, F.Btd, RPAD, NE * D, D}; MoeOrder S; S.init(F.tile, ntiles, 8, (int)gridDim.x, (int)blockIdx.x);
        EpiDown E{F.obuf, F.b_down}; pg8::gemm_phase<EpiDown, MoeOrder, true, true>(F.lds, g, S, E); }
    SEAM(10);
    if (IN(11)) { p11_final(F); }
#undef IN
#undef SEAM
}

extern "C" void kernel_launch(void* const* d_in, const int* in_sizes, int n_in, void* d_out, int out_size, void* d_ws, size_t ws_size, hipStream_t stream) {
    static int grid = 0;
    if (grid == 0) {
        if (n_in != 23 || out_size != SEQ * D || ws_size < WS_END) { fprintf(stderr, "kernel_launch: unexpected shapes (n_in %d out %d ws %zu need %zu)\n", n_in, out_size, ws_size, (size_t)WS_END); grid = -1; return; }
        int dev = 0, cus = 0, per_cu = 0;
        if (hipGetDevice(&dev) != hipSuccess || hipDeviceGetAttribute(&cus, hipDeviceAttributeMultiprocessorCount, dev) != hipSuccess) { grid = -1; return; }
        if (hipFuncSetAttribute((const void*)fwd, hipFuncAttributeMaxDynamicSharedMemorySize, LDS_BYTES) != hipSuccess) { fprintf(stderr, "kernel_launch: hipFuncSetAttribute failed\n"); grid = -1; return; }
        if (hipOccupancyMaxActiveBlocksPerMultiprocessor(&per_cu, (const void*)fwd, NWAVES * 64, LDS_BYTES) != hipSuccess || per_cu < 1) fprintf(stderr, "kernel_launch: occupancy query says %d\n", per_cu);
        (void)hipGetLastError();
        grid = cus > 256 ? 256 : cus;
    }
    if (grid < 0) return;
    Args a{};
    for (int i = 0; i < 23; ++i) a.in[i] = (const float*)d_in[i];
    a.out = (float*)d_out; a.ws = (unsigned char*)d_ws;
#if MK_ONE_LAUNCH
    hipMemsetAsync((char*)d_ws + WS_CTL, 0, CTL_BYTES, stream);
    a.ph_lo = 0; a.ph_hi = NPH;
    hipLaunchKernelGGL(fwd, dim3(grid), dim3(NWAVES * 64), LDS_BYTES, stream, a);
#else
    for (int p = 0; p < NPH; ++p) { a.ph_lo = p; a.ph_hi = p + 1; hipLaunchKernelGGL(fwd, dim3(grid), dim3(NWAVES * 64), LDS_BYTES, stream, a); }
#endif
}
```

```cpp
#include <hip/hip_runtime.h>
#include <cstdio>
#include <cstdint>
namespace pg8 {
#define PG8_LAS __attribute__((address_space(3)))
typedef unsigned short bf16_t;
typedef short bf16x8 __attribute__((ext_vector_type(8)));
typedef float f32x4 __attribute__((ext_vector_type(4)));
typedef unsigned u32x4 __attribute__((ext_vector_type(4)));
typedef int i32x8 __attribute__((ext_vector_type(8)));
constexpr int BM = 256, BK = 64, HALF = 128, HTB = HALF * BK * 2  , STAGE_BYTES = 8 * HTB, NXCD = 8, WGM = 8;

__host__ __device__ __forceinline__ int lds_byte(int r, int c) { const int st = (r >> 4) * 2 + (c >> 5), rr = r & 15, cc = c & 31, ob = rr * 64 + cc * 2; return st * 1024 + (ob ^ (((ob >> 9) & 1) << 5)); }
__host__ __device__ __forceinline__ void stage_rc(int b, int& R, int& C) { const int st = b / 1024, sb = b % 1024, swz = sb ^ (((sb >> 9) & 1) << 5); R = (st >> 1) * 16 + swz / 64; C = (st & 1) * 32 + (swz % 64) / 2; }
__host__ __device__ __forceinline__ int perm32(int rho) { const int n = rho >> 4, i = rho & 15; return 8 * (i >> 2) + 4 * n + (i & 3); }

struct Unit { int pm, pn; };
struct Gemm { const bf16_t* A; const bf16_t* Bt; int M, N, K; };

struct StaticOrder {
    int nM, nN, nwg, G, c;
    __host__ __device__ void init(int M, int N, int G_, int c_) { nM = M / BM; nN = N / BM; nwg = nM * nN; G = G_; c = c_; }
    __host__ __device__ bool next(int i, Unit& u) const {
        const long L = (long)i * G + c; if (L >= nwg) return false;
        int wgid = (int)L; { const int q = nwg / NXCD, r = nwg % NXCD, xcd = wgid % NXCD, off = wgid / NXCD; wgid = (xcd < r ? xcd * (q + 1) : r * (q + 1) + (xcd - r) * q) + off; }
        const int nig = WGM * nN, gid = wgid / nig, fm = gid * WGM, gsz = (nM - fm) < WGM ? (nM - fm) : WGM;
        u.pm = fm + ((wgid % nig) % gsz); u.pn = (wgid % nig) / gsz; return true;
    }
    __device__ __forceinline__ void a_ready(const Unit&) const {}
    __device__ __forceinline__ void done(const Unit&) const {}
};

__device__ __forceinline__ unsigned cvt_pk_bf16(float lo, float hi) { unsigned r; asm volatile("v_cvt_pk_bf16_f32 %0, %1, %2" : "=v"(r) : "v"(lo), "v"(hi)); return r; }
template <class Epi, class Sched, bool ALIGN_EPI = false, bool SP2 = false, bool F8 = false, bool GATHER = false>
__device__ __forceinline__ void gemm_phase(PG8_LAS unsigned char* lds, const Gemm g, const Sched& S, const Epi& E) {
    const int tid = threadIdx.x, wid = __builtin_amdgcn_readfirstlane(tid >> 6), lane = tid & 63, wr = wid >> 2, wc = wid & 3, fr = lane & 15, fq = lane >> 4;
    const int KB = F8 ? g.K : 2 * g.K  , nt = KB / 128;
    static_assert(!GATHER || (F8 && SP2), "the gather path exists in the fp8 two-super-phase loop only");
    unsigned voffA[2], voffB[2]; int gR[2]; unsigned gC[2];
    unsigned gA0[2], gA1[2], gN0[2], gN1[2]; int gT[4];
#pragma unroll
    for (int i = 0; i < 2; ++i) { int R, C; stage_rc(tid * 16 + i * 8192, R, C); const int Rb = Epi::PERM ? ((R & ~31) + perm32(R & 31)) : R;
        voffA[i] = (unsigned)(R * KB + C * 2); voffB[i] = (unsigned)(Rb * KB + C * 2); gR[i] = R; gC[i] = (unsigned)(C * 2); }
    const size_t kstep = (size_t)(BK * 2);
    const size_t hstep = (size_t)HALF * KB;
    const size_t tstep = 2 * hstep;
    const unsigned ldsw = (unsigned)wid * 1024u;
    const int aoff = lds_byte(wr * 64 + fr, fq * 8), boff = lds_byte(wc * 32 + fr, fq * 8);

#define PG8_SA(b, h) (((b) * 2 + (h)) * HTB)
#define PG8_SB(b, h) ((4 + (b) * 2 + (h)) * HTB)
#define PG8_STAGE(bufoff, gbase, voff) do { if constexpr (F8) { const char* gb_ = (const char*)(gbase); _Pragma("unroll") for (int _i = 0; _i < 2; ++_i) { \
        const unsigned la_ = (unsigned)(size_t)(lds + (bufoff) + ldsw + _i * 8192); \
        asm volatile("s_mov_b32 m0, %2\n\ts_nop 4\n\tglobal_load_lds_dwordx4 %0, %1" :: "v"((voff)[_i]), "s"(gb_), "s"(la_) : "memory", "m0"); } } else { \
        _Pragma("unroll") for (int _i = 0; _i < 2; ++_i) \
        __builtin_amdgcn_global_load_lds((const unsigned*)((const char*)(gbase) + (voff)[_i]), (PG8_LAS unsigned*)(lds + (bufoff) + ldsw + _i * 8192), 16, 0, 0); } } while (0)
#define PG8_STAGE_A(bufoff, base, h, useN) do { if constexpr (GATHER) { unsigned v_[2]; \
        v_[0] = (useN) ? ((h) ? gN1[0] : gN0[0]) : ((h) ? gA1[0] : gA0[0]); v_[1] = (useN) ? ((h) ? gN1[1] : gN0[1]) : ((h) ? gA1[1] : gA0[1]); PG8_STAGE(bufoff, base, v_); } \
        else { PG8_STAGE(bufoff, (base) + (h) * hstep, voffA); } } while (0)
#define PG8_GROWS_ISSUE(u) do { const int* rt_ = S.rowtok + (size_t)(u).pm * 256; \
        asm volatile("global_load_dword %0, %1, off" : "=v"(gT[0]) : "v"(rt_ + gR[0]) : "memory"); asm volatile("global_load_dword %0, %1, off" : "=v"(gT[1]) : "v"(rt_ + gR[1]) : "memory"); \
        asm volatile("global_load_dword %0, %1, off" : "=v"(gT[2]) : "v"(rt_ + 128 + gR[0]) : "memory"); asm volatile("global_load_dword %0, %1, off" : "=v"(gT[3]) : "v"(rt_ + 128 + gR[1]) : "memory"); } while (0)
#define PG8_GROWS_USE(d0, d1) do { asm volatile("" : "+v"(gT[0]), "+v"(gT[1]), "+v"(gT[2]), "+v"(gT[3])); \
        d0[0] = (unsigned)gT[0] * (unsigned)KB + gC[0]; d0[1] = (unsigned)gT[1] * (unsigned)KB + gC[1]; d1[0] = (unsigned)gT[2] * (unsigned)KB + gC[0]; d1[1] = (unsigned)gT[3] * (unsigned)KB + gC[1]; } while (0)
#define PG8_LDA(dst, b, h) do { if constexpr (F8) { _Pragma("unroll") for (int m = 0; m < 4; ++m) dst##8[m] = __builtin_bit_cast(i32x8, __builtin_shufflevector(*(const PG8_LAS bf16x8*)(lds + PG8_SA(b, h) + aoff + m * 2048), *(const PG8_LAS bf16x8*)(lds + PG8_SA(b, h) + aoff + m * 2048 + 1024), 0, 1, 2, 3, 4, 5, 6, 7, 8, 9, 10, 11, 12, 13, 14, 15)); } else { \
        _Pragma("unroll") for (int m = 0; m < 4; ++m) _Pragma("unroll") for (int k = 0; k < 2; ++k) dst[m][k] = *(const PG8_LAS bf16x8*)(lds + PG8_SA(b, h) + aoff + m * 2048 + k * 1024); } } while (0)
#define PG8_LDB(dst, b, h) do { if constexpr (F8) { _Pragma("unroll") for (int n = 0; n < 2; ++n) dst##8[n] = __builtin_bit_cast(i32x8, __builtin_shufflevector(*(const PG8_LAS bf16x8*)(lds + PG8_SB(b, h) + boff + n * 2048), *(const PG8_LAS bf16x8*)(lds + PG8_SB(b, h) + boff + n * 2048 + 1024), 0, 1, 2, 3, 4, 5, 6, 7, 8, 9, 10, 11, 12, 13, 14, 15)); } else { \
        _Pragma("unroll") for (int n = 0; n < 2; ++n) _Pragma("unroll") for (int k = 0; k < 2; ++k) dst[n][k] = *(const PG8_LAS bf16x8*)(lds + PG8_SB(b, h) + boff + n * 2048 + k * 1024); } } while (0)
#define PG8_MMA(ai, bj, At, Bt) do { __builtin_amdgcn_s_setprio(1); if constexpr (F8) { _Pragma("unroll") for (int m = 0; m < 4; ++m) _Pragma("unroll") for (int n = 0; n < 2; ++n) \
        asm volatile("v_mfma_scale_f32_16x16x128_f8f6f4 %0, %1, %2, %0, %3, %3 op_sel_hi:[0,0,0]" : "+v"(acc[ai][bj][m][n]) : "v"(Bt##8[n]), "v"(At##8[m]), "v"(f8scale)); } else {     \
        _Pragma("unroll") for (int m = 0; m < 4; ++m) _Pragma("unroll") for (int n = 0; n < 2; ++n) _Pragma("unroll") for (int k = 0; k < 2; ++k) \
        acc[ai][bj][m][n] = __builtin_amdgcn_mfma_f32_16x16x32_bf16(Bt[n][k], At[m][k], acc[ai][bj][m][n], 0, 0, 0); } __builtin_amdgcn_s_setprio(0); } while (0)
#define PG8_WAIT_V(n) asm volatile("s_waitcnt vmcnt(" #n ")" ::: "memory")
#define PG8_WAIT_L(n) asm volatile("s_waitcnt lgkmcnt(" #n ")" ::: "memory")
#define PG8_BAR __builtin_amdgcn_s_barrier()
#define PG8_SCHED __builtin_amdgcn_sched_barrier(0)
    Unit cur, nxt; int ui = 0;
    if (!S.next(0, cur)) return;
    f32x4 acc[2][2][4][2];
#pragma unroll
    for (int a = 0; a < 2; ++a)
#pragma unroll
        for (int b = 0; b < 2; ++b)
#pragma unroll
            for (int m = 0; m < 4; ++m)
#pragma unroll
                for (int n = 0; n < 2; ++n) acc[a][b][m][n] = (f32x4){0.f, 0.f, 0.f, 0.f};
    const int f8scale = 0x7f7f7f7f;
    bf16x8 At[4][2], B0[2][2], B1[2][2]; i32x8 At8[4], B08[2], B18[2];
    const char* cA = GATHER ? (const char*)g.A : (const char*)g.A + (size_t)cur.pm * tstep; const char* cB = (const char*)g.Bt + (size_t)cur.pn * tstep;
    S.a_ready(cur);
    if constexpr (GATHER) { PG8_GROWS_ISSUE(cur); asm volatile("s_waitcnt vmcnt(0)" ::: "memory"); PG8_GROWS_USE(gA0, gA1); }
    if constexpr (SP2) {
        PG8_STAGE(PG8_SB(0, 0), cB, voffB); PG8_STAGE(PG8_SB(0, 1), cB + hstep, voffB); PG8_STAGE_A(PG8_SA(0, 0), cA, 0, false); PG8_STAGE_A(PG8_SA(0, 1), cA, 1, false);
        if (wr == 1) PG8_BAR;
        PG8_WAIT_V(2); PG8_BAR;
        PG8_STAGE(PG8_SB(1, 0), cB + kstep, voffB); PG8_STAGE_A(PG8_SA(1, 0), cA + kstep, 0, false); PG8_STAGE(PG8_SB(1, 1), cB + hstep + kstep, voffB);
        PG8_WAIT_V(6); PG8_BAR;
    } else {
        PG8_STAGE(PG8_SB(0, 0), cB, voffB); PG8_STAGE(PG8_SA(0, 0), cA, voffA); PG8_STAGE(PG8_SB(0, 1), cB + hstep, voffB); PG8_STAGE(PG8_SA(0, 1), cA + hstep, voffA);
        if (wr == 1) PG8_BAR;
        PG8_WAIT_V(4); PG8_BAR;
        PG8_STAGE(PG8_SB(1, 0), cB + kstep, voffB); PG8_STAGE(PG8_SA(1, 0), cA + kstep, voffA); PG8_STAGE(PG8_SB(1, 1), cB + hstep + kstep, voffB);
        PG8_WAIT_V(6); PG8_BAR;
    }
    for (;;) {
        const bool has_next = S.next(ui + 1, nxt);
        const char* nA = GATHER ? (const char*)g.A : (has_next ? (const char*)g.A + (size_t)nxt.pm * tstep : cA); const char* nB = has_next ? (const char*)g.Bt + (size_t)nxt.pn * tstep : cB;
        if constexpr (GATHER) { if (has_next) PG8_GROWS_ISSUE(nxt); }
        for (int t = 0; t < nt; t += 2) {
            const bool last = (t == nt - 2);
            const char* a1 = cA + (size_t)(t + 1) * kstep;
            const char* a2 = last ? nA : cA + (size_t)(t + 2) * kstep; const char* b2 = last ? nB : cB + (size_t)(t + 2) * kstep;
            const char* a3 = a2 + kstep; const char* b3 = b2 + kstep;
            if (last && has_next) S.a_ready(nxt);
            if constexpr (SP2) {
            PG8_LDB(B0, 0, 0); PG8_LDB(B1, 0, 1); PG8_SCHED; PG8_LDA(At, 0, 0); PG8_STAGE_A(PG8_SA(1, 1), a1, 1, false);
            PG8_WAIT_V(8); PG8_WAIT_L(0);
            if constexpr (GATHER) { if (last) { if (has_next) PG8_GROWS_USE(gN0, gN1); else { gN0[0] = gA0[0]; gN0[1] = gA0[1]; gN1[0] = gA1[0]; gN1[1] = gA1[1]; } } }
            PG8_BAR; PG8_MMA(0, 0, At, B0); PG8_MMA(0, 1, At, B1); PG8_BAR; PG8_SCHED;
            PG8_LDA(At, 0, 1); PG8_STAGE(PG8_SB(0, 0), b2, voffB); PG8_STAGE(PG8_SB(0, 1), b2 + hstep, voffB); PG8_STAGE_A(PG8_SA(0, 0), a2, 0, last);
            PG8_WAIT_V(8); PG8_WAIT_L(0); PG8_BAR; PG8_MMA(1, 0, At, B0); PG8_MMA(1, 1, At, B1); PG8_BAR; PG8_SCHED;
            PG8_LDB(B0, 1, 0); PG8_LDB(B1, 1, 1); PG8_SCHED; PG8_LDA(At, 1, 0); PG8_STAGE_A(PG8_SA(0, 1), a2, 1, last);
            PG8_WAIT_V(8); PG8_WAIT_L(0); PG8_BAR; PG8_MMA(0, 0, At, B0); PG8_MMA(0, 1, At, B1); PG8_BAR; PG8_SCHED;
            PG8_LDA(At, 1, 1); PG8_STAGE(PG8_SB(1, 0), b3, voffB); PG8_STAGE(PG8_SB(1, 1), b3 + hstep, voffB); PG8_STAGE_A(PG8_SA(1, 0), a3, 0, last);
            PG8_WAIT_V(8); PG8_WAIT_L(0); PG8_BAR; PG8_MMA(1, 0, At, B0); PG8_MMA(1, 1, At, B1); PG8_BAR; PG8_SCHED;
            } else {
            PG8_LDB(B0, 0, 0); PG8_SCHED; PG8_LDA(At, 0, 0); PG8_STAGE(PG8_SA(1, 1), a1 + hstep, voffA);
            PG8_WAIT_L(8); PG8_BAR; PG8_WAIT_L(0); PG8_MMA(0, 0, At, B0); PG8_BAR; PG8_SCHED;
            PG8_LDB(B1, 0, 1); PG8_STAGE(PG8_SB(0, 0), b2, voffB);
            PG8_BAR; PG8_WAIT_L(0); PG8_MMA(0, 1, At, B1); PG8_BAR;
            PG8_LDA(At, 0, 1); PG8_STAGE(PG8_SA(0, 0), a2, voffA);
            PG8_BAR; PG8_WAIT_L(0); PG8_MMA(1, 0, At, B0); PG8_BAR; PG8_SCHED;
            PG8_STAGE(PG8_SB(0, 1), b2 + hstep, voffB);
            PG8_WAIT_V(6); PG8_BAR; PG8_MMA(1, 1, At, B1); PG8_BAR;
            PG8_LDB(B0, 1, 0); PG8_SCHED; PG8_LDA(At, 1, 0); PG8_STAGE(PG8_SA(0, 1), a2 + hstep, voffA);
            PG8_WAIT_L(8); PG8_BAR; PG8_WAIT_L(0); PG8_MMA(0, 0, At, B0); PG8_BAR; PG8_SCHED;
            PG8_LDB(B1, 1, 1); PG8_STAGE(PG8_SB(1, 0), b3, voffB);
            PG8_BAR; PG8_WAIT_L(0); PG8_MMA(0, 1, At, B1); PG8_BAR;
            PG8_LDA(At, 1, 1); PG8_STAGE(PG8_SA(1, 0), a3, voffA);
            PG8_BAR; PG8_WAIT_L(0); PG8_MMA(1, 0, At, B0); PG8_BAR; PG8_SCHED;
            PG8_STAGE(PG8_SB(1, 1), b3 + hstep, voffB);
            PG8_WAIT_V(6); PG8_BAR; PG8_MMA(1, 1, At, B1); PG8_BAR;
            }
        }
        if constexpr (ALIGN_EPI) { if (wr == 0) PG8_BAR; }
        if constexpr (F8) asm volatile("s_nop 15\n\ts_nop 7" ::: "memory");
        if constexpr (!Epi::AFTER_DRAIN) {
            int tz_ = threadIdx.x; asm volatile("" : "+v"(tz_)); const int l_ = tz_ & 63, w_ = __builtin_amdgcn_readfirstlane(tz_ >> 6);
            E(acc, cur, w_ >> 2, w_ & 3, l_ & 15, l_ >> 4); S.done(cur); }
        if (!has_next) break;
#pragma unroll
        for (int a = 0; a < 2; ++a)
#pragma unroll
            for (int b = 0; b < 2; ++b)
#pragma unroll
                for (int m = 0; m < 4; ++m)
#pragma unroll
                    for (int n = 0; n < 2; ++n) acc[a][b][m][n] = (f32x4){0.f, 0.f, 0.f, 0.f};
        cur = nxt; cA = nA; cB = nB; ++ui;
        if constexpr (GATHER) { gA0[0] = gN0[0]; gA0[1] = gN0[1]; gA1[0] = gN1[0]; gA1[1] = gN1[1]; }
        if constexpr (ALIGN_EPI) { if (wr == 1) PG8_BAR; }
    }
    PG8_WAIT_V(0);
    if constexpr (!ALIGN_EPI) { if (wr == 0) PG8_BAR; }
    PG8_BAR;
    if constexpr (Epi::AFTER_DRAIN) { E.fused(acc, cur, wr, wc, fr, fq, lds, wid, lane); S.done(cur); }
#undef PG8_SA
#undef PG8_SB
#undef PG8_STAGE
#undef PG8_STAGE_A
#undef PG8_GROWS_ISSUE
#undef PG8_GROWS_USE
#undef PG8_LDA
#undef PG8_LDB
#undef PG8_MMA
#undef PG8_WAIT_V
#undef PG8_WAIT_L
#undef PG8_BAR
#undef PG8_SCHED
}
}
#define LAS __attribute__((address_space(3)))
#define XB_TMO      128
#define XB_XCNT(j)  (256  + 64 * (j))
#define XB_XSUB(j)  (1280 + 64 * (j))
#define XB_XGEN(j)  (2304 + 64 * (j))
#define XB_TOP      3328
#define XB_TOPGEN   3392
#define XCD_BAR_WORDS 3456
#define XB_SPIN_CAP (1u << 18)

__device__ __forceinline__ unsigned xb_ld(unsigned* p)              { return __hip_atomic_load(p, __ATOMIC_RELAXED, __HIP_MEMORY_SCOPE_AGENT); }
__device__ __forceinline__ unsigned xb_add(unsigned* p, unsigned v) { return __hip_atomic_fetch_add(p, v, __ATOMIC_RELAXED, __HIP_MEMORY_SCOPE_AGENT); }
__device__ __forceinline__ unsigned xb_xcc_id() { return (unsigned)__builtin_amdgcn_s_getreg((3 << 11) | 20) & 0xFu; }
#define XB_SPIN(cond, bar) do { unsigned _sp = 0; while (cond) { __builtin_amdgcn_s_sleep(1); \
    if ((++_sp & 255u) == 0u) { if (xb_ld(&(bar)[XB_TMO])) break; if (_sp > XB_SPIN_CAP) { atomicAdd(&(bar)[XB_TMO], 1u); break; } } } } while (0)

struct XcdBarrier {
    unsigned* bar; unsigned x;
    volatile LAS unsigned* st;
    unsigned G;
};

__device__ __forceinline__ XcdBarrier xcd_barrier_post(unsigned* bar, volatile LAS unsigned* st, unsigned G) {
    XcdBarrier b; b.bar = bar; b.x = xb_xcc_id(); b.st = st; b.G = G;
    if (threadIdx.x == 0) (void)xb_add(&bar[XB_XCNT(b.x)], 1u);
    return b;
}
__device__ __forceinline__ void xcd_barrier_complete(unsigned* bar, unsigned x, unsigned& nloc, unsigned& nx, const unsigned G) {
    unsigned sum, cnt, mine, sp = 0u;
    for (;;) {
        sum = 0u; cnt = 0u; mine = 0u;
#pragma unroll
        for (unsigned j = 0; j < 16; ++j) { const unsigned c = xb_ld(&bar[XB_XCNT(j)]); sum += c; cnt += (c > 0u) ? 1u : 0u; mine = (j == x) ? c : mine; }
        if (sum == G) break;
        __builtin_amdgcn_s_sleep(1);
        if ((++sp & 255u) == 0u) { if (xb_ld(&bar[XB_TMO])) break; if (sp > XB_SPIN_CAP) { atomicAdd(&bar[XB_TMO], 1u); break; } }
    }
    nloc = mine > 0u ? mine : 1u; nx = cnt > 0u ? cnt : 1u;
}

__device__ __forceinline__ void xcd_barrier(const XcdBarrier& b) {
    asm volatile("s_waitcnt vmcnt(0)" ::: "memory");
    __syncthreads();
    if (threadIdx.x == 0) {
        unsigned* bar = b.bar;
        __builtin_amdgcn_s_waitcnt(0);
        unsigned nloc = b.st[0], nx = b.st[1];
        if (nloc == 0u) { xcd_barrier_complete(bar, b.x, nloc, nx, b.G); b.st[0] = nloc; b.st[1] = nx; }
        const unsigned old = xb_add(&bar[XB_XSUB(b.x)], 1u);
        const unsigned gen = old / nloc;
        if (old + 1u == (gen + 1u) * nloc) {
            __builtin_amdgcn_fence(__ATOMIC_RELEASE, "agent");
            asm volatile("s_waitcnt vmcnt(0)" ::: "memory");
            const unsigned og = xb_add(&bar[XB_TOP], 1u);
            const unsigned tg = og / nx;
            if (og + 1u == (tg + 1u) * nx) xb_add(&bar[XB_TOPGEN], 1u);
            else XB_SPIN(xb_ld(&bar[XB_TOPGEN]) == tg, bar);
            __builtin_amdgcn_fence(__ATOMIC_ACQUIRE, "agent");
            xb_add(&bar[XB_XGEN(b.x)], 1u);
            asm volatile("s_waitcnt vmcnt(0)" ::: "memory");
        } else {
            XB_SPIN(xb_ld(&bar[XB_XGEN(b.x)]) == gen, bar);
            __builtin_amdgcn_fence(__ATOMIC_ACQUIRE, "agent");
            asm volatile("s_waitcnt vmcnt(0)" ::: "memory");
        }
    }
    __syncthreads();
}
constexpr int D = 2048, SEQ = 8192, NMETA = 16, LEAD = 48, NP = 8256  , MP = 8448  ;
constexpr int NPROJ = 3840, C_Z = 1024, C_X = 2048, C_B = 3072, C_C = 3328, C_DT = 3584, NINPROJ = 3600;
constexpr int NE = 32, DCONV = 1536;
constexpr int RTILES = 160, RPAD = RTILES * 256;
constexpr float EPS = 1e-5f;
constexpr int NWAVES = 8, NPH = 12;
#ifndef WN_WORKERS
#define WN_WORKERS 136
#endif
constexpr int WN = WN_WORKERS;
#ifndef MOE_F8
#define MOE_F8 1
#endif
#ifndef MOE_RB
#define MOE_RB 0
#endif
#ifndef MK_ONE_LAUNCH
#define MK_ONE_LAUNCH 1
#endif

constexpr size_t WS_CTL = 0, CTL_BYTES = 1u << 20;
constexpr size_t WS_HN = CTL_BYTES;
constexpr size_t WS_BT1 = WS_HN + (size_t)MP * D * 2;
constexpr size_t WS_BT2 = WS_BT1 + (size_t)NPROJ * D * 2;
constexpr size_t WS_PROJ = WS_BT2 + (size_t)D * D * 2;
constexpr size_t WS_XT = WS_PROJ + (size_t)MP * NPROJ * 2;
constexpr size_t WS_BTT = WS_XT + (size_t)1024 * NP * 2;
constexpr size_t WS_BC = WS_BTT + (size_t)256 * NP * 2;
constexpr size_t WS_CC = WS_BC + (size_t)NP * 256 * 2;
constexpr size_t WS_DT = WS_CC + (size_t)NP * 256 * 2;
constexpr size_t WS_ST = WS_DT + (size_t)NP * 16 * 4;
constexpr size_t WS_DEC = WS_ST + (size_t)128 * 131072 * 4;
constexpr size_t WS_PREV = WS_DEC + 128 * 16 * 4;
constexpr size_t WS_YCAT = WS_PREV + (size_t)128 * 131072 * 2;
constexpr size_t WS_H2 = WS_YCAT + (size_t)SEQ * D * 2;
constexpr size_t WS_HN2 = WS_H2 + (size_t)SEQ * D * 4;
constexpr size_t WS_WR = WS_HN2 + (size_t)SEQ * D * 2;
constexpr size_t WS_TKE = WS_WR + (size_t)D * NE * 4;
constexpr size_t WS_TKG = WS_TKE + (size_t)SEQ * 16;
constexpr size_t WS_POS = WS_TKG + (size_t)SEQ * 16;
constexpr size_t WS_CNT = WS_POS + (size_t)SEQ * 16;
constexpr size_t WS_TILE = WS_CNT + 256 * 32 * 4;
constexpr size_t WS_XS = WS_TILE + 1024;
constexpr size_t WS_A = WS_XS + (size_t)RPAD * D * 2;
constexpr size_t WS_O = WS_A + (size_t)RPAD * D * 2;
constexpr size_t WS_BTGU = WS_O + (MOE_F8 ? (size_t)RPAD * D * 2 : 0);
constexpr size_t WS_BTD = WS_BTGU + (size_t)NE * 4096 * D * (MOE_F8 ? 1 : 2);
constexpr size_t WS_END = WS_BTD + (size_t)NE * D * D * (MOE_F8 ? 1 : 2);
constexpr int CW_BAR = 4096, CW_BAR2 = 8192;
static_assert((CW_BAR2 + XCD_BAR_WORDS) * 4 <= (int)CTL_BYTES && CW_BAR + XCD_BAR_WORDS <= CW_BAR2, "ctl");

constexpr int RING_BYTES = 131072, SCR_BYTES = 135168, MISC_OFF = SCR_BYTES, LDS_BYTES = 147456;

#define DI __device__ __forceinline__
typedef unsigned short bf16;
typedef unsigned v4u __attribute__((ext_vector_type(4)));
typedef unsigned v2u __attribute__((ext_vector_type(2)));
typedef float f32x4 __attribute__((ext_vector_type(4)));
typedef float f32x16 __attribute__((ext_vector_type(16)));
typedef short bf16x8 __attribute__((ext_vector_type(8)));
#define LDS_WAIT() asm volatile("s_waitcnt lgkmcnt(0)" ::: "memory")
#define MFMA32(a, b, c) __builtin_amdgcn_mfma_f32_32x32x16_bf16((a), (b), (c), 0, 0, 0)
DI float bf_lo(unsigned w) { return __uint_as_float(w << 16); }
DI float bf_hi(unsigned w) { return __uint_as_float(w & 0xffff0000u); }
DI float bf2f(bf16 v) { return __uint_as_float(((unsigned)v) << 16); }
typedef __bf16 bf2v __attribute__((ext_vector_type(2)));
typedef float f2v __attribute__((ext_vector_type(2)));
DI unsigned pk2(float lo, float hi) { const f2v v = {lo, hi}; const bf2v b = __builtin_convertvector(v, bf2v); return __builtin_bit_cast(unsigned, b); }
DI unsigned pk4_f8(float a, float b, float c, float d) { int p = __builtin_amdgcn_cvt_pk_fp8_f32(a, b, 0, false); p = __builtin_amdgcn_cvt_pk_fp8_f32(c, d, p, true); return (unsigned)p; }
DI bf16 f2bf(float f) { return (bf16)(pk2(f, 0.f) & 0xffffu); }
DI float wave_sum(float v) {
#pragma unroll
    for (int o = 1; o < 64; o <<= 1) v += __shfl_xor(v, o);
    return v;
}
DI float wave_incl_scan(float v, int lane) {
#pragma unroll
    for (int o = 1; o < 64; o <<= 1) { const float t = __shfl_up(v, o); if (lane >= o) v += t; }
    return v;
}
DI float silu_f(float x) { return x * __builtin_amdgcn_rcpf(1.f + __expf(-x)); }

struct Frame {
    LAS unsigned char* lds;
    int tid, lane, wave, gw, ngw, bid, nwg;
    const float *x, *meta, *g1, *w_in, *pool_w, *pool_scale, *conv_w, *conv_b, *dt_bias, *a_log, *d_skip, *ssm_g, *w_out, *g2, *router_w, *router_b,
        *w_gate, *b_gate, *w_up, *b_up, *w_down, *b_down, *final_g;
    float* out;
    bf16 *hn, *Bt1, *Bt2, *proj, *xT, *BT, *Bc, *Cc, *prev, *ycat, *hn2, *xs, *abuf, *obuf, *Btgu, *Btd;
    float *dtv, *decay, *Wr, *tkg; bf16 *states, *h2;
    int *tke, *pos, *cnt, *tile;
};

DI int crow16(int reg, int hf) { return (reg & 3) + 8 * (reg >> 2) + 4 * hf; }
DI void p0_norm(Frame& F) {
    const f32x4* gr = (const f32x4*)F.g1 + F.lane;
    for (int P0 = F.gw; P0 < NP; P0 += 2 * F.ngw) {
        f32x4 v[2][8]; bool live[2];
#pragma unroll
        for (int u = 0; u < 2; ++u) { const int P = P0 + u * F.ngw; live[u] = (P >= LEAD && P < NP);
            const int t = live[u] ? P - LEAD : 0;
            const float* src = t < NMETA ? F.meta + (size_t)t * D : F.x + (size_t)(t - NMETA) * D;
            const f32x4* xr = (const f32x4*)src + F.lane;
#pragma unroll
            for (int j = 0; j < 8; ++j) v[u][j] = xr[64 * j]; }
#pragma unroll
        for (int u = 0; u < 2; ++u) { const int P = P0 + u * F.ngw; if (P >= NP) continue;
            unsigned long long* o8 = (unsigned long long*)(F.hn + (size_t)P * D) + F.lane;
            if (!live[u]) {
#pragma unroll
                for (int j = 0; j < 8; ++j) o8[64 * j] = 0ull;
                continue; }
            float s = 0.f;
#pragma unroll
            for (int j = 0; j < 8; ++j) s += (v[u][j].x * v[u][j].x + v[u][j].y * v[u][j].y) + (v[u][j].z * v[u][j].z + v[u][j].w * v[u][j].w);
            const float rstd = rsqrtf(wave_sum(s) * (1.f / D) + EPS);
#pragma unroll
            for (int j = 0; j < 8; ++j) { const f32x4 g = gr[64 * j];
                o8[64 * j] = (unsigned long long)pk2(v[u][j].x * rstd * g.x, v[u][j].y * rstd * g.y) | ((unsigned long long)pk2(v[u][j].z * rstd * g.z, v[u][j].w * rstd * g.w) << 32); }
        }
    }
}
DI void tr_load(float (&v)[64], const float* W, size_t ldw, int nvalid, int lane) {
    const float* wp = W + lane;
    if (lane < nvalid) {
#pragma unroll
        for (int kk = 0; kk < 64; ++kk) v[kk] = __builtin_nontemporal_load(wp + (size_t)kk * ldw);
    } else {
#pragma unroll
        for (int kk = 0; kk < 64; ++kk) v[kk] = 0.f;
    }
}
DI void tr_store(const float (&v)[64], int nvalid, bf16* WT, size_t ldt, LAS float* scr, int lane) {
#pragma unroll
    for (int kk = 0; kk < 64; ++kk) scr[kk * 65 + lane] = v[kk];
    LDS_WAIT();
    const int c = lane & 7;
#pragma unroll
    for (int j = 0; j < 8; ++j) { const int n = (lane >> 3) + 8 * j; const LAS float* s = scr + (8 * c) * 65 + n;
        v4u o; o.x = pk2(s[0], s[65]); o.y = pk2(s[130], s[195]); o.z = pk2(s[260], s[325]); o.w = pk2(s[390], s[455]);
        if (n < nvalid) *(v4u*)(WT + (size_t)n * ldt + 8 * c) = o; }
    LDS_WAIT();
}
DI void tr_store8(const float (&v)[64], unsigned char* WT, size_t ldt, LAS float* scr, int lane, float scale) {
#pragma unroll
    for (int kk = 0; kk < 64; ++kk) scr[kk * 65 + lane] = v[kk] * scale;
    LDS_WAIT();
    const int c = lane & 3;
#pragma unroll
    for (int j = 0; j < 4; ++j) { const int n = (lane >> 2) + 16 * j; const LAS float* s = scr + (16 * c) * 65 + n;
        v4u o; o.x = pk4_f8(s[0], s[65], s[130], s[195]); o.y = pk4_f8(s[260], s[325], s[390], s[455]);
        o.z = pk4_f8(s[520], s[585], s[650], s[715]); o.w = pk4_f8(s[780], s[845], s[910], s[975]);
        *(v4u*)(WT + (size_t)n * ldt + 16 * c) = o; }
    LDS_WAIT();
}
struct TrItem { const float* W; bf16* WT; int ldw, nv; };
constexpr int I_IN = 32 * 57, I_OUT = 16 * 32, I_MOE = MOE_RB ? 0 : NE * 3 * 32 * 32, NITEMS = I_IN + I_OUT + I_MOE;
constexpr float W8_SCALE = 1024.f, X8_SCALE = 16.f, A8_SCALE = 4.f, O8_SCALE = 16.f;
DI TrItem tr_get(Frame& F, int it) {
    TrItem t; int r = it;
    if (r < I_MOE) {
        const int nb = r & 31, kb = (r >> 5) & 31, em = r >> 10, mat = em % 3, e = em / 3;
        t.ldw = D; t.nv = 64;
        constexpr int ES = MOE_F8 ? 1 : 2;
        if (mat == 2) { t.W = F.w_down + (size_t)e * D * D + (size_t)(64 * kb) * D + 64 * nb; t.WT = (bf16*)((unsigned char*)F.Btd + (((size_t)e * D + 64 * nb) * D + 64 * kb) * ES); }
        else { t.W = (mat == 0 ? F.w_gate : F.w_up) + (size_t)e * D * D + (size_t)(64 * kb) * D + 64 * nb;
               const int row = 256 * (nb >> 1) + 64 * (nb & 1) + 128 * mat; t.WT = (bf16*)((unsigned char*)F.Btgu + (((size_t)e * 4096 + row) * D + 64 * kb) * ES); }
        return t;
    }
    r -= I_MOE;
    if (r < I_IN) { const int kb = r / 57, nb = r % 57; t.ldw = NINPROJ; t.nv = (nb == 56) ? 16 : 64;
        t.W = F.w_in + (size_t)(64 * kb) * NINPROJ + 64 * nb; t.WT = F.Bt1 + (size_t)(64 * nb) * D + 64 * kb; return t; }
    r -= I_IN;
    { const int kb = r >> 5, nb = r & 31; t.ldw = D; t.nv = 64;
      t.W = F.w_out + (size_t)(1024 + 64 * kb) * D + 64 * nb; t.WT = F.Bt2 + (size_t)(64 * nb) * D + 1024 + 64 * kb; return t; }
}
DI void p0_weights_range(Frame& F, const int it_lo, const int it_hi) {
    LAS float* scr = (LAS float*)(F.lds + F.wave * 16640);
    float va[64], vb[64];
    int it = it_lo + F.gw;
    if (it >= it_hi) return;
    TrItem ta = tr_get(F, it), tb = ta;
    tr_load(va, ta.W, ta.ldw, ta.nv, F.lane);
    for (;;) {
        const bool hb = it + F.ngw < it_hi;
        if (hb) { tb = tr_get(F, it + F.ngw); tr_load(vb, tb.W, tb.ldw, tb.nv, F.lane); }
        if (MOE_F8 && it < I_MOE) tr_store8(va, (unsigned char*)ta.WT, D, scr, F.lane, W8_SCALE); else tr_store(va, ta.nv, ta.WT, D, scr, F.lane);
        if (!hb) break;
        it += F.ngw;
        const bool ha = it + F.ngw < it_hi;
        if (ha) { ta = tr_get(F, it + F.ngw); tr_load(va, ta.W, ta.ldw, ta.nv, F.lane); }
        if (MOE_F8 && it < I_MOE) tr_store8(vb, (unsigned char*)tb.WT, D, scr, F.lane, W8_SCALE); else tr_store(vb, tb.nv, tb.WT, D, scr, F.lane);
        if (!ha) break;
        it += F.ngw;
    }
}
DI void p0_weff(Frame& F) {
    const int lane = F.lane, li = lane & 31, kh = lane >> 5;
    for (int task = F.gw; task < 2048; task += F.ngw) {
        const int g = task >> 9, rem = task & 511, cb = rem >> 6, nb = rem & 63;
        const float* wo = F.w_out + (size_t)(256 * g + 4 * kh) * D + 32 * nb + li;
        const float* ps = F.pool_scale + 256 * g + 4 * kh;
        const float* pw = F.pool_w + (size_t)(g * 256 + 32 * cb + li) * 256 + 4 * kh;
        f32x16 acc;
#pragma unroll
        for (int i = 0; i < 16; ++i) acc[i] = 0.f;
#pragma unroll 8
        for (int jj = 0; jj < 32; ++jj) {
            const f32x4 b = *(const f32x4*)(pw + 8 * jj), sc = *(const f32x4*)(ps + 8 * jj);
            const float a0 = wo[(size_t)(8 * jj) * D] * sc.x, a1 = wo[(size_t)(8 * jj + 1) * D] * sc.y, a2 = wo[(size_t)(8 * jj + 2) * D] * sc.z, a3 = wo[(size_t)(8 * jj + 3) * D] * sc.w;
            acc = __builtin_amdgcn_mfma_f32_32x32x2f32(a0, b.x, acc, 0, 0, 0);
            acc = __builtin_amdgcn_mfma_f32_32x32x2f32(a1, b.y, acc, 0, 0, 0);
            acc = __builtin_amdgcn_mfma_f32_32x32x2f32(a2, b.z, acc, 0, 0, 0);
            acc = __builtin_amdgcn_mfma_f32_32x32x2f32(a3, b.w, acc, 0, 0, 0);
        }
        bf16* dst = F.Bt2 + (size_t)(32 * nb) * D + 256 * g + 32 * cb + li;
#pragma unroll
        for (int i = 0; i < 16; ++i) dst[(size_t)crow16(i, kh) * D] = f2bf(acc[i]);
    }
}
DI void p0_router_fold(Frame& F) {
    for (int i = F.bid * 512 + F.tid; i < D * NE; i += F.nwg * 512) F.Wr[i] = F.g2[i >> 5] * F.router_w[i];
}

DI void e_conv_tile(Frame& F, int c, int pcol, int cch, bf16* outT, bf16* outR, int rcol) {
    const int lane = F.lane, ch = cch + lane;
    const float w0 = F.conv_w[ch], w1 = F.conv_w[DCONV + ch], w2 = F.conv_w[2 * DCONV + ch], w3 = F.conv_w[3 * DCONV + ch], b = F.conv_b[ch];
    const bf16* src = F.proj + pcol + lane;
    const int P0 = 64 * c;
    bf16 raw[67];
#pragma unroll
    for (int i = 0; i < 3; ++i) raw[i] = (P0 - 3 + i >= 0) ? src[(size_t)(P0 - 3 + i) * NPROJ] : (bf16)0;
#pragma unroll
    for (int i = 0; i < 64; ++i) raw[3 + i] = src[(size_t)(P0 + i) * NPROJ];
#pragma unroll
    for (int sb = 0; sb < 4; ++sb) {
        float o[16];
#pragma unroll
        for (int i = 0; i < 16; ++i) { const int q = 16 * sb + i;
            const float a = b + w0 * bf2f(raw[q]) + w1 * bf2f(raw[q + 1]) + w2 * bf2f(raw[q + 2]) + w3 * bf2f(raw[q + 3]);
            o[i] = (P0 + q >= LEAD) ? silu_f(a) : 0.f; }
        if (outT) { v4u q0, q1;
            q0.x = pk2(o[0], o[1]); q0.y = pk2(o[2], o[3]); q0.z = pk2(o[4], o[5]); q0.w = pk2(o[6], o[7]);
            q1.x = pk2(o[8], o[9]); q1.y = pk2(o[10], o[11]); q1.z = pk2(o[12], o[13]); q1.w = pk2(o[14], o[15]);
            bf16* dst = outT + (size_t)lane * NP + P0 + 16 * sb; *(v4u*)dst = q0; *(v4u*)(dst + 8) = q1; }
        if (outR) {
#pragma unroll
            for (int i = 0; i < 16; ++i) outR[(size_t)(P0 + 16 * sb + i) * 256 + rcol + lane] = f2bf(o[i]); }
    }
}
template <int W> DI void e_pool_tile(Frame& F, int c, int colbase) {
    const int lane = F.lane; const bf16* src = F.proj + colbase + lane; const int P0 = 64 * c;
    bf16 raw[64 + W - 1];
#pragma unroll
    for (int i = 0; i < 64 + W - 1; ++i) raw[i] = src[(size_t)(P0 - (W - 1) + i) * NPROJ];
#pragma unroll
    for (int sb = 0; sb < 4; ++sb) {
#pragma unroll
        for (int i = 0; i < 16; ++i) { const int q = 16 * sb + i; float s = 0.f;
#pragma unroll
            for (int j = 0; j < W; ++j) s += bf2f(raw[q + j]);
            F.ycat[(size_t)(P0 - 64 + q) * D + colbase + lane] = f2bf(s * (1.f / W) - bf2f(raw[q + W - 1])); }
    }
}
DI void e_dt_tile(Frame& F, int c) {
    const int P = 64 * c + F.lane;
    const v4u* src = (const v4u*)(F.proj + (size_t)P * NPROJ + C_DT);
    const v4u r0 = src[0], r1 = src[1];
    const unsigned w[8] = {r0.x, r0.y, r0.z, r0.w, r1.x, r1.y, r1.z, r1.w};
    float o[16];
#pragma unroll
    for (int i = 0; i < 8; ++i) { o[2 * i] = bf_lo(w[i]); o[2 * i + 1] = bf_hi(w[i]); }
#pragma unroll
    for (int h = 0; h < 16; ++h) { const float x = o[h] + F.dt_bias[h]; const float sp = fmaxf(x, 0.f) + log1pf(__expf(-fabsf(x))); o[h] = (P >= LEAD) ? sp : 0.f; }
    f32x4* dst = (f32x4*)(F.dtv + (size_t)P * 16);
#pragma unroll
    for (int q = 0; q < 4; ++q) dst[q] = (f32x4){o[4 * q], o[4 * q + 1], o[4 * q + 2], o[4 * q + 3]};
}
DI void p2_elem(Frame& F) {
    constexpr int NT = 129 * 41;
    for (int task = F.gw; task < NT; task += F.ngw) {
        const int c = task / 41, j = task % 41;
        if (j < 16) { if (c == 0) continue; const int g = j >> 2;
            if (g == 0) e_pool_tile<2>(F, c, 64 * j); else if (g == 1) e_pool_tile<4>(F, c, 64 * j); else if (g == 2) e_pool_tile<8>(F, c, 64 * j); else e_pool_tile<16>(F, c, 64 * j); }
        else if (j < 32) e_conv_tile(F, c, C_X + 64 * (j - 16), 64 * (j - 16), F.xT + (size_t)(64 * (j - 16)) * NP, nullptr, 0);
        else if (j < 36) e_conv_tile(F, c, C_B + 64 * (j - 32), 1024 + 64 * (j - 32), F.BT + (size_t)(64 * (j - 32)) * NP, F.Bc, 64 * (j - 32));
        else if (j < 40) e_conv_tile(F, c, C_C + 64 * (j - 36), 1280 + 64 * (j - 36), nullptr, F.Cc, 64 * (j - 36));
        else e_dt_tile(F, c);
    }
}

DI void p3_states(Frame& F) {
    const int lane = F.lane, r = lane & 31, hf = lane >> 5;
    LAS float* wsm = (LAS float*)(F.lds + F.wave * 256);
    for (int u = F.bid; u < 256; u += F.nwg) {
        const int c = u >> 1, g = u & 1, h = 8 * g + F.wave;
        const float A = -__expf(F.a_log[h]);
        const float dtl = F.dtv[(size_t)(64 * c + lane) * 16 + h];
        const float acs = wave_incl_scan(dtl * A, lane);
        const float tot = __shfl(acs, 63);
        wsm[lane] = dtl * __expf(tot - acs);
        if (lane == 0) F.decay[c * 16 + h] = __expf(tot);
        LDS_WAIT();
        f32x16 acc[2][4];
#pragma unroll
        for (int mt = 0; mt < 2; ++mt)
#pragma unroll
            for (int nt = 0; nt < 4; ++nt)
#pragma unroll
                for (int i = 0; i < 16; ++i) acc[mt][nt][i] = 0.f;
#pragma unroll
        for (int ks = 0; ks < 4; ++ks) {
            const f32x4 wa = *(const LAS f32x4*)(wsm + 16 * ks + 8 * hf), wb = *(const LAS f32x4*)(wsm + 16 * ks + 8 * hf + 4);
            bf16x8 af[2], bfr[4];
#pragma unroll
            for (int mt = 0; mt < 2; ++mt) {
                const v4u raw = *(const v4u*)(F.xT + (size_t)(h * 64 + 32 * mt + r) * NP + 64 * c + 16 * ks + 8 * hf);
                v4u sc; sc.x = pk2(bf_lo(raw.x) * wa.x, bf_hi(raw.x) * wa.y); sc.y = pk2(bf_lo(raw.y) * wa.z, bf_hi(raw.y) * wa.w);
                sc.z = pk2(bf_lo(raw.z) * wb.x, bf_hi(raw.z) * wb.y); sc.w = pk2(bf_lo(raw.w) * wb.z, bf_hi(raw.w) * wb.w);
                af[mt] = __builtin_bit_cast(bf16x8, sc);
            }
#pragma unroll
            for (int nt = 0; nt < 4; ++nt) bfr[nt] = *(const bf16x8*)(F.BT + (size_t)(g * 128 + 32 * nt + r) * NP + 64 * c + 16 * ks + 8 * hf);
#pragma unroll
            for (int mt = 0; mt < 2; ++mt)
#pragma unroll
                for (int nt = 0; nt < 4; ++nt) acc[mt][nt] = MFMA32(af[mt], bfr[nt], acc[mt][nt]);
        }
        bf16* st = F.states + ((size_t)(c * 16 + h) * 64) * 128;
#pragma unroll
        for (int mt = 0; mt < 2; ++mt)
#pragma unroll
            for (int nt = 0; nt < 4; ++nt)
#pragma unroll
                for (int i = 0; i < 16; ++i) st[(32 * mt + crow16(i, hf)) * 128 + 32 * nt + r] = f2bf(acc[mt][nt][i]);
        LDS_WAIT();
    }
}
DI void p4_scan(Frame& F) {
    const unsigned* st2 = (const unsigned*)F.states; unsigned* pv2 = (unsigned*)F.prev;
    for (int e = F.bid * 512 + F.tid; e < 65536; e += F.nwg * 512) {
        const int h = e >> 12; float c0v = 0.f, c1v = 0.f;
        for (int c0 = 0; c0 < 128; c0 += 16) {
            unsigned s[16]; float dc[16];
#pragma unroll
            for (int i = 0; i < 16; ++i) { s[i] = st2[(size_t)(c0 + i) * 65536 + e]; dc[i] = F.decay[(c0 + i) * 16 + h]; }
#pragma unroll
            for (int i = 0; i < 16; ++i) { c0v = c0v * dc[i] + bf_lo(s[i]); c1v = c1v * dc[i] + bf_hi(s[i]); pv2[(size_t)(c0 + i) * 65536 + e] = pk2(c0v, c1v); }
        }
    }
}
DI bf16x8 pack8(const f32x16& x, int s) {
    v4u p; p.x = pk2(x[8 * s], x[8 * s + 1]); p.y = pk2(x[8 * s + 2], x[8 * s + 3]); p.z = pk2(x[8 * s + 4], x[8 * s + 5]); p.w = pk2(x[8 * s + 6], x[8 * s + 7]);
    return __builtin_bit_cast(bf16x8, p);
}
DI void p5_out(Frame& F) {
    const int lane = F.lane, r = lane & 31, hf = lane >> 5;
    LAS float* acs_s = (LAS float*)(F.lds + F.wave * 512);
    LAS float* dt_s = acs_s + 64;
    LAS float* red = (LAS float*)(F.lds + 8192);
    for (int u = F.bid; u < 256; u += F.nwg) {
        const int c = 1 + (u >> 1), g = u & 1, h = 8 * g + F.wave;
        const float A = -__expf(F.a_log[h]), Dh = F.d_skip[h];
        const float dtl = F.dtv[(size_t)(64 * c + lane) * 16 + h];
        const float acs = wave_incl_scan(dtl * A, lane);
        acs_s[lane] = acs; dt_s[lane] = dtl;
        float acs_l[2]; acs_l[0] = __shfl(acs, r); acs_l[1] = __shfl(acs, 32 + r);
        LDS_WAIT();
        f32x16 yT[2][2], sT[3];
#pragma unroll
        for (int i = 0; i < 16; ++i) { yT[0][0][i] = 0.f; yT[0][1][i] = 0.f; yT[1][0][i] = 0.f; yT[1][1][i] = 0.f; sT[0][i] = 0.f; sT[1][i] = 0.f; sT[2][i] = 0.f; }
        const bf16* prevp = F.prev + ((size_t)(c - 1) * 16 + h) * 8192;
#pragma unroll 2
        for (int ks = 0; ks < 8; ++ks) {
            bf16x8 cf[2], pf[2], bg[2];
#pragma unroll
            for (int t = 0; t < 2; ++t) {
                cf[t] = *(const bf16x8*)(F.Cc + (size_t)(64 * c + 32 * t + r) * 256 + g * 128 + 16 * ks + 8 * hf);
                bg[t] = *(const bf16x8*)(F.Bc + (size_t)(64 * c + 32 * t + r) * 256 + g * 128 + 16 * ks + 8 * hf);
                pf[t] = *(const bf16x8*)(prevp + (32 * t + r) * 128 + 16 * ks + 8 * hf);
            }
            yT[0][0] = MFMA32(pf[0], cf[0], yT[0][0]); yT[0][1] = MFMA32(pf[0], cf[1], yT[0][1]);
            yT[1][0] = MFMA32(pf[1], cf[0], yT[1][0]); yT[1][1] = MFMA32(pf[1], cf[1], yT[1][1]);
            sT[0] = MFMA32(bg[0], cf[0], sT[0]); sT[1] = MFMA32(bg[0], cf[1], sT[1]); sT[2] = MFMA32(bg[1], cf[1], sT[2]);
        }
        { const float e0 = __expf(acs_l[0]), e1 = __expf(acs_l[1]);
#pragma unroll
          for (int i = 0; i < 16; ++i) { yT[0][0][i] *= e0; yT[1][0][i] *= e0; yT[0][1][i] *= e1; yT[1][1][i] *= e1; } }
#pragma unroll
        for (int t = 0; t < 3; ++t) {
            const int st = (t == 2) ? 1 : 0, lt = (t == 0) ? 0 : 1;
            const int l = 32 * lt + r;
#pragma unroll
            for (int q = 0; q < 4; ++q) {
                const f32x4 a4 = *(const LAS f32x4*)(acs_s + 32 * st + 8 * q + 4 * hf), d4 = *(const LAS f32x4*)(dt_s + 32 * st + 8 * q + 4 * hf);
#pragma unroll
                for (int e = 0; e < 4; ++e) { const int s = 32 * st + 8 * q + 4 * hf + e;
                    float val = sT[t][4 * q + e] * __expf(acs_l[lt] - a4[e]) * d4[e];
                    val = (s <= l) ? val : 0.f; val = (s == l) ? val + Dh : val;
                    sT[t][4 * q + e] = val; }
            }
        }
#pragma unroll
        for (int st = 0; st < 2; ++st)
#pragma unroll
            for (int sp = 0; sp < 2; ++sp) {
                bf16x8 xa[2];
#pragma unroll
                for (int pt = 0; pt < 2; ++pt) { const bf16* xp = F.xT + (size_t)(h * 64 + 32 * pt + r) * NP + 64 * c + 32 * st + 16 * sp + 4 * hf;
                    const v2u lo = *(const v2u*)xp, hi = *(const v2u*)(xp + 8); v4u w; w.x = lo.x; w.y = lo.y; w.z = hi.x; w.w = hi.y; xa[pt] = __builtin_bit_cast(bf16x8, w); }
                if (st == 0) { const bf16x8 m0 = pack8(sT[0], sp), m1 = pack8(sT[1], sp);
                    yT[0][0] = MFMA32(xa[0], m0, yT[0][0]); yT[1][0] = MFMA32(xa[1], m0, yT[1][0]);
                    yT[0][1] = MFMA32(xa[0], m1, yT[0][1]); yT[1][1] = MFMA32(xa[1], m1, yT[1][1]);
                } else { const bf16x8 m2 = pack8(sT[2], sp);
                    yT[0][1] = MFMA32(xa[0], m2, yT[0][1]); yT[1][1] = MFMA32(xa[1], m2, yT[1][1]); }
            }
        float ss[2] = {0.f, 0.f};
#pragma unroll
        for (int pt = 0; pt < 2; ++pt)
#pragma unroll
            for (int lt = 0; lt < 2; ++lt) {
                const bf16* zp = F.proj + (size_t)(64 * c + 32 * lt + r) * NPROJ + C_Z + h * 64 + 32 * pt + 4 * hf;
#pragma unroll
                for (int q = 0; q < 4; ++q) { const v2u zw = *(const v2u*)(zp + 8 * q);
                    const float z0 = bf_lo(zw.x), z1 = bf_hi(zw.x), z2 = bf_lo(zw.y), z3 = bf_hi(zw.y);
                    float y0 = yT[pt][lt][4 * q] * silu_f(z0), y1 = yT[pt][lt][4 * q + 1] * silu_f(z1), y2 = yT[pt][lt][4 * q + 2] * silu_f(z2), y3 = yT[pt][lt][4 * q + 3] * silu_f(z3);
                    yT[pt][lt][4 * q] = y0; yT[pt][lt][4 * q + 1] = y1; yT[pt][lt][4 * q + 2] = y2; yT[pt][lt][4 * q + 3] = y3;
                    ss[lt] += (y0 * y0 + y1 * y1) + (y2 * y2 + y3 * y3); }
            }
        ss[0] += __shfl_xor(ss[0], 32); ss[1] += __shfl_xor(ss[1], 32);
        if (hf == 0) { red[F.wave * 64 + r] = ss[0]; red[F.wave * 64 + 32 + r] = ss[1]; }
        LDS_WAIT(); __syncthreads();
        float rstd[2];
#pragma unroll
        for (int lt = 0; lt < 2; ++lt) { float t = 0.f;
#pragma unroll
            for (int w = 0; w < 8; ++w) t += red[w * 64 + 32 * lt + r];
            rstd[lt] = rsqrtf(t * (1.f / 512.f) + EPS); }
#pragma unroll
        for (int pt = 0; pt < 2; ++pt)
#pragma unroll
            for (int lt = 0; lt < 2; ++lt) {
                bf16* op = F.ycat + (size_t)(64 * (c - 1) + 32 * lt + r) * D + 1024 + h * 64 + 32 * pt + 4 * hf;
                const float* gp = F.ssm_g + h * 64 + 32 * pt + 4 * hf;
#pragma unroll
                for (int q = 0; q < 4; ++q) { const f32x4 gg = *(const f32x4*)(gp + 8 * q); v2u w;
                    w.x = pk2(yT[pt][lt][4 * q] * rstd[lt] * gg.x, yT[pt][lt][4 * q + 1] * rstd[lt] * gg.y);
                    w.y = pk2(yT[pt][lt][4 * q + 2] * rstd[lt] * gg.z, yT[pt][lt][4 * q + 3] * rstd[lt] * gg.w);
                    *(v2u*)(op + 8 * q) = w; }
            }
        __syncthreads();
    }
}

DI void p7_router(Frame& F) {
    LAS float* rs = (LAS float*)F.lds;
    LAS float* part = rs + 64;
    LAS float* lg = part + 8 * 1024;
    LAS int* hist = (LAS int*)(lg + 32 * 33 + 8);
    const int lane = F.lane, wave = F.wave;
    for (int blk = F.bid; blk < 256; blk += F.nwg) {
        const int r0 = 32 * blk;
        {
            const f32x4* gr = (const f32x4*)F.g2 + lane;
            f32x4 v[4][8];
#pragma unroll
            for (int i = 0; i < 4; ++i) { const v2u* xr = (const v2u*)(F.h2 + (size_t)(r0 + 4 * wave + i) * D) + lane;
#pragma unroll
                for (int j = 0; j < 8; ++j) { const v2u w = xr[64 * j]; v[i][j] = (f32x4){bf_lo(w.x), bf_hi(w.x), bf_lo(w.y), bf_hi(w.y)}; } }
            f32x4 g[8];
#pragma unroll
            for (int j = 0; j < 8; ++j) g[j] = gr[64 * j];
#pragma unroll
            for (int i = 0; i < 4; ++i) { const int rr = r0 + 4 * wave + i; float s = 0.f;
#pragma unroll
                for (int j = 0; j < 8; ++j) s += (v[i][j].x * v[i][j].x + v[i][j].y * v[i][j].y) + (v[i][j].z * v[i][j].z + v[i][j].w * v[i][j].w);
                const float rstd = rsqrtf(wave_sum(s) * (1.f / D) + EPS);
                unsigned long long* o8 = (unsigned long long*)(F.hn2 + (size_t)rr * D) + lane;
                unsigned* o4 = (unsigned*)((unsigned char*)F.hn2 + (size_t)rr * D) + lane;
#pragma unroll
                for (int j = 0; j < 8; ++j) {
                    if (MOE_F8) { const float q = rstd * X8_SCALE; o4[64 * j] = pk4_f8(v[i][j].x * q * g[j].x, v[i][j].y * q * g[j].y, v[i][j].z * q * g[j].z, v[i][j].w * q * g[j].w); }
                    else o8[64 * j] = (unsigned long long)pk2(v[i][j].x * rstd * g[j].x, v[i][j].y * rstd * g[j].y) | ((unsigned long long)pk2(v[i][j].z * rstd * g[j].z, v[i][j].w * rstd * g[j].w) << 32); }
                if (lane == 0) rs[4 * wave + i] = rstd; }
        }
        f32x16 acc;
#pragma unroll
        for (int i = 0; i < 16; ++i) acc[i] = 0.f;
        { const int ri = lane & 31, kh = lane >> 5;
          const bf16* arow = F.h2 + (size_t)(r0 + ri) * D + 256 * wave + 4 * kh;
          const float* wp = F.Wr + (size_t)(256 * wave + 4 * kh) * 32 + ri;
#pragma unroll 8
          for (int jj = 0; jj < 32; ++jj) {
              const v2u aw = *(const v2u*)(arow + 8 * jj); const f32x4 a = {bf_lo(aw.x), bf_hi(aw.x), bf_lo(aw.y), bf_hi(aw.y)};
              const float b0 = wp[(8 * jj) * 32], b1 = wp[(8 * jj + 1) * 32], b2 = wp[(8 * jj + 2) * 32], b3 = wp[(8 * jj + 3) * 32];
              acc = __builtin_amdgcn_mfma_f32_32x32x2f32(a.x, b0, acc, 0, 0, 0);
              acc = __builtin_amdgcn_mfma_f32_32x32x2f32(a.y, b1, acc, 0, 0, 0);
              acc = __builtin_amdgcn_mfma_f32_32x32x2f32(a.z, b2, acc, 0, 0, 0);
              acc = __builtin_amdgcn_mfma_f32_32x32x2f32(a.w, b3, acc, 0, 0, 0);
          }
#pragma unroll
          for (int i = 0; i < 16; ++i) part[wave * 1024 + crow16(i, kh) * 32 + ri] = acc[i];
        }
        if (F.tid < 32) hist[F.tid] = 0;
        LDS_WAIT(); __syncthreads();
        for (int idx = F.tid; idx < 1024; idx += 512) { float s = 0.f;
#pragma unroll
            for (int w = 0; w < 8; ++w) s += part[w * 1024 + idx];
            lg[(idx >> 5) * 33 + (idx & 31)] = s * rs[idx >> 5] + F.router_b[idx & 31]; }
        LDS_WAIT(); __syncthreads();
        if (F.tid < 32) {
            const int i = F.tid; float tv[4]; int te[4];
#pragma unroll
            for (int k = 0; k < 4; ++k) { float best = -3.0e38f; int be = 0;
                for (int e = 0; e < 32; ++e) { const float x = lg[i * 33 + e]; if (x > best) { best = x; be = e; } }
                tv[k] = best; te[k] = be; lg[i * 33 + be] = -3.4e38f; }
            const float e1 = __expf(tv[1] - tv[0]), e2 = __expf(tv[2] - tv[0]), e3 = __expf(tv[3] - tv[0]);
            const float inv = 1.f / (1.f + e1 + e2 + e3);
            *(f32x4*)(F.tkg + (size_t)(r0 + i) * 4) = (f32x4){inv, e1 * inv, e2 * inv, e3 * inv};
            int* tk = F.tke + (size_t)(r0 + i) * 4; tk[0] = te[0]; tk[1] = te[1]; tk[2] = te[2]; tk[3] = te[3];
#pragma unroll
            for (int k = 0; k < 4; ++k) __hip_atomic_fetch_add(hist + te[k], 1, __ATOMIC_RELAXED, __HIP_MEMORY_SCOPE_WORKGROUP);
        }
        LDS_WAIT(); __syncthreads();
        if (F.tid < 32) F.cnt[blk * 32 + F.tid] = hist[F.tid];
        __syncthreads();
    }
}
DI void p8_route(Frame& F) {
    LAS int* tot = (LAS int*)F.lds; LAS int* pre = tot + 32; LAS int* base = tot + 64; LAS int* posl = tot + 128; LAS int* tkl = tot + 256; LAS int* ptot = tot + 512; LAS int* ppre = ptot + 512;
    for (int blk = F.bid; blk < 256; blk += F.nwg) {
        const int r0 = 32 * blk;
        { const int e = F.tid & 31, wq = F.tid >> 5; int t = 0, p = 0;
#pragma unroll
          for (int i = 0; i < 16; ++i) { const int w = wq + 16 * i; const int v = F.cnt[w * 32 + e]; p += (w < blk) ? v : 0; t += v; }
          ptot[wq * 32 + e] = t; ppre[wq * 32 + e] = p; }
        if (F.tid < 128) tkl[F.tid] = F.tke[(size_t)r0 * 4 + F.tid];
        LDS_WAIT(); __syncthreads();
        if (F.tid < 32) { int t = 0, p = 0;
#pragma unroll
            for (int i = 0; i < 16; ++i) { t += ptot[i * 32 + F.tid]; p += ppre[i * 32 + F.tid]; }
            tot[F.tid] = t; pre[F.tid] = p; }
        LDS_WAIT(); __syncthreads();
        if (F.tid < 32) { int accp = 0; for (int e = 0; e < F.tid; ++e) accp += ((tot[e] + 255) >> 8) << 8; base[F.tid] = accp; }
        if (blk == 0 && F.tid == 64) { int nt = 0;
            for (int e = 0; e < 32; ++e) { const int tiles = (tot[e] + 255) >> 8; for (int j = 0; j < tiles; ++j) F.tile[nt + j] = e; nt += tiles; }
            F.tile[255] = nt; }
        LDS_WAIT(); __syncthreads();
        if (F.tid < 128) { const int e = tkl[F.tid]; int q = 0; for (int j = 0; j < F.tid; ++j) q += (tkl[j] == e) ? 1 : 0;
            const int p = base[e] + pre[e] + q; posl[F.tid] = p; F.pos[(size_t)r0 * 4 + F.tid] = p; }
        LDS_WAIT(); __syncthreads();
        if (F.tid < 128) ((int*)F.xs)[posl[F.tid]] = r0 + (F.tid >> 2);
        if (blk == 0 && F.tid < 32) { const int e = F.tid, lo_ = base[e] + tot[e], hi_ = base[e] + (((tot[e] + 255) >> 8) << 8); for (int q = lo_; q < hi_; ++q) ((int*)F.xs)[q] = 0; }
        __syncthreads();
    }
}
DI void p11_final(Frame& F) {
    const int lane = F.lane;
    for (int rr = F.gw; rr < SEQ; rr += F.ngw) {
        const int* pp = F.pos + (size_t)rr * 4; const f32x4 gt = *(const f32x4*)(F.tkg + (size_t)rr * 4);
        const float gk[4] = {gt.x, gt.y, gt.z, gt.w};
        const v2u* xr = (const v2u*)(F.h2 + (size_t)rr * D) + lane;
        f32x4 v[8];
#pragma unroll
        for (int j = 0; j < 8; ++j) { const v2u w = xr[64 * j]; v[j] = (f32x4){bf_lo(w.x), bf_hi(w.x), bf_lo(w.y), bf_hi(w.y)}; }
#pragma unroll
        for (int k = 0; k < 4; ++k) { const int* orow = (const int*)((const unsigned char*)F.obuf + (size_t)pp[k] * D) + lane; const float gq = gk[k] * (1.f / O8_SCALE);
#pragma unroll
            for (int j = 0; j < 8; ++j) { const int w = orow[64 * j];
                v[j].x += gq * __builtin_amdgcn_cvt_f32_fp8(w, 0); v[j].y += gq * __builtin_amdgcn_cvt_f32_fp8(w, 1); v[j].z += gq * __builtin_amdgcn_cvt_f32_fp8(w, 2); v[j].w += gq * __builtin_amdgcn_cvt_f32_fp8(w, 3); } }
        float s = 0.f;
#pragma unroll
        for (int j = 0; j < 8; ++j) s += (v[j].x * v[j].x + v[j].y * v[j].y) + (v[j].z * v[j].z + v[j].w * v[j].w);
        const float rstd = rsqrtf(wave_sum(s) * (1.f / D) + EPS);
        const f32x4* gr = (const f32x4*)F.final_g + lane; f32x4* op = (f32x4*)(F.out + (size_t)rr * D) + lane;
#pragma unroll
        for (int j = 0; j < 8; ++j) { const f32x4 g = gr[64 * j]; op[64 * j] = (f32x4){v[j].x * rstd * g.x, v[j].y * rstd * g.y, v[j].z * rstd * g.z, v[j].w * rstd * g.w}; }
    }
}

using pg8::Unit; using pg8::HALF; using pg8::BM;
struct EpiProj {
    static constexpr bool PERM = true, AFTER_DRAIN = false;
    bf16* O;
    DI void operator()(const f32x4 (&acc)[2][2][4][2], const Unit& u, int wr, int wc, int fr, int fq) const {
        const int row0 = u.pm * BM + wr * 64 + fr, col0 = u.pn * BM + wc * 32 + 8 * fq;
#pragma unroll
        for (int ai = 0; ai < 2; ++ai)
#pragma unroll
            for (int m = 0; m < 4; ++m) { bf16* rowp = O + (size_t)(row0 + ai * HALF + m * 16) * NPROJ + col0;
#pragma unroll
                for (int bj = 0; bj < 2; ++bj) { const f32x4 v0 = acc[ai][bj][m][0], v1 = acc[ai][bj][m][1];
                    v4u w; w.x = pk2(v0[0], v0[1]); w.y = pk2(v0[2], v0[3]); w.z = pk2(v1[0], v1[1]); w.w = pk2(v1[2], v1[3]);
                    *(v4u*)(rowp + bj * HALF) = w; } }
    }
};
struct EpiH2 {
    static constexpr bool PERM = true, AFTER_DRAIN = false;
    const float* X; bf16* H;
    DI void operator()(const f32x4 (&acc)[2][2][4][2], const Unit& u, int wr, int wc, int fr, int fq) const {
        const int row0 = u.pm * BM + wr * 64 + fr, col0 = u.pn * BM + wc * 32 + 8 * fq;
#pragma unroll
        for (int ai = 0; ai < 2; ++ai)
#pragma unroll
            for (int m = 0; m < 4; ++m) { const size_t off = (size_t)(row0 + ai * HALF + m * 16) * D + col0;
#pragma unroll
                for (int bj = 0; bj < 2; ++bj) { const f32x4 x0 = *(const f32x4*)(X + off + bj * HALF), x1 = *(const f32x4*)(X + off + bj * HALF + 4);
                    const f32x4 v0 = acc[ai][bj][m][0] + x0, v1 = acc[ai][bj][m][1] + x1;
                    v4u w; w.x = pk2(v0[0], v0[1]); w.y = pk2(v0[2], v0[3]); w.z = pk2(v1[0], v1[1]); w.w = pk2(v1[2], v1[3]);
                    *(v4u*)(H + off + bj * HALF) = w; } }
    }
};
DI float swiglu(float g, float u) {
    g = fminf(g, 7.f); u = fminf(fmaxf(u, -7.f), 7.f);
    return (u + 1.f) * g * __builtin_amdgcn_rcpf(1.f + __expf(-1.702f * g));
}
struct EpiGU {
    static constexpr bool PERM = true, AFTER_DRAIN = false;
    bf16* O; const float* bgate; const float* bup;
    DI void operator()(const f32x4 (&acc)[2][2][4][2], const Unit& u, int wr, int wc, int fr, int fq) const {
        const int e = u.pn >> 4, pnl = u.pn & 15;
        const int row0 = u.pm * BM + wr * 64 + fr, colb = 128 * pnl + wc * 32 + 8 * fq;
        f32x4 bg[2], bu[2];
#pragma unroll
        for (int n = 0; n < 2; ++n) { bg[n] = *(const f32x4*)(bgate + e * D + colb + 4 * n); bu[n] = *(const f32x4*)(bup + e * D + colb + 4 * n); }
#pragma unroll
        for (int ai = 0; ai < 2; ++ai)
#pragma unroll
            for (int m = 0; m < 4; ++m) { bf16* rowp = O + (size_t)(row0 + ai * HALF + m * 16) * D + colb;
                const f32x4 g0 = acc[ai][0][m][0] + bg[0], g1 = acc[ai][0][m][1] + bg[1], u0 = acc[ai][1][m][0] + bu[0], u1 = acc[ai][1][m][1] + bu[1];
                v4u w; w.x = pk2(swiglu(g0[0], u0[0]), swiglu(g0[1], u0[1])); w.y = pk2(swiglu(g0[2], u0[2]), swiglu(g0[3], u0[3]));
                w.z = pk2(swiglu(g1[0], u1[0]), swiglu(g1[1], u1[1])); w.w = pk2(swiglu(g1[2], u1[2]), swiglu(g1[3], u1[3]));
                *(v4u*)rowp = w; }
    }
};
struct EpiDown {
    static constexpr bool PERM = true, AFTER_DRAIN = false;
    bf16* O; const float* bias;
    DI void operator()(const f32x4 (&acc)[2][2][4][2], const Unit& u, int wr, int wc, int fr, int fq) const {
        const int e = u.pn >> 3, pnl = u.pn & 7;
        const int row0 = u.pm * BM + wr * 64 + fr, col0 = 256 * pnl + wc * 32 + 8 * fq;
        f32x4 bv[2][2];
#pragma unroll
        for (int bj = 0; bj < 2; ++bj)
#pragma unroll
            for (int n = 0; n < 2; ++n) bv[bj][n] = *(const f32x4*)(bias + e * D + col0 + bj * HALF + 4 * n);
#pragma unroll
        for (int ai = 0; ai < 2; ++ai)
#pragma unroll
            for (int m = 0; m < 4; ++m) { bf16* rowp = O + (size_t)(row0 + ai * HALF + m * 16) * D + col0;
#pragma unroll
                for (int bj = 0; bj < 2; ++bj) { const f32x4 v0 = acc[ai][bj][m][0] + bv[bj][0], v1 = acc[ai][bj][m][1] + bv[bj][1];
                    v4u w; w.x = pk2(v0[0], v0[1]); w.y = pk2(v0[2], v0[3]); w.z = pk2(v1[0], v1[1]); w.w = pk2(v1[2], v1[3]);
                    *(v4u*)(rowp + bj * HALF) = w; } }
    }
};
struct EpiGU8 {
    static constexpr bool PERM = true, AFTER_DRAIN = false;
    unsigned char* O; const float* bgate; const float* bup;
    DI void operator()(const f32x4 (&acc)[2][2][4][2], const Unit& u, int wr, int wc, int fr, int fq) const {
        const int e = u.pn >> 4, pnl = u.pn & 15;
        const int row0 = u.pm * BM + wr * 64 + fr, colb = 128 * pnl + wc * 32 + 8 * fq;
        constexpr float DQ = 1.f / (W8_SCALE * X8_SCALE);
        f32x4 bg[2], bu[2];
#pragma unroll
        for (int n = 0; n < 2; ++n) { bg[n] = *(const f32x4*)(bgate + e * D + colb + 4 * n); bu[n] = *(const f32x4*)(bup + e * D + colb + 4 * n); }
#pragma unroll
        for (int ai = 0; ai < 2; ++ai)
#pragma unroll
            for (int m = 0; m < 4; ++m) { unsigned char* rowp = O + (size_t)(row0 + ai * HALF + m * 16) * D + colb;
                const f32x4 g0 = acc[ai][0][m][0] * DQ + bg[0], g1 = acc[ai][0][m][1] * DQ + bg[1], u0 = acc[ai][1][m][0] * DQ + bu[0], u1 = acc[ai][1][m][1] * DQ + bu[1];
                v2u w; w.x = pk4_f8(swiglu(g0[0], u0[0]) * A8_SCALE, swiglu(g0[1], u0[1]) * A8_SCALE, swiglu(g0[2], u0[2]) * A8_SCALE, swiglu(g0[3], u0[3]) * A8_SCALE);
                w.y = pk4_f8(swiglu(g1[0], u1[0]) * A8_SCALE, swiglu(g1[1], u1[1]) * A8_SCALE, swiglu(g1[2], u1[2]) * A8_SCALE, swiglu(g1[3], u1[3]) * A8_SCALE);
                *(v2u*)rowp = w; }
    }
};
struct EpiDown8 {
    static constexpr bool PERM = true, AFTER_DRAIN = false;
    unsigned char* O; const float* bias;
    DI void operator()(const f32x4 (&acc)[2][2][4][2], const Unit& u, int wr, int wc, int fr, int fq) const {
        const int e = u.pn >> 3, pnl = u.pn & 7;
        const int row0 = u.pm * BM + wr * 64 + fr, col0 = 256 * pnl + wc * 32 + 8 * fq;
        constexpr float DQ = O8_SCALE / (W8_SCALE * A8_SCALE);
        f32x4 bv[2][2];
#pragma unroll
        for (int bj = 0; bj < 2; ++bj)
#pragma unroll
            for (int n = 0; n < 2; ++n) bv[bj][n] = *(const f32x4*)(bias + e * D + col0 + bj * HALF + 4 * n) * O8_SCALE;
#pragma unroll
        for (int ai = 0; ai < 2; ++ai)
#pragma unroll
            for (int m = 0; m < 4; ++m) { unsigned char* rowp = O + (size_t)(row0 + ai * HALF + m * 16) * D + col0;
#pragma unroll
                for (int bj = 0; bj < 2; ++bj) { const f32x4 v0 = acc[ai][bj][m][0] * DQ + bv[bj][0], v1 = acc[ai][bj][m][1] * DQ + bv[bj][1];
                    v2u w; w.x = pk4_f8(v0[0], v0[1], v0[2], v0[3]); w.y = pk4_f8(v1[0], v1[1], v1[2], v1[3]);
                    *(v2u*)(rowp + bj * HALF) = w; } }
    }
};
struct MoeOrder {
    const LAS int* tile_e; const int* rowtok = nullptr;
    int nM, nN, nwg, G, c;
    DI void init(const LAS int* te, int ntiles, int nN_, int G_, int c_) { tile_e = te; nM = ntiles; nN = nN_; nwg = nM * nN; G = G_; c = c_; }
    DI bool next(int i, Unit& u) const {
        const int L = i * G + c; if (L >= nwg) return false;
        int wgid = L; { const int q = nwg / pg8::NXCD, r = nwg % pg8::NXCD, xcd = wgid % pg8::NXCD, off = wgid / pg8::NXCD; wgid = (xcd < r ? xcd * (q + 1) : r * (q + 1) + (xcd - r) * q) + off; }
        const int nig = pg8::WGM * nN, gid = wgid / nig, fm = gid * pg8::WGM, gsz = (nM - fm) < pg8::WGM ? (nM - fm) : pg8::WGM;
        u.pm = fm + ((wgid % nig) % gsz); const int pnl = (wgid % nig) / gsz;
        u.pn = __builtin_amdgcn_readfirstlane(tile_e[u.pm]) * nN + pnl; return true;
    }
    DI void a_ready(const Unit&) const {}
    DI void done(const Unit&) const {}
};


#if MOE_RB
#define MFMA16(a, b, c) __builtin_amdgcn_mfma_f32_16x16x32_bf16((a), (b), (c), 0, 0, 0)
template <class Epi, class Sched>
DI void gemm_rb(LAS unsigned char* lds, const bf16* A, const Sched& S, const Epi& E) {
    constexpr int K = D, NT = K / 64;
    const int tid = threadIdx.x, wave = __builtin_amdgcn_readfirstlane(tid >> 6), lane = tid & 63, fr = lane & 15, fq = lane >> 4;
    unsigned voffA[2];
#pragma unroll
    for (int i = 0; i < 2; ++i) { int R, C; pg8::stage_rc(tid * 16 + i * 8192, R, C); voffA[i] = (unsigned)(R * K + C) * 2u; }
    const unsigned ldsw = (unsigned)wave * 1024u;
    const int aoff = pg8::lds_byte(fr, fq * 8);
    const unsigned boff = (unsigned)((8 * fq) * K + fr) * 4u;
    Unit u;
    for (int ui = 0; S.next(ui, u); ++ui) {
        const char* cA = (const char*)A + (size_t)u.pm * 256 * K * 2;
        const float *b0, *b1; E.bsrc(u, wave, b0, b1);
        const char* pb0 = (const char*)b0 + boff; const char* pb1 = (const char*)b1 + boff;
        f32x4 acc[16][2];
#pragma unroll
        for (int m = 0; m < 16; ++m) { acc[m][0] = (f32x4){0.f, 0.f, 0.f, 0.f}; acc[m][1] = (f32x4){0.f, 0.f, 0.f, 0.f}; }
        float rb[4][16];
#define RB_DMA(t) do { const int tt_ = (t) < NT ? (t) : NT - 1; const unsigned bo_ = (unsigned)(((t) % 3) * 32768); \
        _Pragma("unroll") for (int h_ = 0; h_ < 2; ++h_) _Pragma("unroll") for (int i_ = 0; i_ < 2; ++i_) \
            __builtin_amdgcn_global_load_lds((const unsigned*)(cA + (size_t)h_ * 128 * K * 2 + (size_t)tt_ * 128 + voffA[i_]), (LAS unsigned*)(lds + bo_ + h_ * 16384 + ldsw + i_ * 8192), 16, 0, 0); } while (0)
#define RB_ISSUE(slot, hs) do { const int he_ = (hs) < 2 * NT ? (hs) : 2 * NT - 1; const char* s0_ = pb0 + (size_t)he_ * 32 * K * 4; const char* s1_ = pb1 + (size_t)he_ * 32 * K * 4; \
        _Pragma("unroll") for (int j_ = 0; j_ < 8; ++j_) { \
            asm volatile("global_load_dword %0, %1, off" : "=v"(rb[slot][j_]) : "v"(s0_ + (size_t)j_ * K * 4) : "memory"); \
            asm volatile("global_load_dword %0, %1, off" : "=v"(rb[slot][8 + j_]) : "v"(s1_ + (size_t)j_ * K * 4) : "memory"); } } while (0)
#define RB_WAITB(slot) asm volatile("s_waitcnt vmcnt(52)" : "+v"(rb[slot][0]), "+v"(rb[slot][1]), "+v"(rb[slot][2]), "+v"(rb[slot][3]), "+v"(rb[slot][4]), "+v"(rb[slot][5]), "+v"(rb[slot][6]), "+v"(rb[slot][7]), \
        "+v"(rb[slot][8]), "+v"(rb[slot][9]), "+v"(rb[slot][10]), "+v"(rb[slot][11]), "+v"(rb[slot][12]), "+v"(rb[slot][13]), "+v"(rb[slot][14]), "+v"(rb[slot][15]) :: "memory")
#define RB_COMPUTE(bufo, ks, slot) do { v4u p0_, p1_; \
        p0_.x = pk2(rb[slot][0], rb[slot][1]); p0_.y = pk2(rb[slot][2], rb[slot][3]); p0_.z = pk2(rb[slot][4], rb[slot][5]); p0_.w = pk2(rb[slot][6], rb[slot][7]); \
        p1_.x = pk2(rb[slot][8], rb[slot][9]); p1_.y = pk2(rb[slot][10], rb[slot][11]); p1_.z = pk2(rb[slot][12], rb[slot][13]); p1_.w = pk2(rb[slot][14], rb[slot][15]); \
        const bf16x8 bf0_ = __builtin_bit_cast(bf16x8, p0_), bf1_ = __builtin_bit_cast(bf16x8, p1_); \
        _Pragma("unroll") for (int mg_ = 0; mg_ < 4; ++mg_) { bf16x8 a_[4]; \
            _Pragma("unroll") for (int q_ = 0; q_ < 4; ++q_) { const int m_ = 4 * mg_ + q_; a_[q_] = *(const LAS bf16x8*)(lds + (bufo) + (m_ >> 3) * 16384 + (m_ & 7) * 2048 + (ks) * 1024 + aoff); } \
            _Pragma("unroll") for (int q_ = 0; q_ < 4; ++q_) { const int m_ = 4 * mg_ + q_; acc[m_][0] = MFMA16(bf0_, a_[q_], acc[m_][0]); acc[m_][1] = MFMA16(bf1_, a_[q_], acc[m_][1]); } \
            __builtin_amdgcn_sched_barrier(0); } } while (0)
        RB_DMA(0); RB_DMA(1);
        RB_ISSUE(0, 0); RB_ISSUE(1, 1); RB_ISSUE(2, 2);
        int bi = 0;
#pragma unroll 1
        for (int t = 0; t < NT; t += 2) {
            const int bo0 = bi * 32768, bi1 = (bi == 2) ? 0 : bi + 1, bo1 = bi1 * 32768;
            asm volatile("s_waitcnt vmcnt(36)" ::: "memory"); __builtin_amdgcn_s_barrier(); asm volatile("" ::: "memory");
            RB_DMA(t + 2);
            RB_ISSUE(3, 2 * t + 3); RB_WAITB(0); RB_COMPUTE(bo0, 0, 0);
            RB_ISSUE(0, 2 * t + 4); RB_WAITB(1); RB_COMPUTE(bo0, 1, 1);
            asm volatile("s_waitcnt vmcnt(36)" ::: "memory"); __builtin_amdgcn_s_barrier(); asm volatile("" ::: "memory");
            RB_DMA(t + 3);
            RB_ISSUE(1, 2 * t + 5); RB_WAITB(2); RB_COMPUTE(bo1, 0, 2);
            RB_ISSUE(2, 2 * t + 6); RB_WAITB(3); RB_COMPUTE(bo1, 1, 3);
            bi = (bi1 == 2) ? 0 : bi1 + 1;
        }
#define RB_KEEP(slot, str) asm volatile(str : "+v"(rb[slot][0]), "+v"(rb[slot][1]), "+v"(rb[slot][2]), "+v"(rb[slot][3]), "+v"(rb[slot][4]), "+v"(rb[slot][5]), "+v"(rb[slot][6]), "+v"(rb[slot][7]), \
        "+v"(rb[slot][8]), "+v"(rb[slot][9]), "+v"(rb[slot][10]), "+v"(rb[slot][11]), "+v"(rb[slot][12]), "+v"(rb[slot][13]), "+v"(rb[slot][14]), "+v"(rb[slot][15]) :: "memory")
        RB_KEEP(0, "s_waitcnt vmcnt(0)"); RB_KEEP(1, ""); RB_KEEP(2, ""); RB_KEEP(3, "");
#undef RB_KEEP
        E(acc, u, wave, fr, fq);
        asm volatile("s_waitcnt vmcnt(0)" ::: "memory"); __builtin_amdgcn_s_barrier(); asm volatile("" ::: "memory");
#undef RB_DMA
#undef RB_ISSUE
#undef RB_WAITB
#undef RB_COMPUTE
    }
}
struct EpiGU2 {
    bf16* O; const float *wg, *wu, *bgate, *bup;
    DI void bsrc(const Unit& u, int wave, const float*& b0, const float*& b1) const {
        const int e = u.pn >> 4, pnl = u.pn & 15; const size_t o = (size_t)e * D * D + 128 * pnl + 16 * wave; b0 = wg + o; b1 = wu + o; }
    DI void operator()(const f32x4 (&acc)[16][2], const Unit& u, int wave, int fr, int fq) const {
        const int e = u.pn >> 4, pnl = u.pn & 15, col = 128 * pnl + 16 * wave + 4 * fq;
        const f32x4 bg = *(const f32x4*)(bgate + e * D + col), bu = *(const f32x4*)(bup + e * D + col);
        bf16* op = O + (size_t)(u.pm * 256 + fr) * D + col;
#pragma unroll
        for (int m = 0; m < 16; ++m) { const f32x4 g = acc[m][0] + bg, uu = acc[m][1] + bu; v2u w;
            w.x = pk2(swiglu(g[0], uu[0]), swiglu(g[1], uu[1])); w.y = pk2(swiglu(g[2], uu[2]), swiglu(g[3], uu[3]));
            *(v2u*)(op + (size_t)(16 * m) * D) = w; }
    }
};
struct EpiDown2 {
    bf16* O; const float *wd, *bias;
    DI void bsrc(const Unit& u, int wave, const float*& b0, const float*& b1) const {
        const int e = u.pn >> 3, pnl = u.pn & 7; b0 = wd + (size_t)e * D * D + 256 * pnl + 32 * wave; b1 = b0 + 16; }
    DI void operator()(const f32x4 (&acc)[16][2], const Unit& u, int wave, int fr, int fq) const {
        const int e = u.pn >> 3, pnl = u.pn & 7, col = 256 * pnl + 32 * wave + 4 * fq;
        const f32x4 v0 = *(const f32x4*)(bias + e * D + col), v1 = *(const f32x4*)(bias + e * D + col + 16);
        bf16* op = O + (size_t)(u.pm * 256 + fr) * D + col;
#pragma unroll
        for (int m = 0; m < 16; ++m) { const f32x4 a = acc[m][0] + v0, b = acc[m][1] + v1; v2u w0, w1;
            w0.x = pk2(a[0], a[1]); w0.y = pk2(a[2], a[3]); w1.x = pk2(b[0], b[1]); w1.y = pk2(b[2], b[3]);
            *(v2u*)(op + (size_t)(16 * m) * D) = w0; *(v2u*)(op + (size_t)(16 * m) * D + 16) = w1; }
    }
};

#endif
struct Args { const float* in[23]; float* out; unsigned char* ws; int ph_lo, ph_hi; };
DI void fill_frame(Frame& F, const Args& args, LAS unsigned char* lds, const int bid, const int nwg) {
    F.lds = lds;
    int tz = threadIdx.x; asm volatile("" : "+v"(tz)); F.tid = tz;
    F.lane = F.tid & 63; F.wave = __builtin_amdgcn_readfirstlane(F.tid >> 6);
    F.bid = bid; F.nwg = nwg; F.gw = bid * NWAVES + F.wave; F.ngw = nwg * NWAVES;
    unsigned char* ws = args.ws;
    F.x = args.in[0]; F.meta = args.in[1]; F.g1 = args.in[2]; F.w_in = args.in[3]; F.pool_w = args.in[4]; F.pool_scale = args.in[5]; F.conv_w = args.in[6]; F.conv_b = args.in[7];
    F.dt_bias = args.in[8]; F.a_log = args.in[9]; F.d_skip = args.in[10]; F.ssm_g = args.in[11]; F.w_out = args.in[12]; F.g2 = args.in[13]; F.router_w = args.in[14]; F.router_b = args.in[15];
    F.w_gate = args.in[16]; F.b_gate = args.in[17]; F.w_up = args.in[18]; F.b_up = args.in[19]; F.w_down = args.in[20]; F.b_down = args.in[21]; F.final_g = args.in[22];
    F.out = args.out;
    F.hn = (bf16*)(ws + WS_HN); F.Bt1 = (bf16*)(ws + WS_BT1); F.Bt2 = (bf16*)(ws + WS_BT2); F.proj = (bf16*)(ws + WS_PROJ); F.xT = (bf16*)(ws + WS_XT); F.BT = (bf16*)(ws + WS_BTT);
    F.Bc = (bf16*)(ws + WS_BC); F.Cc = (bf16*)(ws + WS_CC); F.prev = (bf16*)(ws + WS_PREV); F.ycat = (bf16*)(ws + WS_YCAT); F.hn2 = (bf16*)(ws + WS_HN2); F.xs = (bf16*)(ws + WS_XS);
    F.abuf = (bf16*)(ws + WS_A); F.obuf = (bf16*)(ws + (MOE_F8 ? WS_O : WS_XS)); F.Btgu = (bf16*)(ws + WS_BTGU); F.Btd = (bf16*)(ws + WS_BTD);
    F.dtv = (float*)(ws + WS_DT); F.states = (bf16*)(ws + WS_ST); F.decay = (float*)(ws + WS_DEC); F.h2 = (bf16*)(ws + WS_H2); F.Wr = (float*)(ws + WS_WR); F.tkg = (float*)(ws + WS_TKG);
    F.tke = (int*)(ws + WS_TKE); F.pos = (int*)(ws + WS_POS); F.cnt = (int*)(ws + WS_CNT); F.tile = (int*)(ws + WS_TILE);

}
__global__ void __launch_bounds__(NWAVES * 64, 2) fwd(Args args) {
    extern __shared__ __attribute__((aligned(16))) unsigned char lds_raw[];
    LAS unsigned char* const lds_base = (LAS unsigned char*)lds_raw; unsigned char* ws = args.ws;
    volatile LAS unsigned* MISC = (volatile LAS unsigned*)(lds_base + MISC_OFF);
    if (threadIdx.x < 32) MISC[threadIdx.x] = 0u;
    __syncthreads();
    const int G = (int)gridDim.x, bx = (int)blockIdx.x;
    const bool worker = bx < WN;
    XcdBarrier barA = xcd_barrier_post((unsigned*)(ws + WS_CTL) + CW_BAR, MISC + 8, (unsigned)G);
    XcdBarrier barW; barW.bar = (unsigned*)(ws + WS_CTL) + CW_BAR2; barW.x = 0; barW.st = MISC + 12; barW.G = (unsigned)WN;
    if (worker) barW = xcd_barrier_post((unsigned*)(ws + WS_CTL) + CW_BAR2, MISC + 12, (unsigned)WN);

    { Frame F; fill_frame(F, args, lds_base, bx, G); p0_norm(F); p0_weff(F); p0_router_fold(F); p0_weights_range(F, I_MOE, NITEMS); __syncthreads(); }
    xcd_barrier(barA);
    if (!worker) {
        Frame F; fill_frame(F, args, lds_base, bx - WN, G - WN); p0_weights_range(F, 0, I_MOE); __syncthreads();
    } else {
        { Frame F; fill_frame(F, args, lds_base, bx, WN); pg8::Gemm g{F.hn, F.Bt1, MP, NPROJ, D}; pg8::StaticOrder S; S.init(MP, NPROJ, WN, bx);
          EpiProj E{F.proj}; pg8::gemm_phase<EpiProj, pg8::StaticOrder, true, true>(F.lds, g, S, E); }
        xcd_barrier(barW);
        { Frame F; fill_frame(F, args, lds_base, bx, WN); p2_elem(F); }
        xcd_barrier(barW);
        { Frame F; fill_frame(F, args, lds_base, bx, WN); p3_states(F); }
        xcd_barrier(barW);
        { Frame F; fill_frame(F, args, lds_base, bx, WN); p4_scan(F); }
        xcd_barrier(barW);
        { Frame F; fill_frame(F, args, lds_base, bx, WN); p5_out(F); }
        xcd_barrier(barW);
        { Frame F; fill_frame(F, args, lds_base, bx, WN); pg8::Gemm g{F.ycat, F.Bt2, SEQ, D, D}; pg8::StaticOrder S; S.init(SEQ, D, WN, bx);
          EpiH2 E{F.x, F.h2}; pg8::gemm_phase<EpiH2, pg8::StaticOrder, true, true>(F.lds, g, S, E); }
        xcd_barrier(barW);
        { Frame F; fill_frame(F, args, lds_base, bx, WN); p7_router(F); }
        xcd_barrier(barW);
        { Frame F; fill_frame(F, args, lds_base, bx, WN); p8_route(F); }
    }
    xcd_barrier(barA);
    { Frame F; fill_frame(F, args, lds_base, bx, G); LAS int* tl = (LAS int*)(lds_base + MISC_OFF + 1024);
      if (F.tid < 256) tl[F.tid] = F.tile[F.tid];
      LDS_WAIT(); __syncthreads();
      const int ntiles = __builtin_amdgcn_readfirstlane(tl[255]);
      MoeOrder S; S.init(tl, ntiles, 16, G, bx); S.rowtok = (const int*)F.xs;
      pg8::Gemm g{F.hn2, F.Btgu, SEQ, NE * 4096, D}; EpiGU8 E{(unsigned char*)F.abuf, F.b_gate, F.b_up}; pg8::gemm_phase<EpiGU8, MoeOrder, true, true, true, true>(F.lds, g, S, E); }
    xcd_barrier(barA);
    { Frame F; fill_frame(F, args, lds_base, bx, G); LAS int* tl = (LAS int*)(lds_base + MISC_OFF + 1024);
      if (F.tid < 256) tl[F.tid] = F.tile[F.tid];
      LDS_WAIT(); __syncthreads();
      const int ntiles = __builtin_amdgcn_readfirstlane(tl[255]);
      MoeOrder S; S.init(tl, ntiles, 8, G, bx);
      pg8::Gemm g{F.abuf, F.Btd, RPAD, NE * D, D}; EpiDown8 E{(unsigned char*)F.obuf, F.b_down}; pg8::gemm_phase<EpiDown8, MoeOrder, true, true, true>(F.lds, g, S, E); }
    xcd_barrier(barA);
    { Frame F; fill_frame(F, args, lds_base, bx, G); p11_final(F); }
}

extern "C" void kernel_launch(void* const* d_in, const int* in_sizes, int n_in, void* d_out, int out_size, void* d_ws, size_t ws_size, hipStream_t stream) {
    static int grid = 0;
    if (grid == 0) {
        if (n_in != 23 || out_size != SEQ * D || ws_size < WS_END) { fprintf(stderr, "kernel_launch: unexpected shapes (n_in %d out %d ws %zu need %zu)\n", n_in, out_size, ws_size, (size_t)WS_END); grid = -1; return; }
        int dev = 0, cus = 0, per_cu = 0;
        if (hipGetDevice(&dev) != hipSuccess || hipDeviceGetAttribute(&cus, hipDeviceAttributeMultiprocessorCount, dev) != hipSuccess) { grid = -1; return; }
        if (hipFuncSetAttribute((const void*)fwd, hipFuncAttributeMaxDynamicSharedMemorySize, LDS_BYTES) != hipSuccess) { fprintf(stderr, "kernel_launch: hipFuncSetAttribute failed\n"); grid = -1; return; }
        if (hipOccupancyMaxActiveBlocksPerMultiprocessor(&per_cu, (const void*)fwd, NWAVES * 64, LDS_BYTES) != hipSuccess || per_cu < 1) fprintf(stderr, "kernel_launch: occupancy query says %d\n", per_cu);
        (void)hipGetLastError();
        grid = 256;
        if (cus < 256) { fprintf(stderr, "kernel_launch: needs 256 CUs, device has %d\n", cus); grid = -1; return; }
    }
    if (grid < 0) return;
    Args a{};
    for (int i = 0; i < 23; ++i) a.in[i] = (const float*)d_in[i];
    a.out = (float*)d_out; a.ws = (unsigned char*)d_ws;
    (void)hipMemsetAsync((char*)d_ws + WS_CTL, 0, CTL_BYTES, stream);
    a.ph_lo = 0; a.ph_hi = NPH;
    hipLaunchKernelGGL(fwd, dim3(grid), dim3(NWAVES * 64), LDS_BYTES, stream, a);
}
```

```cpp
#include <hip/hip_runtime.h>
#include <cstdio>
#include <cstdint>
namespace pg8 {
#define PG8_LAS __attribute__((address_space(3)))
typedef unsigned short bf16_t;
typedef short bf16x8 __attribute__((ext_vector_type(8)));
typedef float f32x4 __attribute__((ext_vector_type(4)));
typedef unsigned u32x4 __attribute__((ext_vector_type(4)));
typedef int i32x8 __attribute__((ext_vector_type(8)));
constexpr int BM = 256, BK = 64, HALF = 128, HTB = HALF * BK * 2  , STAGE_BYTES = 8 * HTB, NXCD = 8, WGM = 8;

__host__ __device__ __forceinline__ int lds_byte(int r, int c) { const int st = (r >> 4) * 2 + (c >> 5), rr = r & 15, cc = c & 31, ob = rr * 64 + cc * 2; return st * 1024 + (ob ^ (((ob >> 9) & 1) << 5)); }
__host__ __device__ __forceinline__ void stage_rc(int b, int& R, int& C) { const int st = b / 1024, sb = b % 1024, swz = sb ^ (((sb >> 9) & 1) << 5); R = (st >> 1) * 16 + swz / 64; C = (st & 1) * 32 + (swz % 64) / 2; }
__host__ __device__ __forceinline__ int perm32(int rho) { const int n = rho >> 4, i = rho & 15; return 8 * (i >> 2) + 4 * n + (i & 3); }

struct Unit { int pm, pn; };
struct Gemm { const bf16_t* A; const bf16_t* Bt; int M, N, K; };

struct StaticOrder {
    int nM, nN, nwg, G, c;
    __host__ __device__ void init(int M, int N, int G_, int c_) { nM = M / BM; nN = N / BM; nwg = nM * nN; G = G_; c = c_; }
    __host__ __device__ bool next(int i, Unit& u) const {
        const long L = (long)i * G + c; if (L >= nwg) return false;
        int wgid = (int)L; { const int q = nwg / NXCD, r = nwg % NXCD, xcd = wgid % NXCD, off = wgid / NXCD; wgid = (xcd < r ? xcd * (q + 1) : r * (q + 1) + (xcd - r) * q) + off; }
        const int nig = WGM * nN, gid = wgid / nig, fm = gid * WGM, gsz = (nM - fm) < WGM ? (nM - fm) : WGM;
        u.pm = fm + ((wgid % nig) % gsz); u.pn = (wgid % nig) / gsz; return true;
    }
    __device__ __forceinline__ void a_ready(const Unit&) const {}
    __device__ __forceinline__ void done(const Unit&) const {}
};

__device__ __forceinline__ unsigned cvt_pk_bf16(float lo, float hi) { unsigned r; asm volatile("v_cvt_pk_bf16_f32 %0, %1, %2" : "=v"(r) : "v"(lo), "v"(hi)); return r; }
template <class Epi, class Sched, bool ALIGN_EPI = false, bool SP2 = false, bool F8 = false, bool GATHER = false>
__device__ __forceinline__ void gemm_phase(PG8_LAS unsigned char* lds, const Gemm g, const Sched& S, const Epi& E) {
    const int tid = threadIdx.x, wid = __builtin_amdgcn_readfirstlane(tid >> 6), lane = tid & 63, wr = wid >> 2, wc = wid & 3, fr = lane & 15, fq = lane >> 4;
    const int KB = F8 ? g.K : 2 * g.K  , nt = KB / 128;
    static_assert(!GATHER || (F8 && SP2), "the gather path exists in the fp8 two-super-phase loop only");
    unsigned voffA[2], voffB[2]; int gR[2]; unsigned gC[2];
    unsigned gA0[2], gA1[2], gN0[2], gN1[2]; int gT[4];
#pragma unroll
    for (int i = 0; i < 2; ++i) { int R, C; stage_rc(tid * 16 + i * 8192, R, C); const int Rb = Epi::PERM ? ((R & ~31) + perm32(R & 31)) : R;
        voffA[i] = (unsigned)(R * KB + C * 2); voffB[i] = (unsigned)(Rb * KB + C * 2); gR[i] = R; gC[i] = (unsigned)(C * 2); }
    const size_t kstep = (size_t)(BK * 2);
    const size_t hstep = (size_t)HALF * KB;
    const size_t tstep = 2 * hstep;
    const unsigned ldsw = (unsigned)wid * 1024u;
    const int aoff = lds_byte(wr * 64 + fr, F8 ? fq * 16 : fq * 8), boff = lds_byte(wc * 32 + fr, F8 ? fq * 16 : fq * 8);

#define PG8_SA(b, h) (((b) * 2 + (h)) * HTB)
#define PG8_SB(b, h) ((4 + (b) * 2 + (h)) * HTB)
#define PG8_STAGE(bufoff, gbase, voff) do { if constexpr (F8) { const char* gb_ = (const char*)(gbase); _Pragma("unroll") for (int _i = 0; _i < 2; ++_i) { \
        const unsigned la_ = (unsigned)(size_t)(lds + (bufoff) + ldsw + _i * 8192); \
        asm volatile("s_mov_b32 m0, %2\n\ts_nop 4\n\tglobal_load_lds_dwordx4 %0, %1" :: "v"((voff)[_i]), "s"(gb_), "s"(la_) : "memory", "m0"); } } else { \
        _Pragma("unroll") for (int _i = 0; _i < 2; ++_i) \
        __builtin_amdgcn_global_load_lds((const unsigned*)((const char*)(gbase) + (voff)[_i]), (PG8_LAS unsigned*)(lds + (bufoff) + ldsw + _i * 8192), 16, 0, 0); } } while (0)
#define PG8_STAGE_A(bufoff, base, h, useN) do { if constexpr (GATHER) { unsigned v_[2]; \
        v_[0] = (useN) ? ((h) ? gN1[0] : gN0[0]) : ((h) ? gA1[0] : gA0[0]); v_[1] = (useN) ? ((h) ? gN1[1] : gN0[1]) : ((h) ? gA1[1] : gA0[1]); PG8_STAGE(bufoff, base, v_); } \
        else { PG8_STAGE(bufoff, (base) + (h) * hstep, voffA); } } while (0)
#define PG8_GROWS_ISSUE(u) do { const int* rt_ = S.rowtok + (size_t)(u).pm * 256; \
        asm volatile("global_load_dword %0, %1, off" : "=v"(gT[0]) : "v"(rt_ + gR[0]) : "memory"); asm volatile("global_load_dword %0, %1, off" : "=v"(gT[1]) : "v"(rt_ + gR[1]) : "memory"); \
        asm volatile("global_load_dword %0, %1, off" : "=v"(gT[2]) : "v"(rt_ + 128 + gR[0]) : "memory"); asm volatile("global_load_dword %0, %1, off" : "=v"(gT[3]) : "v"(rt_ + 128 + gR[1]) : "memory"); } while (0)
#define PG8_GROWS_USE(d0, d1) do { asm volatile("" : "+v"(gT[0]), "+v"(gT[1]), "+v"(gT[2]), "+v"(gT[3])); \
        d0[0] = (unsigned)gT[0] * (unsigned)KB + gC[0]; d0[1] = (unsigned)gT[1] * (unsigned)KB + gC[1]; d1[0] = (unsigned)gT[2] * (unsigned)KB + gC[0]; d1[1] = (unsigned)gT[3] * (unsigned)KB + gC[1]; } while (0)
#define PG8_LDA(dst, b, h) do { if constexpr (F8) { _Pragma("unroll") for (int m = 0; m < 4; ++m) dst##8[m] = *(const PG8_LAS i32x8*)(lds + PG8_SA(b, h) + aoff + m * 2048); } else { \
        _Pragma("unroll") for (int m = 0; m < 4; ++m) _Pragma("unroll") for (int k = 0; k < 2; ++k) dst[m][k] = *(const PG8_LAS bf16x8*)(lds + PG8_SA(b, h) + aoff + m * 2048 + k * 1024); } } while (0)
#define PG8_LDB(dst, b, h) do { if constexpr (F8) { _Pragma("unroll") for (int n = 0; n < 2; ++n) dst##8[n] = *(const PG8_LAS i32x8*)(lds + PG8_SB(b, h) + boff + n * 2048); } else { \
        _Pragma("unroll") for (int n = 0; n < 2; ++n) _Pragma("unroll") for (int k = 0; k < 2; ++k) dst[n][k] = *(const PG8_LAS bf16x8*)(lds + PG8_SB(b, h) + boff + n * 2048 + k * 1024); } } while (0)
#define PG8_MMA(ai, bj, At, Bt) do { __builtin_amdgcn_s_setprio(1); if constexpr (F8) { _Pragma("unroll") for (int m = 0; m < 4; ++m) _Pragma("unroll") for (int n = 0; n < 2; ++n) \
        asm volatile("v_mfma_scale_f32_16x16x128_f8f6f4 %0, %1, %2, %0, %3, %3 op_sel_hi:[0,0,0]" : "+v"(acc[ai][bj][m][n]) : "v"(Bt##8[n]), "v"(At##8[m]), "v"(f8scale)); } else {     \
        _Pragma("unroll") for (int m = 0; m < 4; ++m) _Pragma("unroll") for (int n = 0; n < 2; ++n) _Pragma("unroll") for (int k = 0; k < 2; ++k) \
        acc[ai][bj][m][n] = __builtin_amdgcn_mfma_f32_16x16x32_bf16(Bt[n][k], At[m][k], acc[ai][bj][m][n], 0, 0, 0); } __builtin_amdgcn_s_setprio(0); } while (0)
#define PG8_WAIT_V(n) asm volatile("s_waitcnt vmcnt(" #n ")" ::: "memory")
#define PG8_WAIT_L(n) asm volatile("s_waitcnt lgkmcnt(" #n ")" ::: "memory")
#define PG8_BAR __builtin_amdgcn_s_barrier()
#define PG8_SCHED __builtin_amdgcn_sched_barrier(0)
    Unit cur, nxt; int ui = 0;
    if (!S.next(0, cur)) return;
    f32x4 acc[2][2][4][2];
#pragma unroll
    for (int a = 0; a < 2; ++a)
#pragma unroll
        for (int b = 0; b < 2; ++b)
#pragma unroll
            for (int m = 0; m < 4; ++m)
#pragma unroll
                for (int n = 0; n < 2; ++n) acc[a][b][m][n] = (f32x4){0.f, 0.f, 0.f, 0.f};
    const int f8scale = 0x7f7f7f7f;
    bf16x8 At[4][2], B0[2][2], B1[2][2]; i32x8 At8[4], B08[2], B18[2];
    const char* cA = GATHER ? (const char*)g.A : (const char*)g.A + (size_t)cur.pm * tstep; const char* cB = (const char*)g.Bt + (size_t)cur.pn * tstep;
    S.a_ready(cur);
    if constexpr (GATHER) { PG8_GROWS_ISSUE(cur); asm volatile("s_waitcnt vmcnt(0)" ::: "memory"); PG8_GROWS_USE(gA0, gA1); }
    if constexpr (SP2) {
        PG8_STAGE(PG8_SB(0, 0), cB, voffB); PG8_STAGE(PG8_SB(0, 1), cB + hstep, voffB); PG8_STAGE_A(PG8_SA(0, 0), cA, 0, false); PG8_STAGE_A(PG8_SA(0, 1), cA, 1, false);
        if (wr == 1) PG8_BAR;
        PG8_WAIT_V(2); PG8_BAR;
        PG8_STAGE(PG8_SB(1, 0), cB + kstep, voffB); PG8_STAGE_A(PG8_SA(1, 0), cA + kstep, 0, false); PG8_STAGE(PG8_SB(1, 1), cB + hstep + kstep, voffB);
        PG8_WAIT_V(6); PG8_BAR;
    } else {
        PG8_STAGE(PG8_SB(0, 0), cB, voffB); PG8_STAGE(PG8_SA(0, 0), cA, voffA); PG8_STAGE(PG8_SB(0, 1), cB + hstep, voffB); PG8_STAGE(PG8_SA(0, 1), cA + hstep, voffA);
        if (wr == 1) PG8_BAR;
        PG8_WAIT_V(4); PG8_BAR;
        PG8_STAGE(PG8_SB(1, 0), cB + kstep, voffB); PG8_STAGE(PG8_SA(1, 0), cA + kstep, voffA); PG8_STAGE(PG8_SB(1, 1), cB + hstep + kstep, voffB);
        PG8_WAIT_V(6); PG8_BAR;
    }
    for (;;) {
        const bool has_next = S.next(ui + 1, nxt);
        const char* nA = GATHER ? (const char*)g.A : (has_next ? (const char*)g.A + (size_t)nxt.pm * tstep : cA); const char* nB = has_next ? (const char*)g.Bt + (size_t)nxt.pn * tstep : cB;
        if constexpr (GATHER) { if (has_next) PG8_GROWS_ISSUE(nxt); }
        for (int t = 0; t < nt; t += 2) {
            const bool last = (t == nt - 2);
            const char* a1 = cA + (size_t)(t + 1) * kstep;
            const char* a2 = last ? nA : cA + (size_t)(t + 2) * kstep; const char* b2 = last ? nB : cB + (size_t)(t + 2) * kstep;
            const char* a3 = a2 + kstep; const char* b3 = b2 + kstep;
            if (last && has_next) S.a_ready(nxt);
            if constexpr (SP2) {
            PG8_LDB(B0, 0, 0); PG8_LDB(B1, 0, 1); PG8_SCHED; PG8_LDA(At, 0, 0); PG8_STAGE_A(PG8_SA(1, 1), a1, 1, false);
            PG8_WAIT_V(8); PG8_WAIT_L(0);
            if constexpr (GATHER) { if (last) { if (has_next) PG8_GROWS_USE(gN0, gN1); else { gN0[0] = gA0[0]; gN0[1] = gA0[1]; gN1[0] = gA1[0]; gN1[1] = gA1[1]; } } }
            PG8_BAR; PG8_MMA(0, 0, At, B0); PG8_MMA(0, 1, At, B1); PG8_BAR; PG8_SCHED;
            PG8_LDA(At, 0, 1); PG8_STAGE(PG8_SB(0, 0), b2, voffB); PG8_STAGE(PG8_SB(0, 1), b2 + hstep, voffB); PG8_STAGE_A(PG8_SA(0, 0), a2, 0, last);
            PG8_WAIT_V(8); PG8_WAIT_L(0); PG8_BAR; PG8_MMA(1, 0, At, B0); PG8_MMA(1, 1, At, B1); PG8_BAR; PG8_SCHED;
            PG8_LDB(B0, 1, 0); PG8_LDB(B1, 1, 1); PG8_SCHED; PG8_LDA(At, 1, 0); PG8_STAGE_A(PG8_SA(0, 1), a2, 1, last);
            PG8_WAIT_V(8); PG8_WAIT_L(0); PG8_BAR; PG8_MMA(0, 0, At, B0); PG8_MMA(0, 1, At, B1); PG8_BAR; PG8_SCHED;
            PG8_LDA(At, 1, 1); PG8_STAGE(PG8_SB(1, 0), b3, voffB); PG8_STAGE(PG8_SB(1, 1), b3 + hstep, voffB); PG8_STAGE_A(PG8_SA(1, 0), a3, 0, last);
            PG8_WAIT_V(8); PG8_WAIT_L(0); PG8_BAR; PG8_MMA(1, 0, At, B0); PG8_MMA(1, 1, At, B1); PG8_BAR; PG8_SCHED;
            } else {
            PG8_LDB(B0, 0, 0); PG8_SCHED; PG8_LDA(At, 0, 0); PG8_STAGE(PG8_SA(1, 1), a1 + hstep, voffA);
            PG8_WAIT_L(8); PG8_BAR; PG8_WAIT_L(0); PG8_MMA(0, 0, At, B0); PG8_BAR; PG8_SCHED;
            PG8_LDB(B1, 0, 1); PG8_STAGE(PG8_SB(0, 0), b2, voffB);
            PG8_BAR; PG8_WAIT_L(0); PG8_MMA(0, 1, At, B1); PG8_BAR;
            PG8_LDA(At, 0, 1); PG8_STAGE(PG8_SA(0, 0), a2, voffA);
            PG8_BAR; PG8_WAIT_L(0); PG8_MMA(1, 0, At, B0); PG8_BAR; PG8_SCHED;
            PG8_STAGE(PG8_SB(0, 1), b2 + hstep, voffB);
            PG8_WAIT_V(6); PG8_BAR; PG8_MMA(1, 1, At, B1); PG8_BAR;
            PG8_LDB(B0, 1, 0); PG8_SCHED; PG8_LDA(At, 1, 0); PG8_STAGE(PG8_SA(0, 1), a2 + hstep, voffA);
            PG8_WAIT_L(8); PG8_BAR; PG8_WAIT_L(0); PG8_MMA(0, 0, At, B0); PG8_BAR; PG8_SCHED;
            PG8_LDB(B1, 1, 1); PG8_STAGE(PG8_SB(1, 0), b3, voffB);
            PG8_BAR; PG8_WAIT_L(0); PG8_MMA(0, 1, At, B1); PG8_BAR;
            PG8_LDA(At, 1, 1); PG8_STAGE(PG8_SA(1, 0), a3, voffA);
            PG8_BAR; PG8_WAIT_L(0); PG8_MMA(1, 0, At, B0); PG8_BAR; PG8_SCHED;
            PG8_STAGE(PG8_SB(1, 1), b3 + hstep, voffB);
            PG8_WAIT_V(6); PG8_BAR; PG8_MMA(1, 1, At, B1); PG8_BAR;
            }
        }
        if constexpr (ALIGN_EPI) { if (wr == 0) PG8_BAR; }
        if constexpr (F8) asm volatile("s_nop 15\n\ts_nop 7" ::: "memory");
        if constexpr (!Epi::AFTER_DRAIN) {
            int tz_ = threadIdx.x; asm volatile("" : "+v"(tz_)); const int l_ = tz_ & 63, w_ = __builtin_amdgcn_readfirstlane(tz_ >> 6);
            E(acc, cur, w_ >> 2, w_ & 3, l_ & 15, l_ >> 4); S.done(cur); }
        if (!has_next) break;
#pragma unroll
        for (int a = 0; a < 2; ++a)
#pragma unroll
            for (int b = 0; b < 2; ++b)
#pragma unroll
                for (int m = 0; m < 4; ++m)
#pragma unroll
                    for (int n = 0; n < 2; ++n) acc[a][b][m][n] = (f32x4){0.f, 0.f, 0.f, 0.f};
        cur = nxt; cA = nA; cB = nB; ++ui;
        if constexpr (GATHER) { gA0[0] = gN0[0]; gA0[1] = gN0[1]; gA1[0] = gN1[0]; gA1[1] = gN1[1]; }
        if constexpr (ALIGN_EPI) { if (wr == 1) PG8_BAR; }
    }
    PG8_WAIT_V(0);
    if constexpr (!ALIGN_EPI) { if (wr == 0) PG8_BAR; }
    PG8_BAR;
    if constexpr (Epi::AFTER_DRAIN) { E.fused(acc, cur, wr, wc, fr, fq, lds, wid, lane); S.done(cur); }
#undef PG8_SA
#undef PG8_SB
#undef PG8_STAGE
#undef PG8_STAGE_A
#undef PG8_GROWS_ISSUE
#undef PG8_GROWS_USE
#undef PG8_LDA
#undef PG8_LDB
#undef PG8_MMA
#undef PG8_WAIT_V
#undef PG8_WAIT_L
#undef PG8_BAR
#undef PG8_SCHED
}
}
#define LAS __attribute__((address_space(3)))
#define XB_TMO      128
#define XB_XCNT(j)  (256  + 64 * (j))
#define XB_XSUB(j)  (1280 + 64 * (j))
#define XB_XGEN(j)  (2304 + 64 * (j))
#define XB_TOP      3328
#define XB_TOPGEN   3392
#define XCD_BAR_WORDS 3456
#define XB_SPIN_CAP (1u << 18)

__device__ __forceinline__ unsigned xb_ld(unsigned* p)              { return __hip_atomic_load(p, __ATOMIC_RELAXED, __HIP_MEMORY_SCOPE_AGENT); }
__device__ __forceinline__ unsigned xb_add(unsigned* p, unsigned v) { return __hip_atomic_fetch_add(p, v, __ATOMIC_RELAXED, __HIP_MEMORY_SCOPE_AGENT); }
__device__ __forceinline__ unsigned xb_xcc_id() { return (unsigned)__builtin_amdgcn_s_getreg((3 << 11) | 20) & 0xFu; }
#define XB_SPIN(cond, bar) do { unsigned _sp = 0; while (cond) { __builtin_amdgcn_s_sleep(1); \
    if ((++_sp & 255u) == 0u) { if (xb_ld(&(bar)[XB_TMO])) break; if (_sp > XB_SPIN_CAP) { atomicAdd(&(bar)[XB_TMO], 1u); break; } } } } while (0)

struct XcdBarrier {
    unsigned* bar; unsigned x;
    volatile LAS unsigned* st;
    unsigned G;
};

__device__ __forceinline__ XcdBarrier xcd_barrier_post(unsigned* bar, volatile LAS unsigned* st, unsigned G) {
    XcdBarrier b; b.bar = bar; b.x = xb_xcc_id(); b.st = st; b.G = G;
    if (threadIdx.x == 0) (void)xb_add(&bar[XB_XCNT(b.x)], 1u);
    return b;
}
__device__ __forceinline__ void xcd_barrier_complete(unsigned* bar, unsigned x, unsigned& nloc, unsigned& nx, const unsigned G) {
    unsigned sum, cnt, mine, sp = 0u;
    for (;;) {
        sum = 0u; cnt = 0u; mine = 0u;
#pragma unroll
        for (unsigned j = 0; j < 16; ++j) { const unsigned c = xb_ld(&bar[XB_XCNT(j)]); sum += c; cnt += (c > 0u) ? 1u : 0u; mine = (j == x) ? c : mine; }
        if (sum == G) break;
        __builtin_amdgcn_s_sleep(1);
        if ((++sp & 255u) == 0u) { if (xb_ld(&bar[XB_TMO])) break; if (sp > XB_SPIN_CAP) { atomicAdd(&bar[XB_TMO], 1u); break; } }
    }
    nloc = mine > 0u ? mine : 1u; nx = cnt > 0u ? cnt : 1u;
}

__device__ __forceinline__ void xcd_barrier(const XcdBarrier& b) {
    asm volatile("s_waitcnt vmcnt(0)" ::: "memory");
    __syncthreads();
    if (threadIdx.x == 0) {
        unsigned* bar = b.bar;
        __builtin_amdgcn_s_waitcnt(0);
        unsigned nloc = b.st[0], nx = b.st[1];
        if (nloc == 0u) { xcd_barrier_complete(bar, b.x, nloc, nx, b.G); b.st[0] = nloc; b.st[1] = nx; }
        const unsigned old = xb_add(&bar[XB_XSUB(b.x)], 1u);
        const unsigned gen = old / nloc;
        if (old + 1u == (gen + 1u) * nloc) {
            __builtin_amdgcn_fence(__ATOMIC_RELEASE, "agent");
            asm volatile("s_waitcnt vmcnt(0)" ::: "memory");
            const unsigned og = xb_add(&bar[XB_TOP], 1u);
            const unsigned tg = og / nx;
            if (og + 1u == (tg + 1u) * nx) xb_add(&bar[XB_TOPGEN], 1u);
            else XB_SPIN(xb_ld(&bar[XB_TOPGEN]) == tg, bar);
            __builtin_amdgcn_fence(__ATOMIC_ACQUIRE, "agent");
            xb_add(&bar[XB_XGEN(b.x)], 1u);
            asm volatile("s_waitcnt vmcnt(0)" ::: "memory");
        } else {
            XB_SPIN(xb_ld(&bar[XB_XGEN(b.x)]) == gen, bar);
            __builtin_amdgcn_fence(__ATOMIC_ACQUIRE, "agent");
            asm volatile("s_waitcnt vmcnt(0)" ::: "memory");
        }
    }
    __syncthreads();
}
constexpr int D = 2048, SEQ = 8192, NMETA = 16, LEAD = 48, NP = 8256  , MP = 8448  ;
constexpr int NPROJ = 3840, C_Z = 1024, C_X = 2048, C_B = 3072, C_C = 3328, C_DT = 3584, NINPROJ = 3600;
constexpr int NE = 32, DCONV = 1536;
constexpr int RTILES = 160, RPAD = RTILES * 256;
constexpr float EPS = 1e-5f;
constexpr int NWAVES = 8, NPH = 12;
#ifndef WN_WORKERS
#define WN_WORKERS 136
#endif
constexpr int WN = WN_WORKERS;
#ifndef MOE_F8
#define MOE_F8 1
#endif
#ifndef MOE_RB
#define MOE_RB 0
#endif
#ifndef MK_ONE_LAUNCH
#define MK_ONE_LAUNCH 1
#endif

constexpr size_t WS_CTL = 0, CTL_BYTES = 1u << 20;
constexpr size_t WS_HN = CTL_BYTES;
constexpr size_t WS_BT1 = WS_HN + (size_t)MP * D * 2;
constexpr size_t WS_BT2 = WS_BT1 + (size_t)NPROJ * D * 2;
constexpr size_t WS_PROJ = WS_BT2 + (size_t)D * D * 2;
constexpr size_t WS_XT = WS_PROJ + (size_t)MP * NPROJ * 2;
constexpr size_t WS_BTT = WS_XT + (size_t)1024 * NP * 2;
constexpr size_t WS_BC = WS_BTT + (size_t)256 * NP * 2;
constexpr size_t WS_CC = WS_BC + (size_t)NP * 256 * 2;
constexpr size_t WS_DT = WS_CC + (size_t)NP * 256 * 2;
constexpr size_t WS_ST = WS_DT + (size_t)NP * 16 * 4;
constexpr size_t WS_DEC = WS_ST + (size_t)128 * 131072 * 4;
constexpr size_t WS_PREV = WS_DEC + 128 * 16 * 4;
constexpr size_t WS_YCAT = WS_PREV + (size_t)128 * 131072 * 2;
constexpr size_t WS_H2 = WS_YCAT + (size_t)SEQ * D * 2;
constexpr size_t WS_HN2 = WS_H2 + (size_t)SEQ * D * 4;
constexpr size_t WS_WR = WS_HN2 + (size_t)SEQ * D * 2;
constexpr size_t WS_TKE = WS_WR + (size_t)D * NE * 4;
constexpr size_t WS_TKG = WS_TKE + (size_t)SEQ * 16;
constexpr size_t WS_POS = WS_TKG + (size_t)SEQ * 16;
constexpr size_t WS_CNT = WS_POS + (size_t)SEQ * 16;
constexpr size_t WS_TILE = WS_CNT + 256 * 32 * 4;
constexpr size_t WS_XS = WS_TILE + 1024;
constexpr size_t WS_A = WS_XS + (size_t)RPAD * D * 2;
constexpr size_t WS_O = WS_A + (size_t)RPAD * D * 2;
constexpr size_t WS_BTGU = WS_O + (MOE_F8 ? (size_t)RPAD * D * 2 : 0);
constexpr size_t WS_BTD = WS_BTGU + (size_t)NE * 4096 * D * (MOE_F8 ? 1 : 2);
constexpr size_t WS_END = WS_BTD + (size_t)NE * D * D * (MOE_F8 ? 1 : 2);
constexpr int CW_BAR = 4096, CW_BAR2 = 8192;
static_assert((CW_BAR2 + XCD_BAR_WORDS) * 4 <= (int)CTL_BYTES && CW_BAR + XCD_BAR_WORDS <= CW_BAR2, "ctl");

constexpr int RING_BYTES = 131072, SCR_BYTES = 135168, MISC_OFF = SCR_BYTES, LDS_BYTES = 147456;

#define DI __device__ __forceinline__
typedef unsigned short bf16;
typedef unsigned v4u __attribute__((ext_vector_type(4)));
typedef unsigned v2u __attribute__((ext_vector_type(2)));
typedef float f32x4 __attribute__((ext_vector_type(4)));
typedef float f32x16 __attribute__((ext_vector_type(16)));
typedef short bf16x8 __attribute__((ext_vector_type(8)));
#define LDS_WAIT() asm volatile("s_waitcnt lgkmcnt(0)" ::: "memory")
#define MFMA32(a, b, c) __builtin_amdgcn_mfma_f32_32x32x16_bf16((a), (b), (c), 0, 0, 0)
DI float bf_lo(unsigned w) { return __uint_as_float(w << 16); }
DI float bf_hi(unsigned w) { return __uint_as_float(w & 0xffff0000u); }
DI float bf2f(bf16 v) { return __uint_as_float(((unsigned)v) << 16); }
typedef __bf16 bf2v __attribute__((ext_vector_type(2)));
typedef float f2v __attribute__((ext_vector_type(2)));
DI unsigned pk2(float lo, float hi) { const f2v v = {lo, hi}; const bf2v b = __builtin_convertvector(v, bf2v); return __builtin_bit_cast(unsigned, b); }
DI unsigned pk4_f8(float a, float b, float c, float d) { int p = __builtin_amdgcn_cvt_pk_fp8_f32(a, b, 0, false); p = __builtin_amdgcn_cvt_pk_fp8_f32(c, d, p, true); return (unsigned)p; }
DI bf16 f2bf(float f) { return (bf16)(pk2(f, 0.f) & 0xffffu); }
DI float wave_sum(float v) {
#pragma unroll
    for (int o = 1; o < 64; o <<= 1) v += __shfl_xor(v, o);
    return v;
}
DI float wave_incl_scan(float v, int lane) {
#pragma unroll
    for (int o = 1; o < 64; o <<= 1) { const float t = __shfl_up(v, o); if (lane >= o) v += t; }
    return v;
}
DI float silu_f(float x) { return x * __builtin_amdgcn_rcpf(1.f + __expf(-x)); }

struct Frame {
    LAS unsigned char* lds;
    int tid, lane, wave, gw, ngw, bid, nwg;
    const float *x, *meta, *g1, *w_in, *pool_w, *pool_scale, *conv_w, *conv_b, *dt_bias, *a_log, *d_skip, *ssm_g, *w_out, *g2, *router_w, *router_b,
        *w_gate, *b_gate, *w_up, *b_up, *w_down, *b_down, *final_g;
    float* out;
    bf16 *hn, *Bt1, *Bt2, *proj, *xT, *BT, *Bc, *Cc, *prev, *ycat, *hn2, *xs, *abuf, *obuf, *Btgu, *Btd;
    float *dtv, *decay, *Wr, *tkg; bf16 *states, *h2;
    int *tke, *pos, *cnt, *tile;
};

DI int crow16(int reg, int hf) { return (reg & 3) + 8 * (reg >> 2) + 4 * hf; }
DI void p0_norm(Frame& F) {
    const f32x4* gr = (const f32x4*)F.g1 + F.lane;
    for (int P0 = F.gw; P0 < NP; P0 += 2 * F.ngw) {
        f32x4 v[2][8]; bool live[2];
#pragma unroll
        for (int u = 0; u < 2; ++u) { const int P = P0 + u * F.ngw; live[u] = (P >= LEAD && P < NP);
            const int t = live[u] ? P - LEAD : 0;
            const float* src = t < NMETA ? F.meta + (size_t)t * D : F.x + (size_t)(t - NMETA) * D;
            const f32x4* xr = (const f32x4*)src + F.lane;
#pragma unroll
            for (int j = 0; j < 8; ++j) v[u][j] = xr[64 * j]; }
#pragma unroll
        for (int u = 0; u < 2; ++u) { const int P = P0 + u * F.ngw; if (P >= NP) continue;
            unsigned long long* o8 = (unsigned long long*)(F.hn + (size_t)P * D) + F.lane;
            if (!live[u]) {
#pragma unroll
                for (int j = 0; j < 8; ++j) o8[64 * j] = 0ull;
                continue; }
            float s = 0.f;
#pragma unroll
            for (int j = 0; j < 8; ++j) s += (v[u][j].x * v[u][j].x + v[u][j].y * v[u][j].y) + (v[u][j].z * v[u][j].z + v[u][j].w * v[u][j].w);
            const float rstd = rsqrtf(wave_sum(s) * (1.f / D) + EPS);
#pragma unroll
            for (int j = 0; j < 8; ++j) { const f32x4 g = gr[64 * j];
                o8[64 * j] = (unsigned long long)pk2(v[u][j].x * rstd * g.x, v[u][j].y * rstd * g.y) | ((unsigned long long)pk2(v[u][j].z * rstd * g.z, v[u][j].w * rstd * g.w) << 32); }
        }
    }
}
DI void tr_load(float (&v)[64], const float* W, size_t ldw, int nvalid, int lane) {
    const float* wp = W + lane;
    if (lane < nvalid) {
#pragma unroll
        for (int kk = 0; kk < 64; ++kk) v[kk] = __builtin_nontemporal_load(wp + (size_t)kk * ldw);
    } else {
#pragma unroll
        for (int kk = 0; kk < 64; ++kk) v[kk] = 0.f;
    }
}
DI void tr_store(const float (&v)[64], int nvalid, bf16* WT, size_t ldt, LAS float* scr, int lane) {
#pragma unroll
    for (int kk = 0; kk < 64; ++kk) scr[kk * 65 + lane] = v[kk];
    LDS_WAIT();
    const int c = lane & 7;
#pragma unroll
    for (int j = 0; j < 8; ++j) { const int n = (lane >> 3) + 8 * j; const LAS float* s = scr + (8 * c) * 65 + n;
        v4u o; o.x = pk2(s[0], s[65]); o.y = pk2(s[130], s[195]); o.z = pk2(s[260], s[325]); o.w = pk2(s[390], s[455]);
        if (n < nvalid) *(v4u*)(WT + (size_t)n * ldt + 8 * c) = o; }
    LDS_WAIT();
}
DI void tr_store8(const float (&v)[64], unsigned char* WT, size_t ldt, LAS float* scr, int lane, float scale) {
#pragma unroll
    for (int kk = 0; kk < 64; ++kk) scr[kk * 65 + lane] = v[kk] * scale;
    LDS_WAIT();
    const int c = lane & 3;
#pragma unroll
    for (int j = 0; j < 4; ++j) { const int n = (lane >> 2) + 16 * j; const LAS float* s = scr + (16 * c) * 65 + n;
        v4u o; o.x = pk4_f8(s[0], s[65], s[130], s[195]); o.y = pk4_f8(s[260], s[325], s[390], s[455]);
        o.z = pk4_f8(s[520], s[585], s[650], s[715]); o.w = pk4_f8(s[780], s[845], s[910], s[975]);
        *(v4u*)(WT + (size_t)n * ldt + 16 * c) = o; }
    LDS_WAIT();
}
struct TrItem { const float* W; bf16* WT; int ldw, nv; };
constexpr int I_IN = 32 * 57, I_OUT = 16 * 32, I_MOE = MOE_RB ? 0 : NE * 3 * 32 * 32, NITEMS = I_IN + I_OUT + I_MOE;
constexpr float W8_SCALE = 1024.f, X8_SCALE = 16.f, A8_SCALE = 4.f, O8_SCALE = 16.f;
DI TrItem tr_get(Frame& F, int it) {
    TrItem t; int r = it;
    if (r < I_MOE) {
        const int nb = r & 31, kb = (r >> 5) & 31, em = r >> 10, mat = em % 3, e = em / 3;
        t.ldw = D; t.nv = 64;
        constexpr int ES = MOE_F8 ? 1 : 2;
        if (mat == 2) { t.W = F.w_down + (size_t)e * D * D + (size_t)(64 * kb) * D + 64 * nb; t.WT = (bf16*)((unsigned char*)F.Btd + (((size_t)e * D + 64 * nb) * D + 64 * kb) * ES); }
        else { t.W = (mat == 0 ? F.w_gate : F.w_up) + (size_t)e * D * D + (size_t)(64 * kb) * D + 64 * nb;
               const int row = 256 * (nb >> 1) + 64 * (nb & 1) + 128 * mat; t.WT = (bf16*)((unsigned char*)F.Btgu + (((size_t)e * 4096 + row) * D + 64 * kb) * ES); }
        return t;
    }
    r -= I_MOE;
    if (r < I_IN) { const int kb = r / 57, nb = r % 57; t.ldw = NINPROJ; t.nv = (nb == 56) ? 16 : 64;
        t.W = F.w_in + (size_t)(64 * kb) * NINPROJ + 64 * nb; t.WT = F.Bt1 + (size_t)(64 * nb) * D + 64 * kb; return t; }
    r -= I_IN;
    { const int kb = r >> 5, nb = r & 31; t.ldw = D; t.nv = 64;
      t.W = F.w_out + (size_t)(1024 + 64 * kb) * D + 64 * nb; t.WT = F.Bt2 + (size_t)(64 * nb) * D + 1024 + 64 * kb; return t; }
}
DI void p0_weights_range(Frame& F, const int it_lo, const int it_hi) {
    LAS float* scr = (LAS float*)(F.lds + F.wave * 16640);
    float va[64], vb[64];
    int it = it_lo + F.gw;
    if (it >= it_hi) return;
    TrItem ta = tr_get(F, it), tb = ta;
    tr_load(va, ta.W, ta.ldw, ta.nv, F.lane);
    for (;;) {
        const bool hb = it + F.ngw < it_hi;
        if (hb) { tb = tr_get(F, it + F.ngw); tr_load(vb, tb.W, tb.ldw, tb.nv, F.lane); }
        if (MOE_F8 && it < I_MOE) tr_store8(va, (unsigned char*)ta.WT, D, scr, F.lane, W8_SCALE); else tr_store(va, ta.nv, ta.WT, D, scr, F.lane);
        if (!hb) break;
        it += F.ngw;
        const bool ha = it + F.ngw < it_hi;
        if (ha) { ta = tr_get(F, it + F.ngw); tr_load(va, ta.W, ta.ldw, ta.nv, F.lane); }
        if (MOE_F8 && it < I_MOE) tr_store8(vb, (unsigned char*)tb.WT, D, scr, F.lane, W8_SCALE); else tr_store(vb, tb.nv, tb.WT, D, scr, F.lane);
        if (!ha) break;
        it += F.ngw;
    }
}
DI void p0_weff(Frame& F) {
    const int lane = F.lane, li = lane & 31, kh = lane >> 5;
    for (int task = F.gw; task < 2048; task += F.ngw) {
        const int g = task >> 9, rem = task & 511, cb = rem >> 6, nb = rem & 63;
        const float* wo = F.w_out + (size_t)(256 * g + 4 * kh) * D + 32 * nb + li;
        const float* ps = F.pool_scale + 256 * g + 4 * kh;
        const float* pw = F.pool_w + (size_t)(g * 256 + 32 * cb + li) * 256 + 4 * kh;
        f32x16 acc;
#pragma unroll
        for (int i = 0; i < 16; ++i) acc[i] = 0.f;
#pragma unroll 8
        for (int jj = 0; jj < 32; ++jj) {
            const f32x4 b = *(const f32x4*)(pw + 8 * jj), sc = *(const f32x4*)(ps + 8 * jj);
            const float a0 = wo[(size_t)(8 * jj) * D] * sc.x, a1 = wo[(size_t)(8 * jj + 1) * D] * sc.y, a2 = wo[(size_t)(8 * jj + 2) * D] * sc.z, a3 = wo[(size_t)(8 * jj + 3) * D] * sc.w;
            acc = __builtin_amdgcn_mfma_f32_32x32x2f32(a0, b.x, acc, 0, 0, 0);
            acc = __builtin_amdgcn_mfma_f32_32x32x2f32(a1, b.y, acc, 0, 0, 0);
            acc = __builtin_amdgcn_mfma_f32_32x32x2f32(a2, b.z, acc, 0, 0, 0);
            acc = __builtin_amdgcn_mfma_f32_32x32x2f32(a3, b.w, acc, 0, 0, 0);
        }
        bf16* dst = F.Bt2 + (size_t)(32 * nb) * D + 256 * g + 32 * cb + li;
#pragma unroll
        for (int i = 0; i < 16; ++i) dst[(size_t)crow16(i, kh) * D] = f2bf(acc[i]);
    }
}
DI void p0_router_fold(Frame& F) {
    for (int i = F.bid * 512 + F.tid; i < D * NE; i += F.nwg * 512) F.Wr[i] = F.g2[i >> 5] * F.router_w[i];
}

DI void e_conv_tile(Frame& F, int c, int pcol, int cch, bf16* outT, bf16* outR, int rcol) {
    const int lane = F.lane, ch = cch + lane;
    const float w0 = F.conv_w[ch], w1 = F.conv_w[DCONV + ch], w2 = F.conv_w[2 * DCONV + ch], w3 = F.conv_w[3 * DCONV + ch], b = F.conv_b[ch];
    const bf16* src = F.proj + pcol + lane;
    const int P0 = 64 * c;
    bf16 raw[67];
#pragma unroll
    for (int i = 0; i < 3; ++i) raw[i] = (P0 - 3 + i >= 0) ? src[(size_t)(P0 - 3 + i) * NPROJ] : (bf16)0;
#pragma unroll
    for (int i = 0; i < 64; ++i) raw[3 + i] = src[(size_t)(P0 + i) * NPROJ];
#pragma unroll
    for (int sb = 0; sb < 4; ++sb) {
        float o[16];
#pragma unroll
        for (int i = 0; i < 16; ++i) { const int q = 16 * sb + i;
            const float a = b + w0 * bf2f(raw[q]) + w1 * bf2f(raw[q + 1]) + w2 * bf2f(raw[q + 2]) + w3 * bf2f(raw[q + 3]);
            o[i] = (P0 + q >= LEAD) ? silu_f(a) : 0.f; }
        if (outT) { v4u q0, q1;
            q0.x = pk2(o[0], o[1]); q0.y = pk2(o[2], o[3]); q0.z = pk2(o[4], o[5]); q0.w = pk2(o[6], o[7]);
            q1.x = pk2(o[8], o[9]); q1.y = pk2(o[10], o[11]); q1.z = pk2(o[12], o[13]); q1.w = pk2(o[14], o[15]);
            bf16* dst = outT + (size_t)lane * NP + P0 + 16 * sb; *(v4u*)dst = q0; *(v4u*)(dst + 8) = q1; }
        if (outR) {
#pragma unroll
            for (int i = 0; i < 16; ++i) outR[(size_t)(P0 + 16 * sb + i) * 256 + rcol + lane] = f2bf(o[i]); }
    }
}
template <int W> DI void e_pool_tile(Frame& F, int c, int colbase) {
    const int lane = F.lane; const bf16* src = F.proj + colbase + lane; const int P0 = 64 * c;
    bf16 raw[64 + W - 1];
#pragma unroll
    for (int i = 0; i < 64 + W - 1; ++i) raw[i] = src[(size_t)(P0 - (W - 1) + i) * NPROJ];
#pragma unroll
    for (int sb = 0; sb < 4; ++sb) {
#pragma unroll
        for (int i = 0; i < 16; ++i) { const int q = 16 * sb + i; float s = 0.f;
#pragma unroll
            for (int j = 0; j < W; ++j) s += bf2f(raw[q + j]);
            F.ycat[(size_t)(P0 - 64 + q) * D + colbase + lane] = f2bf(s * (1.f / W) - bf2f(raw[q + W - 1])); }
    }
}
DI void e_dt_tile(Frame& F, int c) {
    const int P = 64 * c + F.lane;
    const v4u* src = (const v4u*)(F.proj + (size_t)P * NPROJ + C_DT);
    const v4u r0 = src[0], r1 = src[1];
    const unsigned w[8] = {r0.x, r0.y, r0.z, r0.w, r1.x, r1.y, r1.z, r1.w};
    float o[16];
#pragma unroll
    for (int i = 0; i < 8; ++i) { o[2 * i] = bf_lo(w[i]); o[2 * i + 1] = bf_hi(w[i]); }
#pragma unroll
    for (int h = 0; h < 16; ++h) { const float x = o[h] + F.dt_bias[h]; const float sp = fmaxf(x, 0.f) + log1pf(__expf(-fabsf(x))); o[h] = (P >= LEAD) ? sp : 0.f; }
    f32x4* dst = (f32x4*)(F.dtv + (size_t)P * 16);
#pragma unroll
    for (int q = 0; q < 4; ++q) dst[q] = (f32x4){o[4 * q], o[4 * q + 1], o[4 * q + 2], o[4 * q + 3]};
}
DI void p2_elem(Frame& F) {
    constexpr int NT = 129 * 41;
    for (int task = F.gw; task < NT; task += F.ngw) {
        const int c = task / 41, j = task % 41;
        if (j < 16) { if (c == 0) continue; const int g = j >> 2;
            if (g == 0) e_pool_tile<2>(F, c, 64 * j); else if (g == 1) e_pool_tile<4>(F, c, 64 * j); else if (g == 2) e_pool_tile<8>(F, c, 64 * j); else e_pool_tile<16>(F, c, 64 * j); }
        else if (j < 32) e_conv_tile(F, c, C_X + 64 * (j - 16), 64 * (j - 16), F.xT + (size_t)(64 * (j - 16)) * NP, nullptr, 0);
        else if (j < 36) e_conv_tile(F, c, C_B + 64 * (j - 32), 1024 + 64 * (j - 32), F.BT + (size_t)(64 * (j - 32)) * NP, F.Bc, 64 * (j - 32));
        else if (j < 40) e_conv_tile(F, c, C_C + 64 * (j - 36), 1280 + 64 * (j - 36), nullptr, F.Cc, 64 * (j - 36));
        else e_dt_tile(F, c);
    }
}

DI void p3_states(Frame& F) {
    const int lane = F.lane, r = lane & 31, hf = lane >> 5;
    LAS float* wsm = (LAS float*)(F.lds + F.wave * 256);
    for (int u = F.bid; u < 256; u += F.nwg) {
        const int c = u >> 1, g = u & 1, h = 8 * g + F.wave;
        const float A = -__expf(F.a_log[h]);
        const float dtl = F.dtv[(size_t)(64 * c + lane) * 16 + h];
        const float acs = wave_incl_scan(dtl * A, lane);
        const float tot = __shfl(acs, 63);
        wsm[lane] = dtl * __expf(tot - acs);
        if (lane == 0) F.decay[c * 16 + h] = __expf(tot);
        LDS_WAIT();
        f32x16 acc[2][4];
#pragma unroll
        for (int mt = 0; mt < 2; ++mt)
#pragma unroll
            for (int nt = 0; nt < 4; ++nt)
#pragma unroll
                for (int i = 0; i < 16; ++i) acc[mt][nt][i] = 0.f;
#pragma unroll
        for (int ks = 0; ks < 4; ++ks) {
            const f32x4 wa = *(const LAS f32x4*)(wsm + 16 * ks + 8 * hf), wb = *(const LAS f32x4*)(wsm + 16 * ks + 8 * hf + 4);
            bf16x8 af[2], bfr[4];
#pragma unroll
            for (int mt = 0; mt < 2; ++mt) {
                const v4u raw = *(const v4u*)(F.xT + (size_t)(h * 64 + 32 * mt + r) * NP + 64 * c + 16 * ks + 8 * hf);
                v4u sc; sc.x = pk2(bf_lo(raw.x) * wa.x, bf_hi(raw.x) * wa.y); sc.y = pk2(bf_lo(raw.y) * wa.z, bf_hi(raw.y) * wa.w);
                sc.z = pk2(bf_lo(raw.z) * wb.x, bf_hi(raw.z) * wb.y); sc.w = pk2(bf_lo(raw.w) * wb.z, bf_hi(raw.w) * wb.w);
                af[mt] = __builtin_bit_cast(bf16x8, sc);
            }
#pragma unroll
            for (int nt = 0; nt < 4; ++nt) bfr[nt] = *(const bf16x8*)(F.BT + (size_t)(g * 128 + 32 * nt + r) * NP + 64 * c + 16 * ks + 8 * hf);
#pragma unroll
            for (int mt = 0; mt < 2; ++mt)
#pragma unroll
                for (int nt = 0; nt < 4; ++nt) acc[mt][nt] = MFMA32(af[mt], bfr[nt], acc[mt][nt]);
        }
        bf16* st = F.states + ((size_t)(c * 16 + h) * 64) * 128;
#pragma unroll
        for (int mt = 0; mt < 2; ++mt)
#pragma unroll
            for (int nt = 0; nt < 4; ++nt)
#pragma unroll
                for (int i = 0; i < 16; ++i) st[(32 * mt + crow16(i, hf)) * 128 + 32 * nt + r] = f2bf(acc[mt][nt][i]);
        LDS_WAIT();
    }
}
DI void p4_scan(Frame& F) {
    const unsigned* st2 = (const unsigned*)F.states; unsigned* pv2 = (unsigned*)F.prev;
    for (int e = F.bid * 512 + F.tid; e < 65536; e += F.nwg * 512) {
        const int h = e >> 12; float c0v = 0.f, c1v = 0.f;
        for (int c0 = 0; c0 < 128; c0 += 16) {
            unsigned s[16]; float dc[16];
#pragma unroll
            for (int i = 0; i < 16; ++i) { s[i] = st2[(size_t)(c0 + i) * 65536 + e]; dc[i] = F.decay[(c0 + i) * 16 + h]; }
#pragma unroll
            for (int i = 0; i < 16; ++i) { c0v = c0v * dc[i] + bf_lo(s[i]); c1v = c1v * dc[i] + bf_hi(s[i]); pv2[(size_t)(c0 + i) * 65536 + e] = pk2(c0v, c1v); }
        }
    }
}
DI bf16x8 pack8(const f32x16& x, int s) {
    v4u p; p.x = pk2(x[8 * s], x[8 * s + 1]); p.y = pk2(x[8 * s + 2], x[8 * s + 3]); p.z = pk2(x[8 * s + 4], x[8 * s + 5]); p.w = pk2(x[8 * s + 6], x[8 * s + 7]);
    return __builtin_bit_cast(bf16x8, p);
}
DI void p5_out(Frame& F) {
    const int lane = F.lane, r = lane & 31, hf = lane >> 5;
    LAS float* acs_s = (LAS float*)(F.lds + F.wave * 512);
    LAS float* dt_s = acs_s + 64;
    LAS float* red = (LAS float*)(F.lds + 8192);
    for (int u = F.bid; u < 256; u += F.nwg) {
        const int c = 1 + (u >> 1), g = u & 1, h = 8 * g + F.wave;
        const float A = -__expf(F.a_log[h]), Dh = F.d_skip[h];
        const float dtl = F.dtv[(size_t)(64 * c + lane) * 16 + h];
        const float acs = wave_incl_scan(dtl * A, lane);
        acs_s[lane] = acs; dt_s[lane] = dtl;
        float acs_l[2]; acs_l[0] = __shfl(acs, r); acs_l[1] = __shfl(acs, 32 + r);
        LDS_WAIT();
        f32x16 yT[2][2], sT[3];
#pragma unroll
        for (int i = 0; i < 16; ++i) { yT[0][0][i] = 0.f; yT[0][1][i] = 0.f; yT[1][0][i] = 0.f; yT[1][1][i] = 0.f; sT[0][i] = 0.f; sT[1][i] = 0.f; sT[2][i] = 0.f; }
        const bf16* prevp = F.prev + ((size_t)(c - 1) * 16 + h) * 8192;
#pragma unroll 2
        for (int ks = 0; ks < 8; ++ks) {
            bf16x8 cf[2], pf[2], bg[2];
#pragma unroll
            for (int t = 0; t < 2; ++t) {
                cf[t] = *(const bf16x8*)(F.Cc + (size_t)(64 * c + 32 * t + r) * 256 + g * 128 + 16 * ks + 8 * hf);
                bg[t] = *(const bf16x8*)(F.Bc + (size_t)(64 * c + 32 * t + r) * 256 + g * 128 + 16 * ks + 8 * hf);
                pf[t] = *(const bf16x8*)(prevp + (32 * t + r) * 128 + 16 * ks + 8 * hf);
            }
            yT[0][0] = MFMA32(pf[0], cf[0], yT[0][0]); yT[0][1] = MFMA32(pf[0], cf[1], yT[0][1]);
            yT[1][0] = MFMA32(pf[1], cf[0], yT[1][0]); yT[1][1] = MFMA32(pf[1], cf[1], yT[1][1]);
            sT[0] = MFMA32(bg[0], cf[0], sT[0]); sT[1] = MFMA32(bg[0], cf[1], sT[1]); sT[2] = MFMA32(bg[1], cf[1], sT[2]);
        }
        { const float e0 = __expf(acs_l[0]), e1 = __expf(acs_l[1]);
#pragma unroll
          for (int i = 0; i < 16; ++i) { yT[0][0][i] *= e0; yT[1][0][i] *= e0; yT[0][1][i] *= e1; yT[1][1][i] *= e1; } }
#pragma unroll
        for (int t = 0; t < 3; ++t) {
            const int st = (t == 2) ? 1 : 0, lt = (t == 0) ? 0 : 1;
            const int l = 32 * lt + r;
#pragma unroll
            for (int q = 0; q < 4; ++q) {
                const f32x4 a4 = *(const LAS f32x4*)(acs_s + 32 * st + 8 * q + 4 * hf), d4 = *(const LAS f32x4*)(dt_s + 32 * st + 8 * q + 4 * hf);
#pragma unroll
                for (int e = 0; e < 4; ++e) { const int s = 32 * st + 8 * q + 4 * hf + e;
                    float val = sT[t][4 * q + e] * __expf(acs_l[lt] - a4[e]) * d4[e];
                    val = (s <= l) ? val : 0.f; val = (s == l) ? val + Dh : val;
                    sT[t][4 * q + e] = val; }
            }
        }
#pragma unroll
        for (int st = 0; st < 2; ++st)
#pragma unroll
            for (int sp = 0; sp < 2; ++sp) {
                bf16x8 xa[2];
#pragma unroll
                for (int pt = 0; pt < 2; ++pt) { const bf16* xp = F.xT + (size_t)(h * 64 + 32 * pt + r) * NP + 64 * c + 32 * st + 16 * sp + 4 * hf;
                    const v2u lo = *(const v2u*)xp, hi = *(const v2u*)(xp + 8); v4u w; w.x = lo.x; w.y = lo.y; w.z = hi.x; w.w = hi.y; xa[pt] = __builtin_bit_cast(bf16x8, w); }
                if (st == 0) { const bf16x8 m0 = pack8(sT[0], sp), m1 = pack8(sT[1], sp);
                    yT[0][0] = MFMA32(xa[0], m0, yT[0][0]); yT[1][0] = MFMA32(xa[1], m0, yT[1][0]);
                    yT[0][1] = MFMA32(xa[0], m1, yT[0][1]); yT[1][1] = MFMA32(xa[1], m1, yT[1][1]);
                } else { const bf16x8 m2 = pack8(sT[2], sp);
                    yT[0][1] = MFMA32(xa[0], m2, yT[0][1]); yT[1][1] = MFMA32(xa[1], m2, yT[1][1]); }
            }
        float ss[2] = {0.f, 0.f};
#pragma unroll
        for (int pt = 0; pt < 2; ++pt)
#pragma unroll
            for (int lt = 0; lt < 2; ++lt) {
                const bf16* zp = F.proj + (size_t)(64 * c + 32 * lt + r) * NPROJ + C_Z + h * 64 + 32 * pt + 4 * hf;
#pragma unroll
                for (int q = 0; q < 4; ++q) { const v2u zw = *(const v2u*)(zp + 8 * q);
                    const float z0 = bf_lo(zw.x), z1 = bf_hi(zw.x), z2 = bf_lo(zw.y), z3 = bf_hi(zw.y);
                    float y0 = yT[pt][lt][4 * q] * silu_f(z0), y1 = yT[pt][lt][4 * q + 1] * silu_f(z1), y2 = yT[pt][lt][4 * q + 2] * silu_f(z2), y3 = yT[pt][lt][4 * q + 3] * silu_f(z3);
                    yT[pt][lt][4 * q] = y0; yT[pt][lt][4 * q + 1] = y1; yT[pt][lt][4 * q + 2] = y2; yT[pt][lt][4 * q + 3] = y3;
                    ss[lt] += (y0 * y0 + y1 * y1) + (y2 * y2 + y3 * y3); }
            }
        ss[0] += __shfl_xor(ss[0], 32); ss[1] += __shfl_xor(ss[1], 32);
        if (hf == 0) { red[F.wave * 64 + r] = ss[0]; red[F.wave * 64 + 32 + r] = ss[1]; }
        LDS_WAIT(); __syncthreads();
        float rstd[2];
#pragma unroll
        for (int lt = 0; lt < 2; ++lt) { float t = 0.f;
#pragma unroll
            for (int w = 0; w < 8; ++w) t += red[w * 64 + 32 * lt + r];
            rstd[lt] = rsqrtf(t * (1.f / 512.f) + EPS); }
#pragma unroll
        for (int pt = 0; pt < 2; ++pt)
#pragma unroll
            for (int lt = 0; lt < 2; ++lt) {
                bf16* op = F.ycat + (size_t)(64 * (c - 1) + 32 * lt + r) * D + 1024 + h * 64 + 32 * pt + 4 * hf;
                const float* gp = F.ssm_g + h * 64 + 32 * pt + 4 * hf;
#pragma unroll
                for (int q = 0; q < 4; ++q) { const f32x4 gg = *(const f32x4*)(gp + 8 * q); v2u w;
                    w.x = pk2(yT[pt][lt][4 * q] * rstd[lt] * gg.x, yT[pt][lt][4 * q + 1] * rstd[lt] * gg.y);
                    w.y = pk2(yT[pt][lt][4 * q + 2] * rstd[lt] * gg.z, yT[pt][lt][4 * q + 3] * rstd[lt] * gg.w);
                    *(v2u*)(op + 8 * q) = w; }
            }
        __syncthreads();
    }
}

DI void p7_router(Frame& F) {
    LAS float* rs = (LAS float*)F.lds;
    LAS float* part = rs + 64;
    LAS float* lg = part + 8 * 1024;
    LAS int* hist = (LAS int*)(lg + 32 * 33 + 8);
    const int lane = F.lane, wave = F.wave;
    for (int blk = F.bid; blk < 256; blk += F.nwg) {
        const int r0 = 32 * blk;
        {
            const f32x4* gr = (const f32x4*)F.g2 + lane;
            f32x4 v[4][8];
#pragma unroll
            for (int i = 0; i < 4; ++i) { const v2u* xr = (const v2u*)(F.h2 + (size_t)(r0 + 4 * wave + i) * D) + lane;
#pragma unroll
                for (int j = 0; j < 8; ++j) { const v2u w = xr[64 * j]; v[i][j] = (f32x4){bf_lo(w.x), bf_hi(w.x), bf_lo(w.y), bf_hi(w.y)}; } }
            f32x4 g[8];
#pragma unroll
            for (int j = 0; j < 8; ++j) g[j] = gr[64 * j];
#pragma unroll
            for (int i = 0; i < 4; ++i) { const int rr = r0 + 4 * wave + i; float s = 0.f;
#pragma unroll
                for (int j = 0; j < 8; ++j) s += (v[i][j].x * v[i][j].x + v[i][j].y * v[i][j].y) + (v[i][j].z * v[i][j].z + v[i][j].w * v[i][j].w);
                const float rstd = rsqrtf(wave_sum(s) * (1.f / D) + EPS);
                unsigned long long* o8 = (unsigned long long*)(F.hn2 + (size_t)rr * D) + lane;
                unsigned* o4 = (unsigned*)((unsigned char*)F.hn2 + (size_t)rr * D) + lane;
#pragma unroll
                for (int j = 0; j < 8; ++j) {
                    if (MOE_F8) { const float q = rstd * X8_SCALE; o4[64 * j] = pk4_f8(v[i][j].x * q * g[j].x, v[i][j].y * q * g[j].y, v[i][j].z * q * g[j].z, v[i][j].w * q * g[j].w); }
                    else o8[64 * j] = (unsigned long long)pk2(v[i][j].x * rstd * g[j].x, v[i][j].y * rstd * g[j].y) | ((unsigned long long)pk2(v[i][j].z * rstd * g[j].z, v[i][j].w * rstd * g[j].w) << 32); }
                if (lane == 0) rs[4 * wave + i] = rstd; }
        }
        f32x16 acc;
#pragma unroll
        for (int i = 0; i < 16; ++i) acc[i] = 0.f;
        { const int ri = lane & 31, kh = lane >> 5;
          const bf16* arow = F.h2 + (size_t)(r0 + ri) * D + 256 * wave + 4 * kh;
          const float* wp = F.Wr + (size_t)(256 * wave + 4 * kh) * 32 + ri;
#pragma unroll 8
          for (int jj = 0; jj < 32; ++jj) {
              const v2u aw = *(const v2u*)(arow + 8 * jj); const f32x4 a = {bf_lo(aw.x), bf_hi(aw.x), bf_lo(aw.y), bf_hi(aw.y)};
              const float b0 = wp[(8 * jj) * 32], b1 = wp[(8 * jj + 1) * 32], b2 = wp[(8 * jj + 2) * 32], b3 = wp[(8 * jj + 3) * 32];
              acc = __builtin_amdgcn_mfma_f32_32x32x2f32(a.x, b0, acc, 0, 0, 0);
              acc = __builtin_amdgcn_mfma_f32_32x32x2f32(a.y, b1, acc, 0, 0, 0);
              acc = __builtin_amdgcn_mfma_f32_32x32x2f32(a.z, b2, acc, 0, 0, 0);
              acc = __builtin_amdgcn_mfma_f32_32x32x2f32(a.w, b3, acc, 0, 0, 0);
          }
#pragma unroll
          for (int i = 0; i < 16; ++i) part[wave * 1024 + crow16(i, kh) * 32 + ri] = acc[i];
        }
        if (F.tid < 32) hist[F.tid] = 0;
        LDS_WAIT(); __syncthreads();
        for (int idx = F.tid; idx < 1024; idx += 512) { float s = 0.f;
#pragma unroll
            for (int w = 0; w < 8; ++w) s += part[w * 1024 + idx];
            lg[(idx >> 5) * 33 + (idx & 31)] = s * rs[idx >> 5] + F.router_b[idx & 31]; }
        LDS_WAIT(); __syncthreads();
        if (F.tid < 32) {
            const int i = F.tid; float tv[4]; int te[4];
#pragma unroll
            for (int k = 0; k < 4; ++k) { float best = -3.0e38f; int be = 0;
                for (int e = 0; e < 32; ++e) { const float x = lg[i * 33 + e]; if (x > best) { best = x; be = e; } }
                tv[k] = best; te[k] = be; lg[i * 33 + be] = -3.4e38f; }
            const float e1 = __expf(tv[1] - tv[0]), e2 = __expf(tv[2] - tv[0]), e3 = __expf(tv[3] - tv[0]);
            const float inv = 1.f / (1.f + e1 + e2 + e3);
            *(f32x4*)(F.tkg + (size_t)(r0 + i) * 4) = (f32x4){inv, e1 * inv, e2 * inv, e3 * inv};
            int* tk = F.tke + (size_t)(r0 + i) * 4; tk[0] = te[0]; tk[1] = te[1]; tk[2] = te[2]; tk[3] = te[3];
#pragma unroll
            for (int k = 0; k < 4; ++k) __hip_atomic_fetch_add(hist + te[k], 1, __ATOMIC_RELAXED, __HIP_MEMORY_SCOPE_WORKGROUP);
        }
        LDS_WAIT(); __syncthreads();
        if (F.tid < 32) F.cnt[blk * 32 + F.tid] = hist[F.tid];
        __syncthreads();
    }
}
DI void p8_route(Frame& F) {
    LAS int* tot = (LAS int*)F.lds; LAS int* pre = tot + 32; LAS int* base = tot + 64; LAS int* posl = tot + 128; LAS int* tkl = tot + 256; LAS int* ptot = tot + 512; LAS int* ppre = ptot + 512;
    for (int blk = F.bid; blk < 256; blk += F.nwg) {
        const int r0 = 32 * blk;
        { const int e = F.tid & 31, wq = F.tid >> 5; int t = 0, p = 0;
#pragma unroll
          for (int i = 0; i < 16; ++i) { const int w = wq + 16 * i; const int v = F.cnt[w * 32 + e]; p += (w < blk) ? v : 0; t += v; }
          ptot[wq * 32 + e] = t; ppre[wq * 32 + e] = p; }
        if (F.tid < 128) tkl[F.tid] = F.tke[(size_t)r0 * 4 + F.tid];
        LDS_WAIT(); __syncthreads();
        if (F.tid < 32) { int t = 0, p = 0;
#pragma unroll
            for (int i = 0; i < 16; ++i) { t += ptot[i * 32 + F.tid]; p += ppre[i * 32 + F.tid]; }
            tot[F.tid] = t; pre[F.tid] = p; }
        LDS_WAIT(); __syncthreads();
        if (F.tid < 32) { int accp = 0; for (int e = 0; e < F.tid; ++e) accp += ((tot[e] + 255) >> 8) << 8; base[F.tid] = accp; }
        if (blk == 0 && F.tid == 64) { int nt = 0;
            for (int e = 0; e < 32; ++e) { const int tiles = (tot[e] + 255) >> 8; for (int j = 0; j < tiles; ++j) F.tile[nt + j] = e; nt += tiles; }
            F.tile[255] = nt; }
        LDS_WAIT(); __syncthreads();
        if (F.tid < 128) { const int e = tkl[F.tid]; int q = 0; for (int j = 0; j < F.tid; ++j) q += (tkl[j] == e) ? 1 : 0;
            const int p = base[e] + pre[e] + q; posl[F.tid] = p; F.pos[(size_t)r0 * 4 + F.tid] = p; }
        LDS_WAIT(); __syncthreads();
        if (F.tid < 128) ((int*)F.xs)[posl[F.tid]] = r0 + (F.tid >> 2);
        if (blk == 0 && F.tid < 32) { const int e = F.tid, lo_ = base[e] + tot[e], hi_ = base[e] + (((tot[e] + 255) >> 8) << 8); for (int q = lo_; q < hi_; ++q) ((int*)F.xs)[q] = 0; }
        __syncthreads();
    }
}
DI void p11_final(Frame& F) {
    const int lane = F.lane;
    for (int rr = F.gw; rr < SEQ; rr += F.ngw) {
        const int* pp = F.pos + (size_t)rr * 4; const f32x4 gt = *(const f32x4*)(F.tkg + (size_t)rr * 4);
        const float gk[4] = {gt.x, gt.y, gt.z, gt.w};
        const v2u* xr = (const v2u*)(F.h2 + (size_t)rr * D) + lane;
        f32x4 v[8];
#pragma unroll
        for (int j = 0; j < 8; ++j) { const v2u w = xr[64 * j]; v[j] = (f32x4){bf_lo(w.x), bf_hi(w.x), bf_lo(w.y), bf_hi(w.y)}; }
#pragma unroll
        for (int k = 0; k < 4; ++k) { const int* orow = (const int*)((const unsigned char*)F.obuf + (size_t)pp[k] * D) + lane; const float gq = gk[k] * (1.f / O8_SCALE);
#pragma unroll
            for (int j = 0; j < 8; ++j) { const int w = orow[64 * j];
                v[j].x += gq * __builtin_amdgcn_cvt_f32_fp8(w, 0); v[j].y += gq * __builtin_amdgcn_cvt_f32_fp8(w, 1); v[j].z += gq * __builtin_amdgcn_cvt_f32_fp8(w, 2); v[j].w += gq * __builtin_amdgcn_cvt_f32_fp8(w, 3); } }
        float s = 0.f;
#pragma unroll
        for (int j = 0; j < 8; ++j) s += (v[j].x * v[j].x + v[j].y * v[j].y) + (v[j].z * v[j].z + v[j].w * v[j].w);
        const float rstd = rsqrtf(wave_sum(s) * (1.f / D) + EPS);
        const f32x4* gr = (const f32x4*)F.final_g + lane; f32x4* op = (f32x4*)(F.out + (size_t)rr * D) + lane;
#pragma unroll
        for (int j = 0; j < 8; ++j) { const f32x4 g = gr[64 * j]; op[64 * j] = (f32x4){v[j].x * rstd * g.x, v[j].y * rstd * g.y, v[j].z * rstd * g.z, v[j].w * rstd * g.w}; }
    }
}

using pg8::Unit; using pg8::HALF; using pg8::BM;
struct EpiProj {
    static constexpr bool PERM = true, AFTER_DRAIN = false;
    bf16* O;
    DI void operator()(const f32x4 (&acc)[2][2][4][2], const Unit& u, int wr, int wc, int fr, int fq) const {
        const int row0 = u.pm * BM + wr * 64 + fr, col0 = u.pn * BM + wc * 32 + 8 * fq;
#pragma unroll
        for (int ai = 0; ai < 2; ++ai)
#pragma unroll
            for (int m = 0; m < 4; ++m) { bf16* rowp = O + (size_t)(row0 + ai * HALF + m * 16) * NPROJ + col0;
#pragma unroll
                for (int bj = 0; bj < 2; ++bj) { const f32x4 v0 = acc[ai][bj][m][0], v1 = acc[ai][bj][m][1];
                    v4u w; w.x = pk2(v0[0], v0[1]); w.y = pk2(v0[2], v0[3]); w.z = pk2(v1[0], v1[1]); w.w = pk2(v1[2], v1[3]);
                    *(v4u*)(rowp + bj * HALF) = w; } }
    }
};
struct EpiH2 {
    static constexpr bool PERM = true, AFTER_DRAIN = false;
    const float* X; bf16* H;
    DI void operator()(const f32x4 (&acc)[2][2][4][2], const Unit& u, int wr, int wc, int fr, int fq) const {
        const int row0 = u.pm * BM + wr * 64 + fr, col0 = u.pn * BM + wc * 32 + 8 * fq;
#pragma unroll
        for (int ai = 0; ai < 2; ++ai)
#pragma unroll
            for (int m = 0; m < 4; ++m) { const size_t off = (size_t)(row0 + ai * HALF + m * 16) * D + col0;
#pragma unroll
                for (int bj = 0; bj < 2; ++bj) { const f32x4 x0 = *(const f32x4*)(X + off + bj * HALF), x1 = *(const f32x4*)(X + off + bj * HALF + 4);
                    const f32x4 v0 = acc[ai][bj][m][0] + x0, v1 = acc[ai][bj][m][1] + x1;
                    v4u w; w.x = pk2(v0[0], v0[1]); w.y = pk2(v0[2], v0[3]); w.z = pk2(v1[0], v1[1]); w.w = pk2(v1[2], v1[3]);
                    *(v4u*)(H + off + bj * HALF) = w; } }
    }
};
DI float swiglu(float g, float u) {
    g = fminf(g, 7.f); u = fminf(fmaxf(u, -7.f), 7.f);
    return (u + 1.f) * g * __builtin_amdgcn_rcpf(1.f + __expf(-1.702f * g));
}
DI f32x4 swiglu4(f32x4 g, f32x4 u, const float S) {
#pragma unroll
    for (int i = 0; i < 4; ++i) { g[i] = fminf(g[i], 7.f); u[i] = fminf(fmaxf(u[i], -7.f), 7.f); }
    const f32x4 t = g * (-1.702f * 1.4426950408889634f);
    f32x4 d;
#pragma unroll
    for (int i = 0; i < 4; ++i) d[i] = __builtin_amdgcn_exp2f(t[i]);
    d = d + 1.f;
#pragma unroll
    for (int i = 0; i < 4; ++i) d[i] = __builtin_amdgcn_rcpf(d[i]);
    return (u * S + S) * g * d;
}
struct EpiGU {
    static constexpr bool PERM = true, AFTER_DRAIN = false;
    bf16* O; const float* bgate; const float* bup;
    DI void operator()(const f32x4 (&acc)[2][2][4][2], const Unit& u, int wr, int wc, int fr, int fq) const {
        const int e = u.pn >> 4, pnl = u.pn & 15;
        const int row0 = u.pm * BM + wr * 64 + fr, colb = 128 * pnl + wc * 32 + 8 * fq;
        f32x4 bg[2], bu[2];
#pragma unroll
        for (int n = 0; n < 2; ++n) { bg[n] = *(const f32x4*)(bgate + e * D + colb + 4 * n); bu[n] = *(const f32x4*)(bup + e * D + colb + 4 * n); }
#pragma unroll
        for (int ai = 0; ai < 2; ++ai)
#pragma unroll
            for (int m = 0; m < 4; ++m) { bf16* rowp = O + (size_t)(row0 + ai * HALF + m * 16) * D + colb;
                const f32x4 g0 = acc[ai][0][m][0] + bg[0], g1 = acc[ai][0][m][1] + bg[1], u0 = acc[ai][1][m][0] + bu[0], u1 = acc[ai][1][m][1] + bu[1];
                v4u w; w.x = pk2(swiglu(g0[0], u0[0]), swiglu(g0[1], u0[1])); w.y = pk2(swiglu(g0[2], u0[2]), swiglu(g0[3], u0[3]));
                w.z = pk2(swiglu(g1[0], u1[0]), swiglu(g1[1], u1[1])); w.w = pk2(swiglu(g1[2], u1[2]), swiglu(g1[3], u1[3]));
                *(v4u*)rowp = w; }
    }
};
struct EpiDown {
    static constexpr bool PERM = true, AFTER_DRAIN = false;
    bf16* O; const float* bias;
    DI void operator()(const f32x4 (&acc)[2][2][4][2], const Unit& u, int wr, int wc, int fr, int fq) const {
        const int e = u.pn >> 3, pnl = u.pn & 7;
        const int row0 = u.pm * BM + wr * 64 + fr, col0 = 256 * pnl + wc * 32 + 8 * fq;
        f32x4 bv[2][2];
#pragma unroll
        for (int bj = 0; bj < 2; ++bj)
#pragma unroll
            for (int n = 0; n < 2; ++n) bv[bj][n] = *(const f32x4*)(bias + e * D + col0 + bj * HALF + 4 * n);
#pragma unroll
        for (int ai = 0; ai < 2; ++ai)
#pragma unroll
            for (int m = 0; m < 4; ++m) { bf16* rowp = O + (size_t)(row0 + ai * HALF + m * 16) * D + col0;
#pragma unroll
                for (int bj = 0; bj < 2; ++bj) { const f32x4 v0 = acc[ai][bj][m][0] + bv[bj][0], v1 = acc[ai][bj][m][1] + bv[bj][1];
                    v4u w; w.x = pk2(v0[0], v0[1]); w.y = pk2(v0[2], v0[3]); w.z = pk2(v1[0], v1[1]); w.w = pk2(v1[2], v1[3]);
                    *(v4u*)(rowp + bj * HALF) = w; } }
    }
};
struct EpiGU8 {
    static constexpr bool PERM = true, AFTER_DRAIN = false;
    unsigned char* O; const float* bgate; const float* bup;
    DI void operator()(const f32x4 (&acc)[2][2][4][2], const Unit& u, int wr, int wc, int fr, int fq) const {
        const int e = u.pn >> 4, pnl = u.pn & 15;
        const int row0 = u.pm * BM + wr * 64 + fr, colb = 128 * pnl + wc * 32 + 8 * fq;
        constexpr float DQ = 1.f / (W8_SCALE * X8_SCALE);
        f32x4 bg[2], bu[2];
#pragma unroll
        for (int n = 0; n < 2; ++n) { bg[n] = *(const f32x4*)(bgate + e * D + colb + 4 * n); bu[n] = *(const f32x4*)(bup + e * D + colb + 4 * n); }
#pragma unroll
        for (int ai = 0; ai < 2; ++ai)
#pragma unroll
            for (int m = 0; m < 4; ++m) { unsigned char* rowp = O + (size_t)(row0 + ai * HALF + m * 16) * D + colb;
                const f32x4 g0 = acc[ai][0][m][0] * DQ + bg[0], g1 = acc[ai][0][m][1] * DQ + bg[1], u0 = acc[ai][1][m][0] * DQ + bu[0], u1 = acc[ai][1][m][1] * DQ + bu[1];
                const f32x4 a0 = swiglu4(g0, u0, A8_SCALE), a1 = swiglu4(g1, u1, A8_SCALE);
                v2u w; w.x = pk4_f8(a0[0], a0[1], a0[2], a0[3]); w.y = pk4_f8(a1[0], a1[1], a1[2], a1[3]);
                *(v2u*)rowp = w; }
    }
};
struct EpiDown8 {
    static constexpr bool PERM = true, AFTER_DRAIN = false;
    unsigned char* O; const float* bias;
    DI void operator()(const f32x4 (&acc)[2][2][4][2], const Unit& u, int wr, int wc, int fr, int fq) const {
        const int e = u.pn >> 3, pnl = u.pn & 7;
        const int row0 = u.pm * BM + wr * 64 + fr, col0 = 256 * pnl + wc * 32 + 8 * fq;
        constexpr float DQ = O8_SCALE / (W8_SCALE * A8_SCALE);
        f32x4 bv[2][2];
#pragma unroll
        for (int bj = 0; bj < 2; ++bj)
#pragma unroll
            for (int n = 0; n < 2; ++n) bv[bj][n] = *(const f32x4*)(bias + e * D + col0 + bj * HALF + 4 * n) * O8_SCALE;
#pragma unroll
        for (int ai = 0; ai < 2; ++ai)
#pragma unroll
            for (int m = 0; m < 4; ++m) { unsigned char* rowp = O + (size_t)(row0 + ai * HALF + m * 16) * D + col0;
#pragma unroll
                for (int bj = 0; bj < 2; ++bj) { const f32x4 v0 = acc[ai][bj][m][0] * DQ + bv[bj][0], v1 = acc[ai][bj][m][1] * DQ + bv[bj][1];
                    v2u w; w.x = pk4_f8(v0[0], v0[1], v0[2], v0[3]); w.y = pk4_f8(v1[0], v1[1], v1[2], v1[3]);
                    *(v2u*)(rowp + bj * HALF) = w; } }
    }
};
struct MoeOrder {
    const LAS int* tile_e; const int* rowtok = nullptr;
    int nM, nN, nwg, G, c;
    DI void init(const LAS int* te, int ntiles, int nN_, int G_, int c_) { tile_e = te; nM = ntiles; nN = nN_; nwg = nM * nN; G = G_; c = c_; }
    DI bool next(int i, Unit& u) const {
        const int L = i * G + c; if (L >= nwg) return false;
        int wgid = L; { const int q = nwg / pg8::NXCD, r = nwg % pg8::NXCD, xcd = wgid % pg8::NXCD, off = wgid / pg8::NXCD; wgid = (xcd < r ? xcd * (q + 1) : r * (q + 1) + (xcd - r) * q) + off; }
        const int nig = pg8::WGM * nN, gid = wgid / nig, fm = gid * pg8::WGM, gsz = (nM - fm) < pg8::WGM ? (nM - fm) : pg8::WGM;
        u.pm = fm + ((wgid % nig) % gsz); const int pnl = (wgid % nig) / gsz;
        u.pn = __builtin_amdgcn_readfirstlane(tile_e[u.pm]) * nN + pnl; return true;
    }
    DI void a_ready(const Unit&) const {}
    DI void done(const Unit&) const {}
};


#if MOE_RB
#define MFMA16(a, b, c) __builtin_amdgcn_mfma_f32_16x16x32_bf16((a), (b), (c), 0, 0, 0)
template <class Epi, class Sched>
DI void gemm_rb(LAS unsigned char* lds, const bf16* A, const Sched& S, const Epi& E) {
    constexpr int K = D, NT = K / 64;
    const int tid = threadIdx.x, wave = __builtin_amdgcn_readfirstlane(tid >> 6), lane = tid & 63, fr = lane & 15, fq = lane >> 4;
    unsigned voffA[2];
#pragma unroll
    for (int i = 0; i < 2; ++i) { int R, C; pg8::stage_rc(tid * 16 + i * 8192, R, C); voffA[i] = (unsigned)(R * K + C) * 2u; }
    const unsigned ldsw = (unsigned)wave * 1024u;
    const int aoff = pg8::lds_byte(fr, fq * 8);
    const unsigned boff = (unsigned)((8 * fq) * K + fr) * 4u;
    Unit u;
    for (int ui = 0; S.next(ui, u); ++ui) {
        const char* cA = (const char*)A + (size_t)u.pm * 256 * K * 2;
        const float *b0, *b1; E.bsrc(u, wave, b0, b1);
        const char* pb0 = (const char*)b0 + boff; const char* pb1 = (const char*)b1 + boff;
        f32x4 acc[16][2];
#pragma unroll
        for (int m = 0; m < 16; ++m) { acc[m][0] = (f32x4){0.f, 0.f, 0.f, 0.f}; acc[m][1] = (f32x4){0.f, 0.f, 0.f, 0.f}; }
        float rb[4][16];
#define RB_DMA(t) do { const int tt_ = (t) < NT ? (t) : NT - 1; const unsigned bo_ = (unsigned)(((t) % 3) * 32768); \
        _Pragma("unroll") for (int h_ = 0; h_ < 2; ++h_) _Pragma("unroll") for (int i_ = 0; i_ < 2; ++i_) \
            __builtin_amdgcn_global_load_lds((const unsigned*)(cA + (size_t)h_ * 128 * K * 2 + (size_t)tt_ * 128 + voffA[i_]), (LAS unsigned*)(lds + bo_ + h_ * 16384 + ldsw + i_ * 8192), 16, 0, 0); } while (0)
#define RB_ISSUE(slot, hs) do { const int he_ = (hs) < 2 * NT ? (hs) : 2 * NT - 1; const char* s0_ = pb0 + (size_t)he_ * 32 * K * 4; const char* s1_ = pb1 + (size_t)he_ * 32 * K * 4; \
        _Pragma("unroll") for (int j_ = 0; j_ < 8; ++j_) { \
            asm volatile("global_load_dword %0, %1, off" : "=v"(rb[slot][j_]) : "v"(s0_ + (size_t)j_ * K * 4) : "memory"); \
            asm volatile("global_load_dword %0, %1, off" : "=v"(rb[slot][8 + j_]) : "v"(s1_ + (size_t)j_ * K * 4) : "memory"); } } while (0)
#define RB_WAITB(slot) asm volatile("s_waitcnt vmcnt(52)" : "+v"(rb[slot][0]), "+v"(rb[slot][1]), "+v"(rb[slot][2]), "+v"(rb[slot][3]), "+v"(rb[slot][4]), "+v"(rb[slot][5]), "+v"(rb[slot][6]), "+v"(rb[slot][7]), \
        "+v"(rb[slot][8]), "+v"(rb[slot][9]), "+v"(rb[slot][10]), "+v"(rb[slot][11]), "+v"(rb[slot][12]), "+v"(rb[slot][13]), "+v"(rb[slot][14]), "+v"(rb[slot][15]) :: "memory")
#define RB_COMPUTE(bufo, ks, slot) do { v4u p0_, p1_; \
        p0_.x = pk2(rb[slot][0], rb[slot][1]); p0_.y = pk2(rb[slot][2], rb[slot][3]); p0_.z = pk2(rb[slot][4], rb[slot][5]); p0_.w = pk2(rb[slot][6], rb[slot][7]); \
        p1_.x = pk2(rb[slot][8], rb[slot][9]); p1_.y = pk2(rb[slot][10], rb[slot][11]); p1_.z = pk2(rb[slot][12], rb[slot][13]); p1_.w = pk2(rb[slot][14], rb[slot][15]); \
        const bf16x8 bf0_ = __builtin_bit_cast(bf16x8, p0_), bf1_ = __builtin_bit_cast(bf16x8, p1_); \
        _Pragma("unroll") for (int mg_ = 0; mg_ < 4; ++mg_) { bf16x8 a_[4]; \
            _Pragma("unroll") for (int q_ = 0; q_ < 4; ++q_) { const int m_ = 4 * mg_ + q_; a_[q_] = *(const LAS bf16x8*)(lds + (bufo) + (m_ >> 3) * 16384 + (m_ & 7) * 2048 + (ks) * 1024 + aoff); } \
            _Pragma("unroll") for (int q_ = 0; q_ < 4; ++q_) { const int m_ = 4 * mg_ + q_; acc[m_][0] = MFMA16(bf0_, a_[q_], acc[m_][0]); acc[m_][1] = MFMA16(bf1_, a_[q_], acc[m_][1]); } \
            __builtin_amdgcn_sched_barrier(0); } } while (0)
        RB_DMA(0); RB_DMA(1);
        RB_ISSUE(0, 0); RB_ISSUE(1, 1); RB_ISSUE(2, 2);
        int bi = 0;
#pragma unroll 1
        for (int t = 0; t < NT; t += 2) {
            const int bo0 = bi * 32768, bi1 = (bi == 2) ? 0 : bi + 1, bo1 = bi1 * 32768;
            asm volatile("s_waitcnt vmcnt(36)" ::: "memory"); __builtin_amdgcn_s_barrier(); asm volatile("" ::: "memory");
            RB_DMA(t + 2);
            RB_ISSUE(3, 2 * t + 3); RB_WAITB(0); RB_COMPUTE(bo0, 0, 0);
            RB_ISSUE(0, 2 * t + 4); RB_WAITB(1); RB_COMPUTE(bo0, 1, 1);
            asm volatile("s_waitcnt vmcnt(36)" ::: "memory"); __builtin_amdgcn_s_barrier(); asm volatile("" ::: "memory");
            RB_DMA(t + 3);
            RB_ISSUE(1, 2 * t + 5); RB_WAITB(2); RB_COMPUTE(bo1, 0, 2);
            RB_ISSUE(2, 2 * t + 6); RB_WAITB(3); RB_COMPUTE(bo1, 1, 3);
            bi = (bi1 == 2) ? 0 : bi1 + 1;
        }
#define RB_KEEP(slot, str) asm volatile(str : "+v"(rb[slot][0]), "+v"(rb[slot][1]), "+v"(rb[slot][2]), "+v"(rb[slot][3]), "+v"(rb[slot][4]), "+v"(rb[slot][5]), "+v"(rb[slot][6]), "+v"(rb[slot][7]), \
        "+v"(rb[slot][8]), "+v"(rb[slot][9]), "+v"(rb[slot][10]), "+v"(rb[slot][11]), "+v"(rb[slot][12]), "+v"(rb[slot][13]), "+v"(rb[slot][14]), "+v"(rb[slot][15]) :: "memory")
        RB_KEEP(0, "s_waitcnt vmcnt(0)"); RB_KEEP(1, ""); RB_KEEP(2, ""); RB_KEEP(3, "");
#undef RB_KEEP
        E(acc, u, wave, fr, fq);
        asm volatile("s_waitcnt vmcnt(0)" ::: "memory"); __builtin_amdgcn_s_barrier(); asm volatile("" ::: "memory");
#undef RB_DMA
#undef RB_ISSUE
#undef RB_WAITB
#undef RB_COMPUTE
    }
}
struct EpiGU2 {
    bf16* O; const float *wg, *wu, *bgate, *bup;
    DI void bsrc(const Unit& u, int wave, const float*& b0, const float*& b1) const {
        const int e = u.pn >> 4, pnl = u.pn & 15; const size_t o = (size_t)e * D * D + 128 * pnl + 16 * wave; b0 = wg + o; b1 = wu + o; }
    DI void operator()(const f32x4 (&acc)[16][2], const Unit& u, int wave, int fr, int fq) const {
        const int e = u.pn >> 4, pnl = u.pn & 15, col = 128 * pnl + 16 * wave + 4 * fq;
        const f32x4 bg = *(const f32x4*)(bgate + e * D + col), bu = *(const f32x4*)(bup + e * D + col);
        bf16* op = O + (size_t)(u.pm * 256 + fr) * D + col;
#pragma unroll
        for (int m = 0; m < 16; ++m) { const f32x4 g = acc[m][0] + bg, uu = acc[m][1] + bu; v2u w;
            w.x = pk2(swiglu(g[0], uu[0]), swiglu(g[1], uu[1])); w.y = pk2(swiglu(g[2], uu[2]), swiglu(g[3], uu[3]));
            *(v2u*)(op + (size_t)(16 * m) * D) = w; }
    }
};
struct EpiDown2 {
    bf16* O; const float *wd, *bias;
    DI void bsrc(const Unit& u, int wave, const float*& b0, const float*& b1) const {
        const int e = u.pn >> 3, pnl = u.pn & 7; b0 = wd + (size_t)e * D * D + 256 * pnl + 32 * wave; b1 = b0 + 16; }
    DI void operator()(const f32x4 (&acc)[16][2], const Unit& u, int wave, int fr, int fq) const {
        const int e = u.pn >> 3, pnl = u.pn & 7, col = 256 * pnl + 32 * wave + 4 * fq;
        const f32x4 v0 = *(const f32x4*)(bias + e * D + col), v1 = *(const f32x4*)(bias + e * D + col + 16);
        bf16* op = O + (size_t)(u.pm * 256 + fr) * D + col;
#pragma unroll
        for (int m = 0; m < 16; ++m) { const f32x4 a = acc[m][0] + v0, b = acc[m][1] + v1; v2u w0, w1;
            w0.x = pk2(a[0], a[1]); w0.y = pk2(a[2], a[3]); w1.x = pk2(b[0], b[1]); w1.y = pk2(b[2], b[3]);
            *(v2u*)(op + (size_t)(16 * m) * D) = w0; *(v2u*)(op + (size_t)(16 * m) * D + 16) = w1; }
    }
};

#endif
struct Args { const float* in[23]; float* out; unsigned char* ws; int ph_lo, ph_hi; };
DI void fill_frame(Frame& F, const Args& args, LAS unsigned char* lds, const int bid, const int nwg) {
    F.lds = lds;
    int tz = threadIdx.x; asm volatile("" : "+v"(tz)); F.tid = tz;
    F.lane = F.tid & 63; F.wave = __builtin_amdgcn_readfirstlane(F.tid >> 6);
    F.bid = bid; F.nwg = nwg; F.gw = bid * NWAVES + F.wave; F.ngw = nwg * NWAVES;
    unsigned char* ws = args.ws;
    F.x = args.in[0]; F.meta = args.in[1]; F.g1 = args.in[2]; F.w_in = args.in[3]; F.pool_w = args.in[4]; F.pool_scale = args.in[5]; F.conv_w = args.in[6]; F.conv_b = args.in[7];
    F.dt_bias = args.in[8]; F.a_log = args.in[9]; F.d_skip = args.in[10]; F.ssm_g = args.in[11]; F.w_out = args.in[12]; F.g2 = args.in[13]; F.router_w = args.in[14]; F.router_b = args.in[15];
    F.w_gate = args.in[16]; F.b_gate = args.in[17]; F.w_up = args.in[18]; F.b_up = args.in[19]; F.w_down = args.in[20]; F.b_down = args.in[21]; F.final_g = args.in[22];
    F.out = args.out;
    F.hn = (bf16*)(ws + WS_HN); F.Bt1 = (bf16*)(ws + WS_BT1); F.Bt2 = (bf16*)(ws + WS_BT2); F.proj = (bf16*)(ws + WS_PROJ); F.xT = (bf16*)(ws + WS_XT); F.BT = (bf16*)(ws + WS_BTT);
    F.Bc = (bf16*)(ws + WS_BC); F.Cc = (bf16*)(ws + WS_CC); F.prev = (bf16*)(ws + WS_PREV); F.ycat = (bf16*)(ws + WS_YCAT); F.hn2 = (bf16*)(ws + WS_HN2); F.xs = (bf16*)(ws + WS_XS);
    F.abuf = (bf16*)(ws + WS_A); F.obuf = (bf16*)(ws + (MOE_F8 ? WS_O : WS_XS)); F.Btgu = (bf16*)(ws + WS_BTGU); F.Btd = (bf16*)(ws + WS_BTD);
    F.dtv = (float*)(ws + WS_DT); F.states = (bf16*)(ws + WS_ST); F.decay = (float*)(ws + WS_DEC); F.h2 = (bf16*)(ws + WS_H2); F.Wr = (float*)(ws + WS_WR); F.tkg = (float*)(ws + WS_TKG);
    F.tke = (int*)(ws + WS_TKE); F.pos = (int*)(ws + WS_POS); F.cnt = (int*)(ws + WS_CNT); F.tile = (int*)(ws + WS_TILE);

}
__global__ void __launch_bounds__(NWAVES * 64, 2) fwd(Args args) {
    extern __shared__ __attribute__((aligned(16))) unsigned char lds_raw[];
    LAS unsigned char* const lds_base = (LAS unsigned char*)lds_raw; unsigned char* ws = args.ws;
    volatile LAS unsigned* MISC = (volatile LAS unsigned*)(lds_base + MISC_OFF);
    if (threadIdx.x < 32) MISC[threadIdx.x] = 0u;
    __syncthreads();
    const int G = (int)gridDim.x, bx = (int)blockIdx.x;
    const bool worker = bx < WN;
    XcdBarrier barA = xcd_barrier_post((unsigned*)(ws + WS_CTL) + CW_BAR, MISC + 8, (unsigned)G);
    XcdBarrier barW; barW.bar = (unsigned*)(ws + WS_CTL) + CW_BAR2; barW.x = 0; barW.st = MISC + 12; barW.G = (unsigned)WN;
    if (worker) barW = xcd_barrier_post((unsigned*)(ws + WS_CTL) + CW_BAR2, MISC + 12, (unsigned)WN);

    { Frame F; fill_frame(F, args, lds_base, bx, G); p0_norm(F); p0_weff(F); p0_router_fold(F); p0_weights_range(F, I_MOE, NITEMS); __syncthreads(); }
    xcd_barrier(barA);
    if (!worker) {
        Frame F; fill_frame(F, args, lds_base, bx - WN, G - WN); p0_weights_range(F, 0, I_MOE); __syncthreads();
    } else {
        { Frame F; fill_frame(F, args, lds_base, bx, WN); pg8::Gemm g{F.hn, F.Bt1, MP, NPROJ, D}; pg8::StaticOrder S; S.init(MP, NPROJ, WN, bx);
          EpiProj E{F.proj}; pg8::gemm_phase<EpiProj, pg8::StaticOrder, true, true>(F.lds, g, S, E); }
        xcd_barrier(barW);
        { Frame F; fill_frame(F, args, lds_base, bx, WN); p2_elem(F); }
        xcd_barrier(barW);
        { Frame F; fill_frame(F, args, lds_base, bx, WN); p3_states(F); }
        xcd_barrier(barW);
        { Frame F; fill_frame(F, args, lds_base, bx, WN); p4_scan(F); }
        xcd_barrier(barW);
        { Frame F; fill_frame(F, args, lds_base, bx, WN); p5_out(F); }
        xcd_barrier(barW);
        { Frame F; fill_frame(F, args, lds_base, bx, WN); pg8::Gemm g{F.ycat, F.Bt2, SEQ, D, D}; pg8::StaticOrder S; S.init(SEQ, D, WN, bx);
          EpiH2 E{F.x, F.h2}; pg8::gemm_phase<EpiH2, pg8::StaticOrder, true, true>(F.lds, g, S, E); }
        xcd_barrier(barW);
        { Frame F; fill_frame(F, args, lds_base, bx, WN); p7_router(F); }
        xcd_barrier(barW);
        { Frame F; fill_frame(F, args, lds_base, bx, WN); p8_route(F); }
    }
    xcd_barrier(barA);
    { Frame F; fill_frame(F, args, lds_base, bx, G); LAS int* tl = (LAS int*)(lds_base + MISC_OFF + 1024);
      if (F.tid < 256) tl[F.tid] = F.tile[F.tid];
      LDS_WAIT(); __syncthreads();
      const int ntiles = __builtin_amdgcn_readfirstlane(tl[255]);
      MoeOrder S; S.init(tl, ntiles, 16, G, bx); S.rowtok = (const int*)F.xs;
      pg8::Gemm g{F.hn2, F.Btgu, SEQ, NE * 4096, D}; EpiGU8 E{(unsigned char*)F.abuf, F.b_gate, F.b_up}; pg8::gemm_phase<EpiGU8, MoeOrder, true, true, true, true>(F.lds, g, S, E); }
    xcd_barrier(barA);
    { Frame F; fill_frame(F, args, lds_base, bx, G); LAS int* tl = (LAS int*)(lds_base + MISC_OFF + 1024);
      if (F.tid < 256) tl[F.tid] = F.tile[F.tid];
      LDS_WAIT(); __syncthreads();
      const int ntiles = __builtin_amdgcn_readfirstlane(tl[255]);
      MoeOrder S; S.init(tl, ntiles, 8, G, bx);
      pg8::Gemm g{F.abuf, F.Btd, RPAD, NE * D, D}; EpiDown8 E{(unsigned char*)F.obuf, F.b_down}; pg8::gemm_phase<EpiDown8, MoeOrder, true, true, true>(F.lds, g, S, E); }
    xcd_barrier(barA);
    { Frame F; fill_frame(F, args, lds_base, bx, G); p11_final(F); }
}

extern "C" void kernel_launch(void* const* d_in, const int* in_sizes, int n_in, void* d_out, int out_size, void* d_ws, size_t ws_size, hipStream_t stream) {
    static int grid = 0;
    if (grid == 0) {
        if (n_in != 23 || out_size != SEQ * D || ws_size < WS_END) { fprintf(stderr, "kernel_launch: unexpected shapes (n_in %d out %d ws %zu need %zu)\n", n_in, out_size, ws_size, (size_t)WS_END); grid = -1; return; }
        int dev = 0, cus = 0, per_cu = 0;
        if (hipGetDevice(&dev) != hipSuccess || hipDeviceGetAttribute(&cus, hipDeviceAttributeMultiprocessorCount, dev) != hipSuccess) { grid = -1; return; }
        if (hipFuncSetAttribute((const void*)fwd, hipFuncAttributeMaxDynamicSharedMemorySize, LDS_BYTES) != hipSuccess) { fprintf(stderr, "kernel_launch: hipFuncSetAttribute failed\n"); grid = -1; return; }
        if (hipOccupancyMaxActiveBlocksPerMultiprocessor(&per_cu, (const void*)fwd, NWAVES * 64, LDS_BYTES) != hipSuccess || per_cu < 1) fprintf(stderr, "kernel_launch: occupancy query says %d\n", per_cu);
        (void)hipGetLastError();
        grid = 256;
        if (cus < 256) { fprintf(stderr, "kernel_launch: needs 256 CUs, device has %d\n", cus); grid = -1; return; }
    }
    if (grid < 0) return;
    Args a{};
    for (int i = 0; i < 23; ++i) a.in[i] = (const float*)d_in[i];
    a.out = (float*)d_out; a.ws = (unsigned char*)d_ws;
    (void)hipMemsetAsync((char*)d_ws + WS_CTL, 0, CTL_BYTES, stream);
    a.ph_lo = 0; a.ph_hi = NPH;
    hipLaunchKernelGGL(fwd, dim3(grid), dim3(NWAVES * 64), LDS_BYTES, stream, a);
}
```

```cpp
#include <hip/hip_runtime.h>
#include <cstdio>
#include <cstdint>
namespace pg8 {
#define PG8_LAS __attribute__((address_space(3)))
typedef unsigned short bf16_t;
typedef short bf16x8 __attribute__((ext_vector_type(8)));
typedef float f32x4 __attribute__((ext_vector_type(4)));
typedef unsigned u32x4 __attribute__((ext_vector_type(4)));
typedef int i32x8 __attribute__((ext_vector_type(8)));
constexpr int BM = 256, BK = 64, HALF = 128, HTB = HALF * BK * 2  , STAGE_BYTES = 8 * HTB, NXCD = 8, WGM = 8;

__host__ __device__ __forceinline__ int lds_byte(int r, int c) { const int st = (r >> 4) * 2 + (c >> 5), rr = r & 15, cc = c & 31, ob = rr * 64 + cc * 2; return st * 1024 + (ob ^ (((ob >> 9) & 1) << 5)); }
__host__ __device__ __forceinline__ void stage_rc(int b, int& R, int& C) { const int st = b / 1024, sb = b % 1024, swz = sb ^ (((sb >> 9) & 1) << 5); R = (st >> 1) * 16 + swz / 64; C = (st & 1) * 32 + (swz % 64) / 2; }
__host__ __device__ __forceinline__ int perm32(int rho) { const int n = rho >> 4, i = rho & 15; return 8 * (i >> 2) + 4 * n + (i & 3); }

struct Unit { int pm, pn; };
struct Gemm { const bf16_t* A; const bf16_t* Bt; int M, N, K; };

struct StaticOrder {
    int nM, nN, nwg, G, c;
    __host__ __device__ void init(int M, int N, int G_, int c_) { nM = M / BM; nN = N / BM; nwg = nM * nN; G = G_; c = c_; }
    __host__ __device__ bool next(int i, Unit& u) const {
        const long L = (long)i * G + c; if (L >= nwg) return false;
        int wgid = (int)L; { const int q = nwg / NXCD, r = nwg % NXCD, xcd = wgid % NXCD, off = wgid / NXCD; wgid = (xcd < r ? xcd * (q + 1) : r * (q + 1) + (xcd - r) * q) + off; }
        const int nig = WGM * nN, gid = wgid / nig, fm = gid * WGM, gsz = (nM - fm) < WGM ? (nM - fm) : WGM;
        u.pm = fm + ((wgid % nig) % gsz); u.pn = (wgid % nig) / gsz; return true;
    }
    __device__ __forceinline__ void a_ready(const Unit&) const {}
    __device__ __forceinline__ void done(const Unit&) const {}
};

__device__ __forceinline__ unsigned cvt_pk_bf16(float lo, float hi) { unsigned r; asm volatile("v_cvt_pk_bf16_f32 %0, %1, %2" : "=v"(r) : "v"(lo), "v"(hi)); return r; }
template <class Epi, class Sched, bool ALIGN_EPI = false, bool SP2 = false, bool F8 = false, bool GATHER = false>
__device__ __forceinline__ void gemm_phase(PG8_LAS unsigned char* lds, const Gemm g, const Sched& S, const Epi& E) {
    const int tid = threadIdx.x, wid = __builtin_amdgcn_readfirstlane(tid >> 6), lane = tid & 63, wr = wid >> 2, wc = wid & 3, fr = lane & 15, fq = lane >> 4;
    const int KB = F8 ? g.K : 2 * g.K  , nt = KB / 128;
    static_assert(!GATHER || (F8 && SP2), "the gather path exists in the fp8 two-super-phase loop only");
    unsigned voffA[2], voffB[2]; int gR[2]; unsigned gC[2];
    unsigned gA0[2], gA1[2], gN0[2], gN1[2]; int gT[4];
#pragma unroll
    for (int i = 0; i < 2; ++i) { int R, C; stage_rc(tid * 16 + i * 8192, R, C); const int Rb = Epi::PERM ? ((R & ~31) + perm32(R & 31)) : R;
        voffA[i] = (unsigned)(R * KB + C * 2); voffB[i] = (unsigned)(Rb * KB + C * 2); gR[i] = R; gC[i] = (unsigned)(C * 2); }
    const size_t kstep = (size_t)(BK * 2);
    const size_t hstep = (size_t)HALF * KB;
    const size_t tstep = 2 * hstep;
    const unsigned ldsw = (unsigned)wid * 1024u;
    const int aoff = lds_byte(wr * 64 + fr, F8 ? fq * 16 : fq * 8), boff = lds_byte(wc * 32 + fr, F8 ? fq * 16 : fq * 8);

#define PG8_SA(b, h) (((b) * 2 + (h)) * HTB)
#define PG8_SB(b, h) ((4 + (b) * 2 + (h)) * HTB)
#define PG8_STAGE(bufoff, gbase, voff) do { if constexpr (F8) { const char* gb_ = (const char*)(gbase); _Pragma("unroll") for (int _i = 0; _i < 2; ++_i) { \
        const unsigned la_ = (unsigned)(size_t)(lds + (bufoff) + ldsw + _i * 8192); \
        asm volatile("s_mov_b32 m0, %2\n\ts_nop 4\n\tglobal_load_lds_dwordx4 %0, %1" :: "v"((voff)[_i]), "s"(gb_), "s"(la_) : "memory", "m0"); } } else { \
        _Pragma("unroll") for (int _i = 0; _i < 2; ++_i) \
        __builtin_amdgcn_global_load_lds((const unsigned*)((const char*)(gbase) + (voff)[_i]), (PG8_LAS unsigned*)(lds + (bufoff) + ldsw + _i * 8192), 16, 0, 0); } } while (0)
#define PG8_STAGE_A(bufoff, base, h, useN) do { if constexpr (GATHER) { unsigned v_[2]; \
        v_[0] = (useN) ? ((h) ? gN1[0] : gN0[0]) : ((h) ? gA1[0] : gA0[0]); v_[1] = (useN) ? ((h) ? gN1[1] : gN0[1]) : ((h) ? gA1[1] : gA0[1]); PG8_STAGE(bufoff, base, v_); } \
        else { PG8_STAGE(bufoff, (base) + (h) * hstep, voffA); } } while (0)
#define PG8_GROWS_ISSUE(u) do { const int* rt_ = S.rowtok + (size_t)(u).pm * 256; \
        asm volatile("global_load_dword %0, %1, off" : "=v"(gT[0]) : "v"(rt_ + gR[0]) : "memory"); asm volatile("global_load_dword %0, %1, off" : "=v"(gT[1]) : "v"(rt_ + gR[1]) : "memory"); \
        asm volatile("global_load_dword %0, %1, off" : "=v"(gT[2]) : "v"(rt_ + 128 + gR[0]) : "memory"); asm volatile("global_load_dword %0, %1, off" : "=v"(gT[3]) : "v"(rt_ + 128 + gR[1]) : "memory"); } while (0)
#define PG8_GROWS_USE(d0, d1) do { asm volatile("" : "+v"(gT[0]), "+v"(gT[1]), "+v"(gT[2]), "+v"(gT[3])); \
        d0[0] = (unsigned)gT[0] * (unsigned)KB + gC[0]; d0[1] = (unsigned)gT[1] * (unsigned)KB + gC[1]; d1[0] = (unsigned)gT[2] * (unsigned)KB + gC[0]; d1[1] = (unsigned)gT[3] * (unsigned)KB + gC[1]; } while (0)
#define PG8_LDA(dst, b, h) do { if constexpr (F8) { _Pragma("unroll") for (int m = 0; m < 4; ++m) dst##8[m] = *(const PG8_LAS i32x8*)(lds + PG8_SA(b, h) + aoff + m * 2048); } else { \
        _Pragma("unroll") for (int m = 0; m < 4; ++m) _Pragma("unroll") for (int k = 0; k < 2; ++k) dst[m][k] = *(const PG8_LAS bf16x8*)(lds + PG8_SA(b, h) + aoff + m * 2048 + k * 1024); } } while (0)
#define PG8_LDB(dst, b, h) do { if constexpr (F8) { _Pragma("unroll") for (int n = 0; n < 2; ++n) dst##8[n] = *(const PG8_LAS i32x8*)(lds + PG8_SB(b, h) + boff + n * 2048); } else { \
        _Pragma("unroll") for (int n = 0; n < 2; ++n) _Pragma("unroll") for (int k = 0; k < 2; ++k) dst[n][k] = *(const PG8_LAS bf16x8*)(lds + PG8_SB(b, h) + boff + n * 2048 + k * 1024); } } while (0)
#define PG8_MMA(ai, bj, At, Bt) do { __builtin_amdgcn_s_setprio(1); if constexpr (F8) { _Pragma("unroll") for (int m = 0; m < 4; ++m) _Pragma("unroll") for (int n = 0; n < 2; ++n) \
        asm volatile("v_mfma_scale_f32_16x16x128_f8f6f4 %0, %1, %2, %0, %3, %3 op_sel_hi:[0,0,0]" : "+v"(acc[ai][bj][m][n]) : "v"(Bt##8[n]), "v"(At##8[m]), "v"(f8scale)); } else {     \
        _Pragma("unroll") for (int m = 0; m < 4; ++m) _Pragma("unroll") for (int n = 0; n < 2; ++n) _Pragma("unroll") for (int k = 0; k < 2; ++k) \
        acc[ai][bj][m][n] = __builtin_amdgcn_mfma_f32_16x16x32_bf16(Bt[n][k], At[m][k], acc[ai][bj][m][n], 0, 0, 0); } __builtin_amdgcn_s_setprio(0); } while (0)
#define PG8_WAIT_V(n) asm volatile("s_waitcnt vmcnt(" #n ")" ::: "memory")
#define PG8_WAIT_L(n) asm volatile("s_waitcnt lgkmcnt(" #n ")" ::: "memory")
#define PG8_BAR __builtin_amdgcn_s_barrier()
#define PG8_SCHED __builtin_amdgcn_sched_barrier(0)
    Unit cur, nxt; int ui = 0;
    if (!S.next(0, cur)) return;
    f32x4 acc[2][2][4][2];
#pragma unroll
    for (int a = 0; a < 2; ++a)
#pragma unroll
        for (int b = 0; b < 2; ++b)
#pragma unroll
            for (int m = 0; m < 4; ++m)
#pragma unroll
                for (int n = 0; n < 2; ++n) acc[a][b][m][n] = (f32x4){0.f, 0.f, 0.f, 0.f};
    const int f8scale = 0x7f7f7f7f;
    bf16x8 At[4][2], B0[2][2], B1[2][2]; i32x8 At8[4], B08[2], B18[2];
    const char* cA = GATHER ? (const char*)g.A : (const char*)g.A + (size_t)cur.pm * tstep; const char* cB = (const char*)g.Bt + (size_t)cur.pn * tstep;
    S.a_ready(cur);
    if constexpr (GATHER) { PG8_GROWS_ISSUE(cur); asm volatile("s_waitcnt vmcnt(0)" ::: "memory"); PG8_GROWS_USE(gA0, gA1); }
    if constexpr (SP2) {
        PG8_STAGE(PG8_SB(0, 0), cB, voffB); PG8_STAGE(PG8_SB(0, 1), cB + hstep, voffB); PG8_STAGE_A(PG8_SA(0, 0), cA, 0, false); PG8_STAGE_A(PG8_SA(0, 1), cA, 1, false);
        if (wr == 1) PG8_BAR;
        PG8_WAIT_V(2); PG8_BAR;
        PG8_STAGE(PG8_SB(1, 0), cB + kstep, voffB); PG8_STAGE_A(PG8_SA(1, 0), cA + kstep, 0, false); PG8_STAGE(PG8_SB(1, 1), cB + hstep + kstep, voffB);
        PG8_WAIT_V(6); PG8_BAR;
    } else {
        PG8_STAGE(PG8_SB(0, 0), cB, voffB); PG8_STAGE(PG8_SA(0, 0), cA, voffA); PG8_STAGE(PG8_SB(0, 1), cB + hstep, voffB); PG8_STAGE(PG8_SA(0, 1), cA + hstep, voffA);
        if (wr == 1) PG8_BAR;
        PG8_WAIT_V(4); PG8_BAR;
        PG8_STAGE(PG8_SB(1, 0), cB + kstep, voffB); PG8_STAGE(PG8_SA(1, 0), cA + kstep, voffA); PG8_STAGE(PG8_SB(1, 1), cB + hstep + kstep, voffB);
        PG8_WAIT_V(6); PG8_BAR;
    }
    for (;;) {
        const bool has_next = S.next(ui + 1, nxt);
        const char* nA = GATHER ? (const char*)g.A : (has_next ? (const char*)g.A + (size_t)nxt.pm * tstep : cA); const char* nB = has_next ? (const char*)g.Bt + (size_t)nxt.pn * tstep : cB;
        if constexpr (GATHER) { if (has_next) PG8_GROWS_ISSUE(nxt); }
        for (int t = 0; t < nt; t += 2) {
            const bool last = (t == nt - 2);
            const char* a1 = cA + (size_t)(t + 1) * kstep;
            const char* a2 = last ? nA : cA + (size_t)(t + 2) * kstep; const char* b2 = last ? nB : cB + (size_t)(t + 2) * kstep;
            const char* a3 = a2 + kstep; const char* b3 = b2 + kstep;
            if (last && has_next) S.a_ready(nxt);
            if constexpr (SP2) {
            PG8_LDB(B0, 0, 0); PG8_LDB(B1, 0, 1); PG8_SCHED; PG8_LDA(At, 0, 0); PG8_STAGE_A(PG8_SA(1, 1), a1, 1, false);
            PG8_WAIT_V(8); PG8_WAIT_L(0);
            if constexpr (GATHER) { if (last) { if (has_next) PG8_GROWS_USE(gN0, gN1); else { gN0[0] = gA0[0]; gN0[1] = gA0[1]; gN1[0] = gA1[0]; gN1[1] = gA1[1]; } } }
            PG8_BAR; PG8_MMA(0, 0, At, B0); PG8_MMA(0, 1, At, B1); PG8_BAR; PG8_SCHED;
            PG8_LDA(At, 0, 1); PG8_STAGE(PG8_SB(0, 0), b2, voffB); PG8_STAGE(PG8_SB(0, 1), b2 + hstep, voffB); PG8_STAGE_A(PG8_SA(0, 0), a2, 0, last);
            PG8_WAIT_V(8); PG8_WAIT_L(0); PG8_BAR; PG8_MMA(1, 0, At, B0); PG8_MMA(1, 1, At, B1); PG8_BAR; PG8_SCHED;
            PG8_LDB(B0, 1, 0); PG8_LDB(B1, 1, 1); PG8_SCHED; PG8_LDA(At, 1, 0); PG8_STAGE_A(PG8_SA(0, 1), a2, 1, last);
            PG8_WAIT_V(8); PG8_WAIT_L(0); PG8_BAR; PG8_MMA(0, 0, At, B0); PG8_MMA(0, 1, At, B1); PG8_BAR; PG8_SCHED;
            PG8_LDA(At, 1, 1); PG8_STAGE(PG8_SB(1, 0), b3, voffB); PG8_STAGE(PG8_SB(1, 1), b3 + hstep, voffB); PG8_STAGE_A(PG8_SA(1, 0), a3, 0, last);
            PG8_WAIT_V(8); PG8_WAIT_L(0); PG8_BAR; PG8_MMA(1, 0, At, B0); PG8_MMA(1, 1, At, B1); PG8_BAR; PG8_SCHED;
            } else {
            PG8_LDB(B0, 0, 0); PG8_SCHED; PG8_LDA(At, 0, 0); PG8_STAGE(PG8_SA(1, 1), a1 + hstep, voffA);
            PG8_WAIT_L(8); PG8_BAR; PG8_WAIT_L(0); PG8_MMA(0, 0, At, B0); PG8_BAR; PG8_SCHED;
            PG8_LDB(B1, 0, 1); PG8_STAGE(PG8_SB(0, 0), b2, voffB);
            PG8_BAR; PG8_WAIT_L(0); PG8_MMA(0, 1, At, B1); PG8_BAR;
            PG8_LDA(At, 0, 1); PG8_STAGE(PG8_SA(0, 0), a2, voffA);
            PG8_BAR; PG8_WAIT_L(0); PG8_MMA(1, 0, At, B0); PG8_BAR; PG8_SCHED;
            PG8_STAGE(PG8_SB(0, 1), b2 + hstep, voffB);
            PG8_WAIT_V(6); PG8_BAR; PG8_MMA(1, 1, At, B1); PG8_BAR;
            PG8_LDB(B0, 1, 0); PG8_SCHED; PG8_LDA(At, 1, 0); PG8_STAGE(PG8_SA(0, 1), a2 + hstep, voffA);
            PG8_WAIT_L(8); PG8_BAR; PG8_WAIT_L(0); PG8_MMA(0, 0, At, B0); PG8_BAR; PG8_SCHED;
            PG8_LDB(B1, 1, 1); PG8_STAGE(PG8_SB(1, 0), b3, voffB);
            PG8_BAR; PG8_WAIT_L(0); PG8_MMA(0, 1, At, B1); PG8_BAR;
            PG8_LDA(At, 1, 1); PG8_STAGE(PG8_SA(1, 0), a3, voffA);
            PG8_BAR; PG8_WAIT_L(0); PG8_MMA(1, 0, At, B0); PG8_BAR; PG8_SCHED;
            PG8_STAGE(PG8_SB(1, 1), b3 + hstep, voffB);
            PG8_WAIT_V(6); PG8_BAR; PG8_MMA(1, 1, At, B1); PG8_BAR;
            }
        }
        if constexpr (ALIGN_EPI) { if (wr == 0) PG8_BAR; }
        if constexpr (F8) asm volatile("s_nop 15\n\ts_nop 7" ::: "memory");
        if constexpr (!Epi::AFTER_DRAIN) {
            int tz_ = threadIdx.x; asm volatile("" : "+v"(tz_)); const int l_ = tz_ & 63, w_ = __builtin_amdgcn_readfirstlane(tz_ >> 6);
            E(acc, cur, w_ >> 2, w_ & 3, l_ & 15, l_ >> 4); S.done(cur); }
        if (!has_next) break;
#pragma unroll
        for (int a = 0; a < 2; ++a)
#pragma unroll
            for (int b = 0; b < 2; ++b)
#pragma unroll
                for (int m = 0; m < 4; ++m)
#pragma unroll
                    for (int n = 0; n < 2; ++n) acc[a][b][m][n] = (f32x4){0.f, 0.f, 0.f, 0.f};
        cur = nxt; cA = nA; cB = nB; ++ui;
        if constexpr (GATHER) { gA0[0] = gN0[0]; gA0[1] = gN0[1]; gA1[0] = gN1[0]; gA1[1] = gN1[1]; }
        if constexpr (ALIGN_EPI) { if (wr == 1) PG8_BAR; }
    }
    PG8_WAIT_V(0);
    if constexpr (!ALIGN_EPI) { if (wr == 0) PG8_BAR; }
    PG8_BAR;
    if constexpr (Epi::AFTER_DRAIN) { E.fused(acc, cur, wr, wc, fr, fq, lds, wid, lane); S.done(cur); }
#undef PG8_SA
#undef PG8_SB
#undef PG8_STAGE
#undef PG8_STAGE_A
#undef PG8_GROWS_ISSUE
#undef PG8_GROWS_USE
#undef PG8_LDA
#undef PG8_LDB
#undef PG8_MMA
#undef PG8_WAIT_V
#undef PG8_WAIT_L
#undef PG8_BAR
#undef PG8_SCHED
}
}
#define LAS __attribute__((address_space(3)))
#define XB_TMO      128
#define XB_XCNT(j)  (256  + 64 * (j))
#define XB_XSUB(j)  (1280 + 64 * (j))
#define XB_XGEN(j)  (2304 + 64 * (j))
#define XB_TOP      3328
#define XB_TOPGEN   3392
#define XCD_BAR_WORDS 3456
#define XB_SPIN_CAP (1u << 18)

__device__ __forceinline__ unsigned xb_ld(unsigned* p)              { return __hip_atomic_load(p, __ATOMIC_RELAXED, __HIP_MEMORY_SCOPE_AGENT); }
__device__ __forceinline__ unsigned xb_add(unsigned* p, unsigned v) { return __hip_atomic_fetch_add(p, v, __ATOMIC_RELAXED, __HIP_MEMORY_SCOPE_AGENT); }
__device__ __forceinline__ unsigned xb_xcc_id() { return (unsigned)__builtin_amdgcn_s_getreg((3 << 11) | 20) & 0xFu; }
#define XB_SPIN(cond, bar) do { unsigned _sp = 0; while (cond) { __builtin_amdgcn_s_sleep(1); \
    if ((++_sp & 255u) == 0u) { if (xb_ld(&(bar)[XB_TMO])) break; if (_sp > XB_SPIN_CAP) { atomicAdd(&(bar)[XB_TMO], 1u); break; } } } } while (0)

struct XcdBarrier {
    unsigned* bar; unsigned x;
    volatile LAS unsigned* st;
    unsigned G;
};

__device__ __forceinline__ XcdBarrier xcd_barrier_post(unsigned* bar, volatile LAS unsigned* st, unsigned G) {
    XcdBarrier b; b.bar = bar; b.x = xb_xcc_id(); b.st = st; b.G = G;
    if (threadIdx.x == 0) (void)xb_add(&bar[XB_XCNT(b.x)], 1u);
    return b;
}
__device__ __forceinline__ void xcd_barrier_complete(unsigned* bar, unsigned x, unsigned& nloc, unsigned& nx, const unsigned G) {
    unsigned sum, cnt, mine, sp = 0u;
    for (;;) {
        sum = 0u; cnt = 0u; mine = 0u;
#pragma unroll
        for (unsigned j = 0; j < 16; ++j) { const unsigned c = xb_ld(&bar[XB_XCNT(j)]); sum += c; cnt += (c > 0u) ? 1u : 0u; mine = (j == x) ? c : mine; }
        if (sum == G) break;
        __builtin_amdgcn_s_sleep(1);
        if ((++sp & 255u) == 0u) { if (xb_ld(&bar[XB_TMO])) break; if (sp > XB_SPIN_CAP) { atomicAdd(&bar[XB_TMO], 1u); break; } }
    }
    nloc = mine > 0u ? mine : 1u; nx = cnt > 0u ? cnt : 1u;
}

__device__ __forceinline__ void xcd_barrier(const XcdBarrier& b) {
    asm volatile("s_waitcnt vmcnt(0)" ::: "memory");
    __syncthreads();
    if (threadIdx.x == 0) {
        unsigned* bar = b.bar;
        __builtin_amdgcn_s_waitcnt(0);
        unsigned nloc = b.st[0], nx = b.st[1];
        if (nloc == 0u) { xcd_barrier_complete(bar, b.x, nloc, nx, b.G); b.st[0] = nloc; b.st[1] = nx; }
        const unsigned old = xb_add(&bar[XB_XSUB(b.x)], 1u);
        const unsigned gen = old / nloc;
        if (old + 1u == (gen + 1u) * nloc) {
            __builtin_amdgcn_fence(__ATOMIC_RELEASE, "agent");
            asm volatile("s_waitcnt vmcnt(0)" ::: "memory");
            const unsigned og = xb_add(&bar[XB_TOP], 1u);
            const unsigned tg = og / nx;
            if (og + 1u == (tg + 1u) * nx) xb_add(&bar[XB_TOPGEN], 1u);
            else XB_SPIN(xb_ld(&bar[XB_TOPGEN]) == tg, bar);
            __builtin_amdgcn_fence(__ATOMIC_ACQUIRE, "agent");
            xb_add(&bar[XB_XGEN(b.x)], 1u);
            asm volatile("s_waitcnt vmcnt(0)" ::: "memory");
        } else {
            XB_SPIN(xb_ld(&bar[XB_XGEN(b.x)]) == gen, bar);
            __builtin_amdgcn_fence(__ATOMIC_ACQUIRE, "agent");
            asm volatile("s_waitcnt vmcnt(0)" ::: "memory");
        }
    }
    __syncthreads();
}
constexpr int D = 2048, SEQ = 8192, NMETA = 16, LEAD = 48, NP = 8256  , MP = 8448  ;
constexpr int NPROJ = 3840, C_Z = 1024, C_X = 2048, C_B = 3072, C_C = 3328, C_DT = 3584, NINPROJ = 3600;
constexpr int NE = 32, DCONV = 1536;
constexpr int RTILES = 160, RPAD = RTILES * 256;
constexpr float EPS = 1e-5f;
constexpr int NWAVES = 8, NPH = 12;
#ifndef WN_WORKERS
#define WN_WORKERS 136
#endif
constexpr int WN = WN_WORKERS;
#ifndef MOE_F8
#define MOE_F8 1
#endif
#ifndef MOE_RB
#define MOE_RB 0
#endif
#ifndef MK_ONE_LAUNCH
#define MK_ONE_LAUNCH 1
#endif

constexpr size_t WS_CTL = 0, CTL_BYTES = 1u << 20;
constexpr size_t WS_HN = CTL_BYTES;
constexpr size_t WS_BT1 = WS_HN + (size_t)MP * D * 2;
constexpr size_t WS_BT2 = WS_BT1 + (size_t)NPROJ * D * 2;
constexpr size_t WS_PROJ = WS_BT2 + (size_t)D * D * 2;
constexpr size_t WS_XT = WS_PROJ + (size_t)MP * NPROJ * 2;
constexpr size_t WS_BTT = WS_XT + (size_t)1024 * NP * 2;
constexpr size_t WS_BC = WS_BTT + (size_t)256 * NP * 2;
constexpr size_t WS_CC = WS_BC + (size_t)NP * 256 * 2;
constexpr size_t WS_DT = WS_CC + (size_t)NP * 256 * 2;
constexpr size_t WS_ST = WS_DT + (size_t)NP * 16 * 4;
constexpr size_t WS_DEC = WS_ST + (size_t)128 * 131072 * 4;
constexpr size_t WS_PREV = WS_DEC + 128 * 16 * 4;
constexpr size_t WS_YCAT = WS_PREV + (size_t)128 * 131072 * 2;
constexpr size_t WS_H2 = WS_YCAT + (size_t)SEQ * D * 2;
constexpr size_t WS_HN2 = WS_H2 + (size_t)SEQ * D * 4;
constexpr size_t WS_WR = WS_HN2 + (size_t)SEQ * D * 2;
constexpr size_t WS_TKE = WS_WR + (size_t)D * NE * 4;
constexpr size_t WS_TKG = WS_TKE + (size_t)SEQ * 16;
constexpr size_t WS_POS = WS_TKG + (size_t)SEQ * 16;
constexpr size_t WS_CNT = WS_POS + (size_t)SEQ * 16;
constexpr size_t WS_TILE = WS_CNT + 256 * 32 * 4;
constexpr size_t WS_XS = WS_TILE + 1024;
constexpr size_t WS_A = WS_XS + (size_t)RPAD * D * 2;
constexpr size_t WS_O = WS_A + (size_t)RPAD * D * 2;
constexpr size_t WS_BTGU = WS_O + (MOE_F8 ? (size_t)RPAD * D * 2 : 0);
constexpr size_t WS_BTD = WS_BTGU + (size_t)NE * 4096 * D * (MOE_F8 ? 1 : 2);
constexpr size_t WS_END = WS_BTD + (size_t)NE * D * D * (MOE_F8 ? 1 : 2);
constexpr int CW_BAR = 4096, CW_BAR2 = 8192;
static_assert((CW_BAR2 + XCD_BAR_WORDS) * 4 <= (int)CTL_BYTES && CW_BAR + XCD_BAR_WORDS <= CW_BAR2, "ctl");

constexpr int RING_BYTES = 131072, SCR_BYTES = 135168, MISC_OFF = SCR_BYTES, LDS_BYTES = 147456;

#define DI __device__ __forceinline__
typedef unsigned short bf16;
typedef unsigned v4u __attribute__((ext_vector_type(4)));
typedef unsigned v2u __attribute__((ext_vector_type(2)));
typedef float f32x4 __attribute__((ext_vector_type(4)));
typedef float f32x16 __attribute__((ext_vector_type(16)));
typedef short bf16x8 __attribute__((ext_vector_type(8)));
#define LDS_WAIT() asm volatile("s_waitcnt lgkmcnt(0)" ::: "memory")
#define MFMA32(a, b, c) __builtin_amdgcn_mfma_f32_32x32x16_bf16((a), (b), (c), 0, 0, 0)
DI float bf_lo(unsigned w) { return __uint_as_float(w << 16); }
DI float bf_hi(unsigned w) { return __uint_as_float(w & 0xffff0000u); }
DI float bf2f(bf16 v) { return __uint_as_float(((unsigned)v) << 16); }
typedef __bf16 bf2v __attribute__((ext_vector_type(2)));
typedef float f2v __attribute__((ext_vector_type(2)));
DI unsigned pk2(float lo, float hi) { const f2v v = {lo, hi}; const bf2v b = __builtin_convertvector(v, bf2v); return __builtin_bit_cast(unsigned, b); }
DI unsigned pk4_f8(float a, float b, float c, float d) { int p = __builtin_amdgcn_cvt_pk_fp8_f32(a, b, 0, false); p = __builtin_amdgcn_cvt_pk_fp8_f32(c, d, p, true); return (unsigned)p; }
DI bf16 f2bf(float f) { return (bf16)(pk2(f, 0.f) & 0xffffu); }
DI float wave_sum(float v) {
#pragma unroll
    for (int o = 1; o < 64; o <<= 1) v += __shfl_xor(v, o);
    return v;
}
DI float wave_incl_scan(float v, int lane) {
#pragma unroll
    for (int o = 1; o < 64; o <<= 1) { const float t = __shfl_up(v, o); if (lane >= o) v += t; }
    return v;
}
DI float silu_f(float x) { return x * __builtin_amdgcn_rcpf(1.f + __expf(-x)); }

struct Frame {
    LAS unsigned char* lds;
    int tid, lane, wave, gw, ngw, bid, nwg;
    const float *x, *meta, *g1, *w_in, *pool_w, *pool_scale, *conv_w, *conv_b, *dt_bias, *a_log, *d_skip, *ssm_g, *w_out, *g2, *router_w, *router_b,
        *w_gate, *b_gate, *w_up, *b_up, *w_down, *b_down, *final_g;
    float* out;
    bf16 *hn, *Bt1, *Bt2, *proj, *xT, *BT, *Bc, *Cc, *prev, *ycat, *hn2, *xs, *abuf, *obuf, *Btgu, *Btd;
    float *dtv, *decay, *Wr, *tkg; bf16 *states, *h2;
    int *tke, *pos, *cnt, *tile;
};

DI int crow16(int reg, int hf) { return (reg & 3) + 8 * (reg >> 2) + 4 * hf; }
DI void p0_norm(Frame& F) {
    const f32x4* gr = (const f32x4*)F.g1 + F.lane;
    for (int P0 = F.gw; P0 < NP; P0 += 2 * F.ngw) {
        f32x4 v[2][8]; bool live[2];
#pragma unroll
        for (int u = 0; u < 2; ++u) { const int P = P0 + u * F.ngw; live[u] = (P >= LEAD && P < NP);
            const int t = live[u] ? P - LEAD : 0;
            const float* src = t < NMETA ? F.meta + (size_t)t * D : F.x + (size_t)(t - NMETA) * D;
            const f32x4* xr = (const f32x4*)src + F.lane;
#pragma unroll
            for (int j = 0; j < 8; ++j) v[u][j] = xr[64 * j]; }
#pragma unroll
        for (int u = 0; u < 2; ++u) { const int P = P0 + u * F.ngw; if (P >= NP) continue;
            unsigned long long* o8 = (unsigned long long*)(F.hn + (size_t)P * D) + F.lane;
            if (!live[u]) {
#pragma unroll
                for (int j = 0; j < 8; ++j) o8[64 * j] = 0ull;
                continue; }
            float s = 0.f;
#pragma unroll
            for (int j = 0; j < 8; ++j) s += (v[u][j].x * v[u][j].x + v[u][j].y * v[u][j].y) + (v[u][j].z * v[u][j].z + v[u][j].w * v[u][j].w);
            const float rstd = rsqrtf(wave_sum(s) * (1.f / D) + EPS);
#pragma unroll
            for (int j = 0; j < 8; ++j) { const f32x4 g = gr[64 * j];
                o8[64 * j] = (unsigned long long)pk2(v[u][j].x * rstd * g.x, v[u][j].y * rstd * g.y) | ((unsigned long long)pk2(v[u][j].z * rstd * g.z, v[u][j].w * rstd * g.w) << 32); }
        }
    }
}
typedef unsigned int bs_u4 __attribute__((__vector_size__(16)));
DI void tr_load(float (&v)[64], const float* W, size_t ldw, int nvalid, int lane) {
    const int r4 = lane >> 4, n4 = lane & 15;
    if (4 * n4 < nvalid) {
        const __amdgpu_buffer_rsrc_t rs = __builtin_amdgcn_make_buffer_rsrc((void*)W, 0, 0x7fffffff, 0x00020000);
        const int voff = (r4 * (int)ldw + 4 * n4) * 4;
#pragma unroll
        for (int u = 0; u < 16; ++u) { const f32x4 q = __builtin_bit_cast(f32x4, __builtin_amdgcn_raw_buffer_load_b128(rs, voff, u * 16 * (int)ldw, 2)); v[4 * u] = q.x; v[4 * u + 1] = q.y; v[4 * u + 2] = q.z; v[4 * u + 3] = q.w; }
    } else {
#pragma unroll
        for (int kk = 0; kk < 64; ++kk) v[kk] = 0.f;
    }
}
DI void tr_to_lds(const float (&v)[64], LAS float* scr, int lane, float scale) {
    const int r4 = lane >> 4, n4 = lane & 15; LAS float* d = scr + r4 * 65 + 4 * n4;
#pragma unroll
    for (int u = 0; u < 16; ++u) {
#pragma unroll
        for (int e = 0; e < 4; ++e) d[(4 * u) * 65 + e] = v[4 * u + e] * scale;
        __builtin_amdgcn_sched_barrier(0); }
}
DI void tr_store(const float (&v)[64], int nvalid, bf16* WT, size_t ldt, LAS float* scr, int lane) {
    tr_to_lds(v, scr, lane, 1.f);
    LDS_WAIT();
    const int c = lane & 7;
    const __amdgpu_buffer_rsrc_t rs = __builtin_amdgcn_make_buffer_rsrc((void*)WT, 0, 0x7fffffff, 0x00020000);
    const int voff = ((lane >> 3) * (int)ldt + 8 * c) * 2;
#pragma unroll
    for (int j = 0; j < 8; ++j) { const int n = (lane >> 3) + 8 * j; const LAS float* s = scr + (8 * c) * 65 + n;
        v4u o; o.x = pk2(s[0], s[65]); o.y = pk2(s[130], s[195]); o.z = pk2(s[260], s[325]); o.w = pk2(s[390], s[455]);
        if (n < nvalid) __builtin_amdgcn_raw_buffer_store_b128(__builtin_bit_cast(bs_u4, o), rs, voff, 16 * j * (int)ldt, 0); __builtin_amdgcn_sched_barrier(0); }
    LDS_WAIT();
}
DI void tr_store8(const float (&v)[64], unsigned char* WT, size_t ldt, LAS float* scr, int lane, float scale) {
    tr_to_lds(v, scr, lane, scale);
    LDS_WAIT();
    const int c = lane & 3;
    const __amdgpu_buffer_rsrc_t rs = __builtin_amdgcn_make_buffer_rsrc((void*)WT, 0, 0x7fffffff, 0x00020000);
    const int voff = (lane >> 2) * (int)ldt + 16 * c;
#pragma unroll
    for (int j = 0; j < 4; ++j) { const int n = (lane >> 2) + 16 * j; const LAS float* s = scr + (16 * c) * 65 + n;
        v4u o; o.x = pk4_f8(s[0], s[65], s[130], s[195]); o.y = pk4_f8(s[260], s[325], s[390], s[455]);
        o.z = pk4_f8(s[520], s[585], s[650], s[715]); o.w = pk4_f8(s[780], s[845], s[910], s[975]);
        __builtin_amdgcn_raw_buffer_store_b128(__builtin_bit_cast(bs_u4, o), rs, voff, 16 * j * (int)ldt, 2); __builtin_amdgcn_sched_barrier(0); }
    LDS_WAIT();
}
struct TrItem { const float* W; bf16* WT; int ldw, nv; };
constexpr int I_IN = 32 * 57, I_OUT = 16 * 32, I_MOE = MOE_RB ? 0 : NE * 3 * 32 * 32, NITEMS = I_IN + I_OUT + I_MOE;
constexpr float W8_SCALE = 1024.f, X8_SCALE = 16.f, A8_SCALE = 4.f, O8_SCALE = 16.f;
DI TrItem tr_get(Frame& F, int it) {
    TrItem t; int r = it;
    if (r < I_MOE) {
        const int nb = r & 31, kb = (r >> 5) & 31, em = r >> 10, mat = em % 3, e = em / 3;
        t.ldw = D; t.nv = 64;
        constexpr int ES = MOE_F8 ? 1 : 2;
        if (mat == 2) { t.W = F.w_down + (size_t)e * D * D + (size_t)(64 * kb) * D + 64 * nb; t.WT = (bf16*)((unsigned char*)F.Btd + (((size_t)e * D + 64 * nb) * D + 64 * kb) * ES); }
        else { t.W = (mat == 0 ? F.w_gate : F.w_up) + (size_t)e * D * D + (size_t)(64 * kb) * D + 64 * nb;
               const int row = 256 * (nb >> 1) + 64 * (nb & 1) + 128 * mat; t.WT = (bf16*)((unsigned char*)F.Btgu + (((size_t)e * 4096 + row) * D + 64 * kb) * ES); }
        return t;
    }
    r -= I_MOE;
    if (r < I_IN) { const int kb = r / 57, nb = r % 57; t.ldw = NINPROJ; t.nv = (nb == 56) ? 16 : 64;
        t.W = F.w_in + (size_t)(64 * kb) * NINPROJ + 64 * nb; t.WT = F.Bt1 + (size_t)(64 * nb) * D + 64 * kb; return t; }
    r -= I_IN;
    { const int kb = r >> 5, nb = r & 31; t.ldw = D; t.nv = 64;
      t.W = F.w_out + (size_t)(1024 + 64 * kb) * D + 64 * nb; t.WT = F.Bt2 + (size_t)(64 * nb) * D + 1024 + 64 * kb; return t; }
}
template <bool MOE>
DI void p0_weights_range(Frame& F, const int it_lo, const int it_hi) {
    LAS float* scr = (LAS float*)(F.lds + F.wave * 16640);
    float va[64], vb[64], vc[64];
    int it = it_lo + F.gw; const int st = F.ngw;
    if (it >= it_hi) return;
#define TR_LOAD(v, t) tr_load(v, (t).W, (t).ldw, MOE ? 64 : (t).nv, F.lane)
#define TR_EMIT(v, t) do { if constexpr (MOE) tr_store8(v, (unsigned char*)(t).WT, D, scr, F.lane, W8_SCALE); else tr_store(v, (t).nv, (t).WT, D, scr, F.lane); } while (0)
    TrItem ta = tr_get(F, it), tb = ta, tc = ta;
    TR_LOAD(va, ta);
    if (it + 4 * st < it_hi) {
        tb = tr_get(F, it + st); TR_LOAD(vb, tb);
        do {
            tc = tr_get(F, it + 2 * st); TR_LOAD(vc, tc); TR_EMIT(va, ta);
            ta = tr_get(F, it + 3 * st); TR_LOAD(va, ta); TR_EMIT(vb, tb);
            tb = tr_get(F, it + 4 * st); TR_LOAD(vb, tb); TR_EMIT(vc, tc);
            it += 3 * st;
        } while (it + 4 * st < it_hi);
    } else if (it + st < it_hi) { tb = tr_get(F, it + st); TR_LOAD(vb, tb); }
    bool hb = it + st < it_hi;
    for (;;) {
        const bool hc = it + 2 * st < it_hi;
        if (hc) { tc = tr_get(F, it + 2 * st); TR_LOAD(vc, tc); }
        TR_EMIT(va, ta);
        if (!hb) break;
        const bool ha = it + 3 * st < it_hi;
        if (ha) { ta = tr_get(F, it + 3 * st); TR_LOAD(va, ta); }
        TR_EMIT(vb, tb);
        if (!hc) break;
        hb = it + 4 * st < it_hi;
        if (hb) { tb = tr_get(F, it + 4 * st); TR_LOAD(vb, tb); }
        TR_EMIT(vc, tc);
        if (!ha) break;
        it += 3 * st;
    }
#undef TR_EMIT
#undef TR_LOAD
}
DI void p0_weff(Frame& F) {
    const int lane = F.lane, li = lane & 31, kh = lane >> 5;
    for (int task = F.gw; task < 2048; task += F.ngw) {
        const int g = task >> 9, rem = task & 511, cb = rem >> 6, nb = rem & 63;
        const float* wo = F.w_out + (size_t)(256 * g + 4 * kh) * D + 32 * nb + li;
        const float* ps = F.pool_scale + 256 * g + 4 * kh;
        const float* pw = F.pool_w + (size_t)(g * 256 + 32 * cb + li) * 256 + 4 * kh;
        f32x16 acc;
#pragma unroll
        for (int i = 0; i < 16; ++i) acc[i] = 0.f;
#pragma unroll 8
        for (int jj = 0; jj < 32; ++jj) {
            const f32x4 b = *(const f32x4*)(pw + 8 * jj), sc = *(const f32x4*)(ps + 8 * jj);
            const float a0 = wo[(size_t)(8 * jj) * D] * sc.x, a1 = wo[(size_t)(8 * jj + 1) * D] * sc.y, a2 = wo[(size_t)(8 * jj + 2) * D] * sc.z, a3 = wo[(size_t)(8 * jj + 3) * D] * sc.w;
            acc = __builtin_amdgcn_mfma_f32_32x32x2f32(a0, b.x, acc, 0, 0, 0);
            acc = __builtin_amdgcn_mfma_f32_32x32x2f32(a1, b.y, acc, 0, 0, 0);
            acc = __builtin_amdgcn_mfma_f32_32x32x2f32(a2, b.z, acc, 0, 0, 0);
            acc = __builtin_amdgcn_mfma_f32_32x32x2f32(a3, b.w, acc, 0, 0, 0);
        }
        bf16* dst = F.Bt2 + (size_t)(32 * nb) * D + 256 * g + 32 * cb + li;
#pragma unroll
        for (int i = 0; i < 16; ++i) dst[(size_t)crow16(i, kh) * D] = f2bf(acc[i]);
    }
}
DI void p0_router_fold(Frame& F) {
    for (int i = F.bid * 512 + F.tid; i < D * NE; i += F.nwg * 512) F.Wr[i] = F.g2[i >> 5] * F.router_w[i];
}

DI void e_conv_tile(Frame& F, int c, int pcol, int cch, bf16* outT, bf16* outR, int rcol) {
    const int lane = F.lane, ch = cch + lane;
    const float w0 = F.conv_w[ch], w1 = F.conv_w[DCONV + ch], w2 = F.conv_w[2 * DCONV + ch], w3 = F.conv_w[3 * DCONV + ch], b = F.conv_b[ch];
    const bf16* src = F.proj + pcol + lane;
    const int P0 = 64 * c;
    bf16 raw[67];
#pragma unroll
    for (int i = 0; i < 3; ++i) raw[i] = (P0 - 3 + i >= 0) ? src[(size_t)(P0 - 3 + i) * NPROJ] : (bf16)0;
#pragma unroll
    for (int i = 0; i < 64; ++i) raw[3 + i] = src[(size_t)(P0 + i) * NPROJ];
#pragma unroll
    for (int sb = 0; sb < 4; ++sb) {
        float o[16];
#pragma unroll
        for (int i = 0; i < 16; ++i) { const int q = 16 * sb + i;
            const float a = b + w0 * bf2f(raw[q]) + w1 * bf2f(raw[q + 1]) + w2 * bf2f(raw[q + 2]) + w3 * bf2f(raw[q + 3]);
            o[i] = (P0 + q >= LEAD) ? silu_f(a) : 0.f; }
        if (outT) { v4u q0, q1;
            q0.x = pk2(o[0], o[1]); q0.y = pk2(o[2], o[3]); q0.z = pk2(o[4], o[5]); q0.w = pk2(o[6], o[7]);
            q1.x = pk2(o[8], o[9]); q1.y = pk2(o[10], o[11]); q1.z = pk2(o[12], o[13]); q1.w = pk2(o[14], o[15]);
            bf16* dst = outT + (size_t)lane * NP + P0 + 16 * sb; *(v4u*)dst = q0; *(v4u*)(dst + 8) = q1; }
        if (outR) {
#pragma unroll
            for (int i = 0; i < 16; ++i) outR[(size_t)(P0 + 16 * sb + i) * 256 + rcol + lane] = f2bf(o[i]); }
    }
}
template <int W> DI void e_pool_tile(Frame& F, int c, int colbase) {
    const int lane = F.lane; const bf16* src = F.proj + colbase + lane; const int P0 = 64 * c;
    bf16 raw[64 + W - 1];
#pragma unroll
    for (int i = 0; i < 64 + W - 1; ++i) raw[i] = src[(size_t)(P0 - (W - 1) + i) * NPROJ];
#pragma unroll
    for (int sb = 0; sb < 4; ++sb) {
#pragma unroll
        for (int i = 0; i < 16; ++i) { const int q = 16 * sb + i; float s = 0.f;
#pragma unroll
            for (int j = 0; j < W; ++j) s += bf2f(raw[q + j]);
            F.ycat[(size_t)(P0 - 64 + q) * D + colbase + lane] = f2bf(s * (1.f / W) - bf2f(raw[q + W - 1])); }
    }
}
DI void e_dt_tile(Frame& F, int c) {
    const int P = 64 * c + F.lane;
    const v4u* src = (const v4u*)(F.proj + (size_t)P * NPROJ + C_DT);
    const v4u r0 = src[0], r1 = src[1];
    const unsigned w[8] = {r0.x, r0.y, r0.z, r0.w, r1.x, r1.y, r1.z, r1.w};
    float o[16];
#pragma unroll
    for (int i = 0; i < 8; ++i) { o[2 * i] = bf_lo(w[i]); o[2 * i + 1] = bf_hi(w[i]); }
#pragma unroll
    for (int h = 0; h < 16; ++h) { const float x = o[h] + F.dt_bias[h]; const float sp = fmaxf(x, 0.f) + log1pf(__expf(-fabsf(x))); o[h] = (P >= LEAD) ? sp : 0.f; }
    f32x4* dst = (f32x4*)(F.dtv + (size_t)P * 16);
#pragma unroll
    for (int q = 0; q < 4; ++q) dst[q] = (f32x4){o[4 * q], o[4 * q + 1], o[4 * q + 2], o[4 * q + 3]};
}
DI void p2_elem(Frame& F) {
    constexpr int NT = 129 * 41;
    for (int task = F.gw; task < NT; task += F.ngw) {
        const int c = task / 41, j = task % 41;
        if (j < 16) { if (c == 0) continue; const int g = j >> 2;
            if (g == 0) e_pool_tile<2>(F, c, 64 * j); else if (g == 1) e_pool_tile<4>(F, c, 64 * j); else if (g == 2) e_pool_tile<8>(F, c, 64 * j); else e_pool_tile<16>(F, c, 64 * j); }
        else if (j < 32) e_conv_tile(F, c, C_X + 64 * (j - 16), 64 * (j - 16), F.xT + (size_t)(64 * (j - 16)) * NP, nullptr, 0);
        else if (j < 36) e_conv_tile(F, c, C_B + 64 * (j - 32), 1024 + 64 * (j - 32), F.BT + (size_t)(64 * (j - 32)) * NP, F.Bc, 64 * (j - 32));
        else if (j < 40) e_conv_tile(F, c, C_C + 64 * (j - 36), 1280 + 64 * (j - 36), nullptr, F.Cc, 64 * (j - 36));
        else e_dt_tile(F, c);
    }
}

DI void p3_states(Frame& F) {
    const int lane = F.lane, r = lane & 31, hf = lane >> 5;
    LAS float* wsm = (LAS float*)(F.lds + F.wave * 256);
    for (int u = F.bid; u < 256; u += F.nwg) {
        const int c = u >> 1, g = u & 1, h = 8 * g + F.wave;
        const float A = -__expf(F.a_log[h]);
        const float dtl = F.dtv[(size_t)(64 * c + lane) * 16 + h];
        const float acs = wave_incl_scan(dtl * A, lane);
        const float tot = __shfl(acs, 63);
        wsm[lane] = dtl * __expf(tot - acs);
        if (lane == 0) F.decay[c * 16 + h] = __expf(tot);
        LDS_WAIT();
        f32x16 acc[2][4];
#pragma unroll
        for (int mt = 0; mt < 2; ++mt)
#pragma unroll
            for (int nt = 0; nt < 4; ++nt)
#pragma unroll
                for (int i = 0; i < 16; ++i) acc[mt][nt][i] = 0.f;
#pragma unroll
        for (int ks = 0; ks < 4; ++ks) {
            const f32x4 wa = *(const LAS f32x4*)(wsm + 16 * ks + 8 * hf), wb = *(const LAS f32x4*)(wsm + 16 * ks + 8 * hf + 4);
            bf16x8 af[2], bfr[4];
#pragma unroll
            for (int mt = 0; mt < 2; ++mt) {
                const v4u raw = *(const v4u*)(F.xT + (size_t)(h * 64 + 32 * mt + r) * NP + 64 * c + 16 * ks + 8 * hf);
                v4u sc; sc.x = pk2(bf_lo(raw.x) * wa.x, bf_hi(raw.x) * wa.y); sc.y = pk2(bf_lo(raw.y) * wa.z, bf_hi(raw.y) * wa.w);
                sc.z = pk2(bf_lo(raw.z) * wb.x, bf_hi(raw.z) * wb.y); sc.w = pk2(bf_lo(raw.w) * wb.z, bf_hi(raw.w) * wb.w);
                af[mt] = __builtin_bit_cast(bf16x8, sc);
            }
#pragma unroll
            for (int nt = 0; nt < 4; ++nt) bfr[nt] = *(const bf16x8*)(F.BT + (size_t)(g * 128 + 32 * nt + r) * NP + 64 * c + 16 * ks + 8 * hf);
#pragma unroll
            for (int mt = 0; mt < 2; ++mt)
#pragma unroll
                for (int nt = 0; nt < 4; ++nt) acc[mt][nt] = MFMA32(af[mt], bfr[nt], acc[mt][nt]);
        }
        bf16* st = F.states + ((size_t)(c * 16 + h) * 64) * 128;
#pragma unroll
        for (int mt = 0; mt < 2; ++mt)
#pragma unroll
            for (int nt = 0; nt < 4; ++nt)
#pragma unroll
                for (int i = 0; i < 16; ++i) st[(32 * mt + crow16(i, hf)) * 128 + 32 * nt + r] = f2bf(acc[mt][nt][i]);
        LDS_WAIT();
    }
}
DI void p4_scan(Frame& F) {
    const unsigned* st2 = (const unsigned*)F.states; unsigned* pv2 = (unsigned*)F.prev;
    for (int e = F.bid * 512 + F.tid; e < 65536; e += F.nwg * 512) {
        const int h = e >> 12; float c0v = 0.f, c1v = 0.f;
        for (int c0 = 0; c0 < 128; c0 += 16) {
            unsigned s[16]; float dc[16];
#pragma unroll
            for (int i = 0; i < 16; ++i) { s[i] = st2[(size_t)(c0 + i) * 65536 + e]; dc[i] = F.decay[(c0 + i) * 16 + h]; }
#pragma unroll
            for (int i = 0; i < 16; ++i) { c0v = c0v * dc[i] + bf_lo(s[i]); c1v = c1v * dc[i] + bf_hi(s[i]); pv2[(size_t)(c0 + i) * 65536 + e] = pk2(c0v, c1v); }
        }
    }
}
DI bf16x8 pack8(const f32x16& x, int s) {
    v4u p; p.x = pk2(x[8 * s], x[8 * s + 1]); p.y = pk2(x[8 * s + 2], x[8 * s + 3]); p.z = pk2(x[8 * s + 4], x[8 * s + 5]); p.w = pk2(x[8 * s + 6], x[8 * s + 7]);
    return __builtin_bit_cast(bf16x8, p);
}
DI void p5_out(Frame& F) {
    const int lane = F.lane, r = lane & 31, hf = lane >> 5;
    LAS float* acs_s = (LAS float*)(F.lds + F.wave * 512);
    LAS float* dt_s = acs_s + 64;
    LAS float* red = (LAS float*)(F.lds + 8192);
    for (int u = F.bid; u < 256; u += F.nwg) {
        const int c = 1 + (u >> 1), g = u & 1, h = 8 * g + F.wave;
        const float A = -__expf(F.a_log[h]), Dh = F.d_skip[h];
        const float dtl = F.dtv[(size_t)(64 * c + lane) * 16 + h];
        const float acs = wave_incl_scan(dtl * A, lane);
        acs_s[lane] = acs; dt_s[lane] = dtl;
        float acs_l[2]; acs_l[0] = __shfl(acs, r); acs_l[1] = __shfl(acs, 32 + r);
        LDS_WAIT();
        f32x16 yT[2][2], sT[3];
#pragma unroll
        for (int i = 0; i < 16; ++i) { yT[0][0][i] = 0.f; yT[0][1][i] = 0.f; yT[1][0][i] = 0.f; yT[1][1][i] = 0.f; sT[0][i] = 0.f; sT[1][i] = 0.f; sT[2][i] = 0.f; }
        const bf16* prevp = F.prev + ((size_t)(c - 1) * 16 + h) * 8192;
#pragma unroll 2
        for (int ks = 0; ks < 8; ++ks) {
            bf16x8 cf[2], pf[2], bg[2];
#pragma unroll
            for (int t = 0; t < 2; ++t) {
                cf[t] = *(const bf16x8*)(F.Cc + (size_t)(64 * c + 32 * t + r) * 256 + g * 128 + 16 * ks + 8 * hf);
                bg[t] = *(const bf16x8*)(F.Bc + (size_t)(64 * c + 32 * t + r) * 256 + g * 128 + 16 * ks + 8 * hf);
                pf[t] = *(const bf16x8*)(prevp + (32 * t + r) * 128 + 16 * ks + 8 * hf);
            }
            yT[0][0] = MFMA32(pf[0], cf[0], yT[0][0]); yT[0][1] = MFMA32(pf[0], cf[1], yT[0][1]);
            yT[1][0] = MFMA32(pf[1], cf[0], yT[1][0]); yT[1][1] = MFMA32(pf[1], cf[1], yT[1][1]);
            sT[0] = MFMA32(bg[0], cf[0], sT[0]); sT[1] = MFMA32(bg[0], cf[1], sT[1]); sT[2] = MFMA32(bg[1], cf[1], sT[2]);
        }
        { const float e0 = __expf(acs_l[0]), e1 = __expf(acs_l[1]);
#pragma unroll
          for (int i = 0; i < 16; ++i) { yT[0][0][i] *= e0; yT[1][0][i] *= e0; yT[0][1][i] *= e1; yT[1][1][i] *= e1; } }
#pragma unroll
        for (int t = 0; t < 3; ++t) {
            const int st = (t == 2) ? 1 : 0, lt = (t == 0) ? 0 : 1;
            const int l = 32 * lt + r;
#pragma unroll
            for (int q = 0; q < 4; ++q) {
                const f32x4 a4 = *(const LAS f32x4*)(acs_s + 32 * st + 8 * q + 4 * hf), d4 = *(const LAS f32x4*)(dt_s + 32 * st + 8 * q + 4 * hf);
#pragma unroll
                for (int e = 0; e < 4; ++e) { const int s = 32 * st + 8 * q + 4 * hf + e;
                    float val = sT[t][4 * q + e] * __expf(acs_l[lt] - a4[e]) * d4[e];
                    val = (s <= l) ? val : 0.f; val = (s == l) ? val + Dh : val;
                    sT[t][4 * q + e] = val; }
            }
        }
#pragma unroll
        for (int st = 0; st < 2; ++st)
#pragma unroll
            for (int sp = 0; sp < 2; ++sp) {
                bf16x8 xa[2];
#pragma unroll
                for (int pt = 0; pt < 2; ++pt) { const bf16* xp = F.xT + (size_t)(h * 64 + 32 * pt + r) * NP + 64 * c + 32 * st + 16 * sp + 4 * hf;
                    const v2u lo = *(const v2u*)xp, hi = *(const v2u*)(xp + 8); v4u w; w.x = lo.x; w.y = lo.y; w.z = hi.x; w.w = hi.y; xa[pt] = __builtin_bit_cast(bf16x8, w); }
                if (st == 0) { const bf16x8 m0 = pack8(sT[0], sp), m1 = pack8(sT[1], sp);
                    yT[0][0] = MFMA32(xa[0], m0, yT[0][0]); yT[1][0] = MFMA32(xa[1], m0, yT[1][0]);
                    yT[0][1] = MFMA32(xa[0], m1, yT[0][1]); yT[1][1] = MFMA32(xa[1], m1, yT[1][1]);
                } else { const bf16x8 m2 = pack8(sT[2], sp);
                    yT[0][1] = MFMA32(xa[0], m2, yT[0][1]); yT[1][1] = MFMA32(xa[1], m2, yT[1][1]); }
            }
        float ss[2] = {0.f, 0.f};
#pragma unroll
        for (int pt = 0; pt < 2; ++pt)
#pragma unroll
            for (int lt = 0; lt < 2; ++lt) {
                const bf16* zp = F.proj + (size_t)(64 * c + 32 * lt + r) * NPROJ + C_Z + h * 64 + 32 * pt + 4 * hf;
#pragma unroll
                for (int q = 0; q < 4; ++q) { const v2u zw = *(const v2u*)(zp + 8 * q);
                    const float z0 = bf_lo(zw.x), z1 = bf_hi(zw.x), z2 = bf_lo(zw.y), z3 = bf_hi(zw.y);
                    float y0 = yT[pt][lt][4 * q] * silu_f(z0), y1 = yT[pt][lt][4 * q + 1] * silu_f(z1), y2 = yT[pt][lt][4 * q + 2] * silu_f(z2), y3 = yT[pt][lt][4 * q + 3] * silu_f(z3);
                    yT[pt][lt][4 * q] = y0; yT[pt][lt][4 * q + 1] = y1; yT[pt][lt][4 * q + 2] = y2; yT[pt][lt][4 * q + 3] = y3;
                    ss[lt] += (y0 * y0 + y1 * y1) + (y2 * y2 + y3 * y3); }
            }
        ss[0] += __shfl_xor(ss[0], 32); ss[1] += __shfl_xor(ss[1], 32);
        if (hf == 0) { red[F.wave * 64 + r] = ss[0]; red[F.wave * 64 + 32 + r] = ss[1]; }
        LDS_WAIT(); __syncthreads();
        float rstd[2];
#pragma unroll
        for (int lt = 0; lt < 2; ++lt) { float t = 0.f;
#pragma unroll
            for (int w = 0; w < 8; ++w) t += red[w * 64 + 32 * lt + r];
            rstd[lt] = rsqrtf(t * (1.f / 512.f) + EPS); }
#pragma unroll
        for (int pt = 0; pt < 2; ++pt)
#pragma unroll
            for (int lt = 0; lt < 2; ++lt) {
                bf16* op = F.ycat + (size_t)(64 * (c - 1) + 32 * lt + r) * D + 1024 + h * 64 + 32 * pt + 4 * hf;
                const float* gp = F.ssm_g + h * 64 + 32 * pt + 4 * hf;
#pragma unroll
                for (int q = 0; q < 4; ++q) { const f32x4 gg = *(const f32x4*)(gp + 8 * q); v2u w;
                    w.x = pk2(yT[pt][lt][4 * q] * rstd[lt] * gg.x, yT[pt][lt][4 * q + 1] * rstd[lt] * gg.y);
                    w.y = pk2(yT[pt][lt][4 * q + 2] * rstd[lt] * gg.z, yT[pt][lt][4 * q + 3] * rstd[lt] * gg.w);
                    *(v2u*)(op + 8 * q) = w; }
            }
        __syncthreads();
    }
}

DI void p7_router(Frame& F) {
    LAS float* rs = (LAS float*)F.lds;
    LAS float* part = rs + 64;
    LAS float* lg = part + 8 * 1024;
    LAS int* hist = (LAS int*)(lg + 32 * 33 + 8);
    const int lane = F.lane, wave = F.wave;
    for (int blk = F.bid; blk < 256; blk += F.nwg) {
        const int r0 = 32 * blk;
        {
            const f32x4* gr = (const f32x4*)F.g2 + lane;
            f32x4 v[4][8];
#pragma unroll
            for (int i = 0; i < 4; ++i) { const v2u* xr = (const v2u*)(F.h2 + (size_t)(r0 + 4 * wave + i) * D) + lane;
#pragma unroll
                for (int j = 0; j < 8; ++j) { const v2u w = xr[64 * j]; v[i][j] = (f32x4){bf_lo(w.x), bf_hi(w.x), bf_lo(w.y), bf_hi(w.y)}; } }
            f32x4 g[8];
#pragma unroll
            for (int j = 0; j < 8; ++j) g[j] = gr[64 * j];
#pragma unroll
            for (int i = 0; i < 4; ++i) { const int rr = r0 + 4 * wave + i; float s = 0.f;
#pragma unroll
                for (int j = 0; j < 8; ++j) s += (v[i][j].x * v[i][j].x + v[i][j].y * v[i][j].y) + (v[i][j].z * v[i][j].z + v[i][j].w * v[i][j].w);
                const float rstd = rsqrtf(wave_sum(s) * (1.f / D) + EPS);
                unsigned long long* o8 = (unsigned long long*)(F.hn2 + (size_t)rr * D) + lane;
                unsigned* o4 = (unsigned*)((unsigned char*)F.hn2 + (size_t)rr * D) + lane;
#pragma unroll
                for (int j = 0; j < 8; ++j) {
                    if (MOE_F8) { const float q = rstd * X8_SCALE; o4[64 * j] = pk4_f8(v[i][j].x * q * g[j].x, v[i][j].y * q * g[j].y, v[i][j].z * q * g[j].z, v[i][j].w * q * g[j].w); }
                    else o8[64 * j] = (unsigned long long)pk2(v[i][j].x * rstd * g[j].x, v[i][j].y * rstd * g[j].y) | ((unsigned long long)pk2(v[i][j].z * rstd * g[j].z, v[i][j].w * rstd * g[j].w) << 32); }
                if (lane == 0) rs[4 * wave + i] = rstd; }
        }
        f32x16 acc;
#pragma unroll
        for (int i = 0; i < 16; ++i) acc[i] = 0.f;
        { const int ri = lane & 31, kh = lane >> 5;
          const bf16* arow = F.h2 + (size_t)(r0 + ri) * D + 256 * wave + 4 * kh;
          const float* wp = F.Wr + (size_t)(256 * wave + 4 * kh) * 32 + ri;
#pragma unroll 8
          for (int jj = 0; jj < 32; ++jj) {
              const v2u aw = *(const v2u*)(arow + 8 * jj); const f32x4 a = {bf_lo(aw.x), bf_hi(aw.x), bf_lo(aw.y), bf_hi(aw.y)};
              const float b0 = wp[(8 * jj) * 32], b1 = wp[(8 * jj + 1) * 32], b2 = wp[(8 * jj + 2) * 32], b3 = wp[(8 * jj + 3) * 32];
              acc = __builtin_amdgcn_mfma_f32_32x32x2f32(a.x, b0, acc, 0, 0, 0);
              acc = __builtin_amdgcn_mfma_f32_32x32x2f32(a.y, b1, acc, 0, 0, 0);
              acc = __builtin_amdgcn_mfma_f32_32x32x2f32(a.z, b2, acc, 0, 0, 0);
              acc = __builtin_amdgcn_mfma_f32_32x32x2f32(a.w, b3, acc, 0, 0, 0);
          }
#pragma unroll
          for (int i = 0; i < 16; ++i) part[wave * 1024 + crow16(i, kh) * 32 + ri] = acc[i];
        }
        if (F.tid < 32) hist[F.tid] = 0;
        LDS_WAIT(); __syncthreads();
        for (int idx = F.tid; idx < 1024; idx += 512) { float s = 0.f;
#pragma unroll
            for (int w = 0; w < 8; ++w) s += part[w * 1024 + idx];
            lg[(idx >> 5) * 33 + (idx & 31)] = s * rs[idx >> 5] + F.router_b[idx & 31]; }
        LDS_WAIT(); __syncthreads();
        if (F.tid < 32) {
            const int i = F.tid; float tv[4]; int te[4];
#pragma unroll
            for (int k = 0; k < 4; ++k) { float best = -3.0e38f; int be = 0;
                for (int e = 0; e < 32; ++e) { const float x = lg[i * 33 + e]; if (x > best) { best = x; be = e; } }
                tv[k] = best; te[k] = be; lg[i * 33 + be] = -3.4e38f; }
            const float e1 = __expf(tv[1] - tv[0]), e2 = __expf(tv[2] - tv[0]), e3 = __expf(tv[3] - tv[0]);
            const float inv = 1.f / (1.f + e1 + e2 + e3);
            *(f32x4*)(F.tkg + (size_t)(r0 + i) * 4) = (f32x4){inv, e1 * inv, e2 * inv, e3 * inv};
            int* tk = F.tke + (size_t)(r0 + i) * 4; tk[0] = te[0]; tk[1] = te[1]; tk[2] = te[2]; tk[3] = te[3];
#pragma unroll
            for (int k = 0; k < 4; ++k) __hip_atomic_fetch_add(hist + te[k], 1, __ATOMIC_RELAXED, __HIP_MEMORY_SCOPE_WORKGROUP);
        }
        LDS_WAIT(); __syncthreads();
        if (F.tid < 32) F.cnt[blk * 32 + F.tid] = hist[F.tid];
        __syncthreads();
    }
}
DI void p8_route(Frame& F) {
    LAS int* tot = (LAS int*)F.lds; LAS int* pre = tot + 32; LAS int* base = tot + 64; LAS int* posl = tot + 128; LAS int* tkl = tot + 256; LAS int* ptot = tot + 512; LAS int* ppre = ptot + 512;
    for (int blk = F.bid; blk < 256; blk += F.nwg) {
        const int r0 = 32 * blk;
        { const int e = F.tid & 31, wq = F.tid >> 5; int t = 0, p = 0;
#pragma unroll
          for (int i = 0; i < 16; ++i) { const int w = wq + 16 * i; const int v = F.cnt[w * 32 + e]; p += (w < blk) ? v : 0; t += v; }
          ptot[wq * 32 + e] = t; ppre[wq * 32 + e] = p; }
        if (F.tid < 128) tkl[F.tid] = F.tke[(size_t)r0 * 4 + F.tid];
        LDS_WAIT(); __syncthreads();
        if (F.tid < 32) { int t = 0, p = 0;
#pragma unroll
            for (int i = 0; i < 16; ++i) { t += ptot[i * 32 + F.tid]; p += ppre[i * 32 + F.tid]; }
            tot[F.tid] = t; pre[F.tid] = p; }
        LDS_WAIT(); __syncthreads();
        if (F.tid < 32) { int accp = 0; for (int e = 0; e < F.tid; ++e) accp += ((tot[e] + 255) >> 8) << 8; base[F.tid] = accp; }
        if (blk == 0 && F.tid == 64) { int nt = 0;
            for (int e = 0; e < 32; ++e) { const int tiles = (tot[e] + 255) >> 8; for (int j = 0; j < tiles; ++j) F.tile[nt + j] = e; nt += tiles; }
            F.tile[255] = nt; }
        LDS_WAIT(); __syncthreads();
        if (F.tid < 128) { const int e = tkl[F.tid]; int q = 0; for (int j = 0; j < F.tid; ++j) q += (tkl[j] == e) ? 1 : 0;
            const int p = base[e] + pre[e] + q; posl[F.tid] = p; F.pos[(size_t)r0 * 4 + F.tid] = p; }
        LDS_WAIT(); __syncthreads();
        if (F.tid < 128) ((int*)F.xs)[posl[F.tid]] = r0 + (F.tid >> 2);
        if (blk == 0 && F.tid < 32) { const int e = F.tid, lo_ = base[e] + tot[e], hi_ = base[e] + (((tot[e] + 255) >> 8) << 8); for (int q = lo_; q < hi_; ++q) ((int*)F.xs)[q] = 0; }
        __syncthreads();
    }
}
DI void p11_final(Frame& F) {
    const int lane = F.lane;
    for (int rr = F.gw; rr < SEQ; rr += F.ngw) {
        const int* pp = F.pos + (size_t)rr * 4; const f32x4 gt = *(const f32x4*)(F.tkg + (size_t)rr * 4);
        const float gk[4] = {gt.x, gt.y, gt.z, gt.w};
        const v2u* xr = (const v2u*)(F.h2 + (size_t)rr * D) + lane;
        f32x4 v[8];
#pragma unroll
        for (int j = 0; j < 8; ++j) { const v2u w = xr[64 * j]; v[j] = (f32x4){bf_lo(w.x), bf_hi(w.x), bf_lo(w.y), bf_hi(w.y)}; }
#pragma unroll
        for (int k = 0; k < 4; ++k) { const int* orow = (const int*)((const unsigned char*)F.obuf + (size_t)pp[k] * D) + lane; const float gq = gk[k] * (1.f / O8_SCALE);
#pragma unroll
            for (int j = 0; j < 8; ++j) { const int w = orow[64 * j];
                v[j].x += gq * __builtin_amdgcn_cvt_f32_fp8(w, 0); v[j].y += gq * __builtin_amdgcn_cvt_f32_fp8(w, 1); v[j].z += gq * __builtin_amdgcn_cvt_f32_fp8(w, 2); v[j].w += gq * __builtin_amdgcn_cvt_f32_fp8(w, 3); } }
        float s = 0.f;
#pragma unroll
        for (int j = 0; j < 8; ++j) s += (v[j].x * v[j].x + v[j].y * v[j].y) + (v[j].z * v[j].z + v[j].w * v[j].w);
        const float rstd = rsqrtf(wave_sum(s) * (1.f / D) + EPS);
        const f32x4* gr = (const f32x4*)F.final_g + lane; f32x4* op = (f32x4*)(F.out + (size_t)rr * D) + lane;
#pragma unroll
        for (int j = 0; j < 8; ++j) { const f32x4 g = gr[64 * j]; op[64 * j] = (f32x4){v[j].x * rstd * g.x, v[j].y * rstd * g.y, v[j].z * rstd * g.z, v[j].w * rstd * g.w}; }
    }
}

using pg8::Unit; using pg8::HALF; using pg8::BM;
struct EpiProj {
    static constexpr bool PERM = true, AFTER_DRAIN = false;
    bf16* O;
    DI void operator()(const f32x4 (&acc)[2][2][4][2], const Unit& u, int wr, int wc, int fr, int fq) const {
        const int row0 = u.pm * BM + wr * 64 + fr, col0 = u.pn * BM + wc * 32 + 8 * fq;
#pragma unroll
        for (int ai = 0; ai < 2; ++ai)
#pragma unroll
            for (int m = 0; m < 4; ++m) { bf16* rowp = O + (size_t)(row0 + ai * HALF + m * 16) * NPROJ + col0;
#pragma unroll
                for (int bj = 0; bj < 2; ++bj) { const f32x4 v0 = acc[ai][bj][m][0], v1 = acc[ai][bj][m][1];
                    v4u w; w.x = pk2(v0[0], v0[1]); w.y = pk2(v0[2], v0[3]); w.z = pk2(v1[0], v1[1]); w.w = pk2(v1[2], v1[3]);
                    *(v4u*)(rowp + bj * HALF) = w; } }
    }
};
struct EpiH2 {
    static constexpr bool PERM = true, AFTER_DRAIN = false;
    const float* X; bf16* H;
    DI void operator()(const f32x4 (&acc)[2][2][4][2], const Unit& u, int wr, int wc, int fr, int fq) const {
        const int row0 = u.pm * BM + wr * 64 + fr, col0 = u.pn * BM + wc * 32 + 8 * fq;
#pragma unroll
        for (int ai = 0; ai < 2; ++ai)
#pragma unroll
            for (int m = 0; m < 4; ++m) { const size_t off = (size_t)(row0 + ai * HALF + m * 16) * D + col0;
#pragma unroll
                for (int bj = 0; bj < 2; ++bj) { const f32x4 x0 = *(const f32x4*)(X + off + bj * HALF), x1 = *(const f32x4*)(X + off + bj * HALF + 4);
                    const f32x4 v0 = acc[ai][bj][m][0] + x0, v1 = acc[ai][bj][m][1] + x1;
                    v4u w; w.x = pk2(v0[0], v0[1]); w.y = pk2(v0[2], v0[3]); w.z = pk2(v1[0], v1[1]); w.w = pk2(v1[2], v1[3]);
                    *(v4u*)(H + off + bj * HALF) = w; } }
    }
};
DI float swiglu(float g, float u) {
    g = fminf(g, 7.f); u = fminf(fmaxf(u, -7.f), 7.f);
    return (u + 1.f) * g * __builtin_amdgcn_rcpf(1.f + __expf(-1.702f * g));
}
DI f32x4 swiglu4(f32x4 g, f32x4 u, const float S) {
#pragma unroll
    for (int i = 0; i < 4; ++i) { g[i] = fminf(g[i], 7.f); u[i] = fminf(fmaxf(u[i], -7.f), 7.f); }
    const f32x4 t = g * (-1.702f * 1.4426950408889634f);
    f32x4 d;
#pragma unroll
    for (int i = 0; i < 4; ++i) d[i] = __builtin_amdgcn_exp2f(t[i]);
    d = d + 1.f;
#pragma unroll
    for (int i = 0; i < 4; ++i) d[i] = __builtin_amdgcn_rcpf(d[i]);
    return (u * S + S) * g * d;
}
struct EpiGU {
    static constexpr bool PERM = true, AFTER_DRAIN = false;
    bf16* O; const float* bgate; const float* bup;
    DI void operator()(const f32x4 (&acc)[2][2][4][2], const Unit& u, int wr, int wc, int fr, int fq) const {
        const int e = u.pn >> 4, pnl = u.pn & 15;
        const int row0 = u.pm * BM + wr * 64 + fr, colb = 128 * pnl + wc * 32 + 8 * fq;
        f32x4 bg[2], bu[2];
#pragma unroll
        for (int n = 0; n < 2; ++n) { bg[n] = *(const f32x4*)(bgate + e * D + colb + 4 * n); bu[n] = *(const f32x4*)(bup + e * D + colb + 4 * n); }
#pragma unroll
        for (int ai = 0; ai < 2; ++ai)
#pragma unroll
            for (int m = 0; m < 4; ++m) { bf16* rowp = O + (size_t)(row0 + ai * HALF + m * 16) * D + colb;
                const f32x4 g0 = acc[ai][0][m][0] + bg[0], g1 = acc[ai][0][m][1] + bg[1], u0 = acc[ai][1][m][0] + bu[0], u1 = acc[ai][1][m][1] + bu[1];
                v4u w; w.x = pk2(swiglu(g0[0], u0[0]), swiglu(g0[1], u0[1])); w.y = pk2(swiglu(g0[2], u0[2]), swiglu(g0[3], u0[3]));
                w.z = pk2(swiglu(g1[0], u1[0]), swiglu(g1[1], u1[1])); w.w = pk2(swiglu(g1[2], u1[2]), swiglu(g1[3], u1[3]));
                *(v4u*)rowp = w; }
    }
};
struct EpiDown {
    static constexpr bool PERM = true, AFTER_DRAIN = false;
    bf16* O; const float* bias;
    DI void operator()(const f32x4 (&acc)[2][2][4][2], const Unit& u, int wr, int wc, int fr, int fq) const {
        const int e = u.pn >> 3, pnl = u.pn & 7;
        const int row0 = u.pm * BM + wr * 64 + fr, col0 = 256 * pnl + wc * 32 + 8 * fq;
        f32x4 bv[2][2];
#pragma unroll
        for (int bj = 0; bj < 2; ++bj)
#pragma unroll
            for (int n = 0; n < 2; ++n) bv[bj][n] = *(const f32x4*)(bias + e * D + col0 + bj * HALF + 4 * n);
#pragma unroll
        for (int ai = 0; ai < 2; ++ai)
#pragma unroll
            for (int m = 0; m < 4; ++m) { bf16* rowp = O + (size_t)(row0 + ai * HALF + m * 16) * D + col0;
#pragma unroll
                for (int bj = 0; bj < 2; ++bj) { const f32x4 v0 = acc[ai][bj][m][0] + bv[bj][0], v1 = acc[ai][bj][m][1] + bv[bj][1];
                    v4u w; w.x = pk2(v0[0], v0[1]); w.y = pk2(v0[2], v0[3]); w.z = pk2(v1[0], v1[1]); w.w = pk2(v1[2], v1[3]);
                    *(v4u*)(rowp + bj * HALF) = w; } }
    }
};
struct EpiGU8 {
    static constexpr bool PERM = true, AFTER_DRAIN = false;
    unsigned char* O; const float* bgate; const float* bup;
    DI void operator()(const f32x4 (&acc)[2][2][4][2], const Unit& u, int wr, int wc, int fr, int fq) const {
        const int e = u.pn >> 4, pnl = u.pn & 15;
        const int row0 = u.pm * BM + wr * 64 + fr, colb = 128 * pnl + wc * 32 + 8 * fq;
        constexpr float DQ = 1.f / (W8_SCALE * X8_SCALE);
        f32x4 bg[2], bu[2];
#pragma unroll
        for (int n = 0; n < 2; ++n) { bg[n] = *(const f32x4*)(bgate + e * D + colb + 4 * n); bu[n] = *(const f32x4*)(bup + e * D + colb + 4 * n); }
#pragma unroll
        for (int ai = 0; ai < 2; ++ai)
#pragma unroll
            for (int m = 0; m < 4; ++m) { unsigned char* rowp = O + (size_t)(row0 + ai * HALF + m * 16) * D + colb;
                const f32x4 g0 = acc[ai][0][m][0] * DQ + bg[0], g1 = acc[ai][0][m][1] * DQ + bg[1], u0 = acc[ai][1][m][0] * DQ + bu[0], u1 = acc[ai][1][m][1] * DQ + bu[1];
                const f32x4 a0 = swiglu4(g0, u0, A8_SCALE), a1 = swiglu4(g1, u1, A8_SCALE);
                v2u w; w.x = pk4_f8(a0[0], a0[1], a0[2], a0[3]); w.y = pk4_f8(a1[0], a1[1], a1[2], a1[3]);
                *(v2u*)rowp = w; }
    }
};
struct EpiDown8 {
    static constexpr bool PERM = true, AFTER_DRAIN = false;
    unsigned char* O; const float* bias;
    DI void operator()(const f32x4 (&acc)[2][2][4][2], const Unit& u, int wr, int wc, int fr, int fq) const {
        const int e = u.pn >> 3, pnl = u.pn & 7;
        const int row0 = u.pm * BM + wr * 64 + fr, col0 = 256 * pnl + wc * 32 + 8 * fq;
        constexpr float DQ = O8_SCALE / (W8_SCALE * A8_SCALE);
        f32x4 bv[2][2];
#pragma unroll
        for (int bj = 0; bj < 2; ++bj)
#pragma unroll
            for (int n = 0; n < 2; ++n) bv[bj][n] = *(const f32x4*)(bias + e * D + col0 + bj * HALF + 4 * n) * O8_SCALE;
#pragma unroll
        for (int ai = 0; ai < 2; ++ai)
#pragma unroll
            for (int m = 0; m < 4; ++m) { unsigned char* rowp = O + (size_t)(row0 + ai * HALF + m * 16) * D + col0;
#pragma unroll
                for (int bj = 0; bj < 2; ++bj) { const f32x4 v0 = acc[ai][bj][m][0] * DQ + bv[bj][0], v1 = acc[ai][bj][m][1] * DQ + bv[bj][1];
                    v2u w; w.x = pk4_f8(v0[0], v0[1], v0[2], v0[3]); w.y = pk4_f8(v1[0], v1[1], v1[2], v1[3]);
                    *(v2u*)(rowp + bj * HALF) = w; } }
    }
};
struct MoeOrder {
    const LAS int* tile_e; const int* rowtok = nullptr;
    int nM, nN, nwg, G, c;
    DI void init(const LAS int* te, int ntiles, int nN_, int G_, int c_) { tile_e = te; nM = ntiles; nN = nN_; nwg = nM * nN; G = G_; c = c_; }
    DI bool next(int i, Unit& u) const {
        const int L = i * G + c; if (L >= nwg) return false;
        int wgid = L; { const int q = nwg / pg8::NXCD, r = nwg % pg8::NXCD, xcd = wgid % pg8::NXCD, off = wgid / pg8::NXCD; wgid = (xcd < r ? xcd * (q + 1) : r * (q + 1) + (xcd - r) * q) + off; }
        const int nig = pg8::WGM * nN, gid = wgid / nig, fm = gid * pg8::WGM, gsz = (nM - fm) < pg8::WGM ? (nM - fm) : pg8::WGM;
        u.pm = fm + ((wgid % nig) % gsz); const int pnl = (wgid % nig) / gsz;
        u.pn = __builtin_amdgcn_readfirstlane(tile_e[u.pm]) * nN + pnl; return true;
    }
    DI void a_ready(const Unit&) const {}
    DI void done(const Unit&) const {}
};


#if MOE_RB
#define MFMA16(a, b, c) __builtin_amdgcn_mfma_f32_16x16x32_bf16((a), (b), (c), 0, 0, 0)
template <class Epi, class Sched>
DI void gemm_rb(LAS unsigned char* lds, const bf16* A, const Sched& S, const Epi& E) {
    constexpr int K = D, NT = K / 64;
    const int tid = threadIdx.x, wave = __builtin_amdgcn_readfirstlane(tid >> 6), lane = tid & 63, fr = lane & 15, fq = lane >> 4;
    unsigned voffA[2];
#pragma unroll
    for (int i = 0; i < 2; ++i) { int R, C; pg8::stage_rc(tid * 16 + i * 8192, R, C); voffA[i] = (unsigned)(R * K + C) * 2u; }
    const unsigned ldsw = (unsigned)wave * 1024u;
    const int aoff = pg8::lds_byte(fr, fq * 8);
    const unsigned boff = (unsigned)((8 * fq) * K + fr) * 4u;
    Unit u;
    for (int ui = 0; S.next(ui, u); ++ui) {
        const char* cA = (const char*)A + (size_t)u.pm * 256 * K * 2;
        const float *b0, *b1; E.bsrc(u, wave, b0, b1);
        const char* pb0 = (const char*)b0 + boff; const char* pb1 = (const char*)b1 + boff;
        f32x4 acc[16][2];
#pragma unroll
        for (int m = 0; m < 16; ++m) { acc[m][0] = (f32x4){0.f, 0.f, 0.f, 0.f}; acc[m][1] = (f32x4){0.f, 0.f, 0.f, 0.f}; }
        float rb[4][16];
#define RB_DMA(t) do { const int tt_ = (t) < NT ? (t) : NT - 1; const unsigned bo_ = (unsigned)(((t) % 3) * 32768); \
        _Pragma("unroll") for (int h_ = 0; h_ < 2; ++h_) _Pragma("unroll") for (int i_ = 0; i_ < 2; ++i_) \
            __builtin_amdgcn_global_load_lds((const unsigned*)(cA + (size_t)h_ * 128 * K * 2 + (size_t)tt_ * 128 + voffA[i_]), (LAS unsigned*)(lds + bo_ + h_ * 16384 + ldsw + i_ * 8192), 16, 0, 0); } while (0)
#define RB_ISSUE(slot, hs) do { const int he_ = (hs) < 2 * NT ? (hs) : 2 * NT - 1; const char* s0_ = pb0 + (size_t)he_ * 32 * K * 4; const char* s1_ = pb1 + (size_t)he_ * 32 * K * 4; \
        _Pragma("unroll") for (int j_ = 0; j_ < 8; ++j_) { \
            asm volatile("global_load_dword %0, %1, off" : "=v"(rb[slot][j_]) : "v"(s0_ + (size_t)j_ * K * 4) : "memory"); \
            asm volatile("global_load_dword %0, %1, off" : "=v"(rb[slot][8 + j_]) : "v"(s1_ + (size_t)j_ * K * 4) : "memory"); } } while (0)
#define RB_WAITB(slot) asm volatile("s_waitcnt vmcnt(52)" : "+v"(rb[slot][0]), "+v"(rb[slot][1]), "+v"(rb[slot][2]), "+v"(rb[slot][3]), "+v"(rb[slot][4]), "+v"(rb[slot][5]), "+v"(rb[slot][6]), "+v"(rb[slot][7]), \
        "+v"(rb[slot][8]), "+v"(rb[slot][9]), "+v"(rb[slot][10]), "+v"(rb[slot][11]), "+v"(rb[slot][12]), "+v"(rb[slot][13]), "+v"(rb[slot][14]), "+v"(rb[slot][15]) :: "memory")
#define RB_COMPUTE(bufo, ks, slot) do { v4u p0_, p1_; \
        p0_.x = pk2(rb[slot][0], rb[slot][1]); p0_.y = pk2(rb[slot][2], rb[slot][3]); p0_.z = pk2(rb[slot][4], rb[slot][5]); p0_.w = pk2(rb[slot][6], rb[slot][7]); \
        p1_.x = pk2(rb[slot][8], rb[slot][9]); p1_.y = pk2(rb[slot][10], rb[slot][11]); p1_.z = pk2(rb[slot][12], rb[slot][13]); p1_.w = pk2(rb[slot][14], rb[slot][15]); \
        const bf16x8 bf0_ = __builtin_bit_cast(bf16x8, p0_), bf1_ = __builtin_bit_cast(bf16x8, p1_); \
        _Pragma("unroll") for (int mg_ = 0; mg_ < 4; ++mg_) { bf16x8 a_[4]; \
            _Pragma("unroll") for (int q_ = 0; q_ < 4; ++q_) { const int m_ = 4 * mg_ + q_; a_[q_] = *(const LAS bf16x8*)(lds + (bufo) + (m_ >> 3) * 16384 + (m_ & 7) * 2048 + (ks) * 1024 + aoff); } \
            _Pragma("unroll") for (int q_ = 0; q_ < 4; ++q_) { const int m_ = 4 * mg_ + q_; acc[m_][0] = MFMA16(bf0_, a_[q_], acc[m_][0]); acc[m_][1] = MFMA16(bf1_, a_[q_], acc[m_][1]); } \
            __builtin_amdgcn_sched_barrier(0); } } while (0)
        RB_DMA(0); RB_DMA(1);
        RB_ISSUE(0, 0); RB_ISSUE(1, 1); RB_ISSUE(2, 2);
        int bi = 0;
#pragma unroll 1
        for (int t = 0; t < NT; t += 2) {
            const int bo0 = bi * 32768, bi1 = (bi == 2) ? 0 : bi + 1, bo1 = bi1 * 32768;
            asm volatile("s_waitcnt vmcnt(36)" ::: "memory"); __builtin_amdgcn_s_barrier(); asm volatile("" ::: "memory");
            RB_DMA(t + 2);
            RB_ISSUE(3, 2 * t + 3); RB_WAITB(0); RB_COMPUTE(bo0, 0, 0);
            RB_ISSUE(0, 2 * t + 4); RB_WAITB(1); RB_COMPUTE(bo0, 1, 1);
            asm volatile("s_waitcnt vmcnt(36)" ::: "memory"); __builtin_amdgcn_s_barrier(); asm volatile("" ::: "memory");
            RB_DMA(t + 3);
            RB_ISSUE(1, 2 * t + 5); RB_WAITB(2); RB_COMPUTE(bo1, 0, 2);
            RB_ISSUE(2, 2 * t + 6); RB_WAITB(3); RB_COMPUTE(bo1, 1, 3);
            bi = (bi1 == 2) ? 0 : bi1 + 1;
        }
#define RB_KEEP(slot, str) asm volatile(str : "+v"(rb[slot][0]), "+v"(rb[slot][1]), "+v"(rb[slot][2]), "+v"(rb[slot][3]), "+v"(rb[slot][4]), "+v"(rb[slot][5]), "+v"(rb[slot][6]), "+v"(rb[slot][7]), \
        "+v"(rb[slot][8]), "+v"(rb[slot][9]), "+v"(rb[slot][10]), "+v"(rb[slot][11]), "+v"(rb[slot][12]), "+v"(rb[slot][13]), "+v"(rb[slot][14]), "+v"(rb[slot][15]) :: "memory")
        RB_KEEP(0, "s_waitcnt vmcnt(0)"); RB_KEEP(1, ""); RB_KEEP(2, ""); RB_KEEP(3, "");
#undef RB_KEEP
        E(acc, u, wave, fr, fq);
        asm volatile("s_waitcnt vmcnt(0)" ::: "memory"); __builtin_amdgcn_s_barrier(); asm volatile("" ::: "memory");
#undef RB_DMA
#undef RB_ISSUE
#undef RB_WAITB
#undef RB_COMPUTE
    }
}
struct EpiGU2 {
    bf16* O; const float *wg, *wu, *bgate, *bup;
    DI void bsrc(const Unit& u, int wave, const float*& b0, const float*& b1) const {
        const int e = u.pn >> 4, pnl = u.pn & 15; const size_t o = (size_t)e * D * D + 128 * pnl + 16 * wave; b0 = wg + o; b1 = wu + o; }
    DI void operator()(const f32x4 (&acc)[16][2], const Unit& u, int wave, int fr, int fq) const {
        const int e = u.pn >> 4, pnl = u.pn & 15, col = 128 * pnl + 16 * wave + 4 * fq;
        const f32x4 bg = *(const f32x4*)(bgate + e * D + col), bu = *(const f32x4*)(bup + e * D + col);
        bf16* op = O + (size_t)(u.pm * 256 + fr) * D + col;
#pragma unroll
        for (int m = 0; m < 16; ++m) { const f32x4 g = acc[m][0] + bg, uu = acc[m][1] + bu; v2u w;
            w.x = pk2(swiglu(g[0], uu[0]), swiglu(g[1], uu[1])); w.y = pk2(swiglu(g[2], uu[2]), swiglu(g[3], uu[3]));
            *(v2u*)(op + (size_t)(16 * m) * D) = w; }
    }
};
struct EpiDown2 {
    bf16* O; const float *wd, *bias;
    DI void bsrc(const Unit& u, int wave, const float*& b0, const float*& b1) const {
        const int e = u.pn >> 3, pnl = u.pn & 7; b0 = wd + (size_t)e * D * D + 256 * pnl + 32 * wave; b1 = b0 + 16; }
    DI void operator()(const f32x4 (&acc)[16][2], const Unit& u, int wave, int fr, int fq) const {
        const int e = u.pn >> 3, pnl = u.pn & 7, col = 256 * pnl + 32 * wave + 4 * fq;
        const f32x4 v0 = *(const f32x4*)(bias + e * D + col), v1 = *(const f32x4*)(bias + e * D + col + 16);
        bf16* op = O + (size_t)(u.pm * 256 + fr) * D + col;
#pragma unroll
        for (int m = 0; m < 16; ++m) { const f32x4 a = acc[m][0] + v0, b = acc[m][1] + v1; v2u w0, w1;
            w0.x = pk2(a[0], a[1]); w0.y = pk2(a[2], a[3]); w1.x = pk2(b[0], b[1]); w1.y = pk2(b[2], b[3]);
            *(v2u*)(op + (size_t)(16 * m) * D) = w0; *(v2u*)(op + (size_t)(16 * m) * D + 16) = w1; }
    }
};

#endif
struct Args { const float* in[23]; float* out; unsigned char* ws; int ph_lo, ph_hi; };
DI void fill_frame(Frame& F, const Args& args, LAS unsigned char* lds, const int bid, const int nwg) {
    F.lds = lds;
    int tz = threadIdx.x; asm volatile("" : "+v"(tz)); F.tid = tz;
    F.lane = F.tid & 63; F.wave = __builtin_amdgcn_readfirstlane(F.tid >> 6);
    F.bid = bid; F.nwg = nwg; F.gw = bid * NWAVES + F.wave; F.ngw = nwg * NWAVES;
    unsigned char* ws = args.ws;
    F.x = args.in[0]; F.meta = args.in[1]; F.g1 = args.in[2]; F.w_in = args.in[3]; F.pool_w = args.in[4]; F.pool_scale = args.in[5]; F.conv_w = args.in[6]; F.conv_b = args.in[7];
    F.dt_bias = args.in[8]; F.a_log = args.in[9]; F.d_skip = args.in[10]; F.ssm_g = args.in[11]; F.w_out = args.in[12]; F.g2 = args.in[13]; F.router_w = args.in[14]; F.router_b = args.in[15];
    F.w_gate = args.in[16]; F.b_gate = args.in[17]; F.w_up = args.in[18]; F.b_up = args.in[19]; F.w_down = args.in[20]; F.b_down = args.in[21]; F.final_g = args.in[22];
    F.out = args.out;
    F.hn = (bf16*)(ws + WS_HN); F.Bt1 = (bf16*)(ws + WS_BT1); F.Bt2 = (bf16*)(ws + WS_BT2); F.proj = (bf16*)(ws + WS_PROJ); F.xT = (bf16*)(ws + WS_XT); F.BT = (bf16*)(ws + WS_BTT);
    F.Bc = (bf16*)(ws + WS_BC); F.Cc = (bf16*)(ws + WS_CC); F.prev = (bf16*)(ws + WS_PREV); F.ycat = (bf16*)(ws + WS_YCAT); F.hn2 = (bf16*)(ws + WS_HN2); F.xs = (bf16*)(ws + WS_XS);
    F.abuf = (bf16*)(ws + WS_A); F.obuf = (bf16*)(ws + (MOE_F8 ? WS_O : WS_XS)); F.Btgu = (bf16*)(ws + WS_BTGU); F.Btd = (bf16*)(ws + WS_BTD);
    F.dtv = (float*)(ws + WS_DT); F.states = (bf16*)(ws + WS_ST); F.decay = (float*)(ws + WS_DEC); F.h2 = (bf16*)(ws + WS_H2); F.Wr = (float*)(ws + WS_WR); F.tkg = (float*)(ws + WS_TKG);
    F.tke = (int*)(ws + WS_TKE); F.pos = (int*)(ws + WS_POS); F.cnt = (int*)(ws + WS_CNT); F.tile = (int*)(ws + WS_TILE);

}
__global__ void __launch_bounds__(NWAVES * 64, 2) fwd(Args args) {
    extern __shared__ __attribute__((aligned(16))) unsigned char lds_raw[];
    LAS unsigned char* const lds_base = (LAS unsigned char*)lds_raw; unsigned char* ws = args.ws;
    volatile LAS unsigned* MISC = (volatile LAS unsigned*)(lds_base + MISC_OFF);
    if (threadIdx.x < 32) MISC[threadIdx.x] = 0u;
    __syncthreads();
    const int G = (int)gridDim.x, bx = (int)blockIdx.x;
    const bool worker = bx < WN;
    XcdBarrier barA = xcd_barrier_post((unsigned*)(ws + WS_CTL) + CW_BAR, MISC + 8, (unsigned)G);
    XcdBarrier barW; barW.bar = (unsigned*)(ws + WS_CTL) + CW_BAR2; barW.x = 0; barW.st = MISC + 12; barW.G = (unsigned)WN;
    if (worker) barW = xcd_barrier_post((unsigned*)(ws + WS_CTL) + CW_BAR2, MISC + 12, (unsigned)WN);

    { Frame F; fill_frame(F, args, lds_base, bx, G); p0_norm(F); p0_weff(F); p0_router_fold(F); p0_weights_range<false>(F, I_MOE, NITEMS); __syncthreads(); }
    xcd_barrier(barA);
    if (!worker) {
        Frame F; fill_frame(F, args, lds_base, bx - WN, G - WN); p0_weights_range<true>(F, 0, I_MOE); __syncthreads();
    } else {
        { Frame F; fill_frame(F, args, lds_base, bx, WN); pg8::Gemm g{F.hn, F.Bt1, MP, NPROJ, D}; pg8::StaticOrder S; S.init(MP, NPROJ, WN, bx);
          EpiProj E{F.proj}; pg8::gemm_phase<EpiProj, pg8::StaticOrder, true, true>(F.lds, g, S, E); }
        xcd_barrier(barW);
        { Frame F; fill_frame(F, args, lds_base, bx, WN); p2_elem(F); }
        xcd_barrier(barW);
        { Frame F; fill_frame(F, args, lds_base, bx, WN); p3_states(F); }
        xcd_barrier(barW);
        { Frame F; fill_frame(F, args, lds_base, bx, WN); p4_scan(F); }
        xcd_barrier(barW);
        { Frame F; fill_frame(F, args, lds_base, bx, WN); p5_out(F); }
        xcd_barrier(barW);
        { Frame F; fill_frame(F, args, lds_base, bx, WN); pg8::Gemm g{F.ycat, F.Bt2, SEQ, D, D}; pg8::StaticOrder S; S.init(SEQ, D, WN, bx);
          EpiH2 E{F.x, F.h2}; pg8::gemm_phase<EpiH2, pg8::StaticOrder, true, true>(F.lds, g, S, E); }
        xcd_barrier(barW);
        { Frame F; fill_frame(F, args, lds_base, bx, WN); p7_router(F); }
        xcd_barrier(barW);
        { Frame F; fill_frame(F, args, lds_base, bx, WN); p8_route(F); }
    }
    xcd_barrier(barA);
    { Frame F; fill_frame(F, args, lds_base, bx, G); LAS int* tl = (LAS int*)(lds_base + MISC_OFF + 1024);
      if (F.tid < 256) tl[F.tid] = F.tile[F.tid];
      LDS_WAIT(); __syncthreads();
      const int ntiles = __builtin_amdgcn_readfirstlane(tl[255]);
      MoeOrder S; S.init(tl, ntiles, 16, G, bx); S.rowtok = (const int*)F.xs;
      pg8::Gemm g{F.hn2, F.Btgu, SEQ, NE * 4096, D}; EpiGU8 E{(unsigned char*)F.abuf, F.b_gate, F.b_up}; pg8::gemm_phase<EpiGU8, MoeOrder, true, true, true, true>(F.lds, g, S, E); }
    xcd_barrier(barA);
    { Frame F; fill_frame(F, args, lds_base, bx, G); LAS int* tl = (LAS int*)(lds_base + MISC_OFF + 1024);
      if (F.tid < 256) tl[F.tid] = F.tile[F.tid];
      LDS_WAIT(); __syncthreads();
      const int ntiles = __builtin_amdgcn_readfirstlane(tl[255]);
      MoeOrder S; S.init(tl, ntiles, 8, G, bx);
      pg8::Gemm g{F.abuf, F.Btd, RPAD, NE * D, D}; EpiDown8 E{(unsigned char*)F.obuf, F.b_down}; pg8::gemm_phase<EpiDown8, MoeOrder, true, true, true>(F.lds, g, S, E); }
    xcd_barrier(barA);
    { Frame F; fill_frame(F, args, lds_base, bx, G); p11_final(F); }
}

extern "C" void kernel_launch(void* const* d_in, const int* in_sizes, int n_in, void* d_out, int out_size, void* d_ws, size_t ws_size, hipStream_t stream) {
    static int grid = 0;
    if (grid == 0) {
        if (n_in != 23 || out_size != SEQ * D || ws_size < WS_END) { fprintf(stderr, "kernel_launch: unexpected shapes (n_in %d out %d ws %zu need %zu)\n", n_in, out_size, ws_size, (size_t)WS_END); grid = -1; return; }
        int dev = 0, cus = 0, per_cu = 0;
        if (hipGetDevice(&dev) != hipSuccess || hipDeviceGetAttribute(&cus, hipDeviceAttributeMultiprocessorCount, dev) != hipSuccess) { grid = -1; return; }
        if (hipFuncSetAttribute((const void*)fwd, hipFuncAttributeMaxDynamicSharedMemorySize, LDS_BYTES) != hipSuccess) { fprintf(stderr, "kernel_launch: hipFuncSetAttribute failed\n"); grid = -1; return; }
        if (hipOccupancyMaxActiveBlocksPerMultiprocessor(&per_cu, (const void*)fwd, NWAVES * 64, LDS_BYTES) != hipSuccess || per_cu < 1) fprintf(stderr, "kernel_launch: occupancy query says %d\n", per_cu);
        (void)hipGetLastError();
        grid = 256;
        if (cus < 256) { fprintf(stderr, "kernel_launch: needs 256 CUs, device has %d\n", cus); grid = -1; return; }
    }
    if (grid < 0) return;
    Args a{};
    for (int i = 0; i < 23; ++i) a.in[i] = (const float*)d_in[i];
    a.out = (float*)d_out; a.ws = (unsigned char*)d_ws;
    (void)hipMemsetAsync((char*)d_ws + WS_CTL, 0, CTL_BYTES, stream);
    a.ph_lo = 0; a.ph_hi = NPH;
    hipLaunchKernelGGL(fwd, dim3(grid), dim3(NWAVES * 64), LDS_BYTES, stream, a);
}
```

```cpp
#include <hip/hip_runtime.h>
#include <cstdio>
#include <cstdint>
namespace pg8 {
#define PG8_LAS __attribute__((address_space(3)))
typedef unsigned short bf16_t;
typedef short bf16x8 __attribute__((ext_vector_type(8)));
typedef float f32x4 __attribute__((ext_vector_type(4)));
typedef unsigned u32x4 __attribute__((ext_vector_type(4)));
typedef int i32x8 __attribute__((ext_vector_type(8)));
constexpr int BM = 256, BK = 64, HALF = 128, HTB = HALF * BK * 2  , STAGE_BYTES = 8 * HTB, NXCD = 8, WGM = 8;

__host__ __device__ __forceinline__ int lds_byte(int r, int c) { const int st = (r >> 4) * 2 + (c >> 5), rr = r & 15, cc = c & 31, ob = rr * 64 + cc * 2; return st * 1024 + (ob ^ (((ob >> 9) & 1) << 5)); }
__host__ __device__ __forceinline__ void stage_rc(int b, int& R, int& C) { const int st = b / 1024, sb = b % 1024, swz = sb ^ (((sb >> 9) & 1) << 5); R = (st >> 1) * 16 + swz / 64; C = (st & 1) * 32 + (swz % 64) / 2; }
__host__ __device__ __forceinline__ int perm32(int rho) { const int n = rho >> 4, i = rho & 15; return 8 * (i >> 2) + 4 * n + (i & 3); }

struct Unit { int pm, pn; };
struct Gemm { const bf16_t* A; const bf16_t* Bt; int M, N, K; };

struct StaticOrder {
    int nM, nN, nwg, G, c;
    __host__ __device__ void init(int M, int N, int G_, int c_) { nM = M / BM; nN = N / BM; nwg = nM * nN; G = G_; c = c_; }
    __host__ __device__ bool next(int i, Unit& u) const {
        const long L = (long)i * G + c; if (L >= nwg) return false;
        int wgid = (int)L; { const int q = nwg / NXCD, r = nwg % NXCD, xcd = wgid % NXCD, off = wgid / NXCD; wgid = (xcd < r ? xcd * (q + 1) : r * (q + 1) + (xcd - r) * q) + off; }
        const int nig = WGM * nN, gid = wgid / nig, fm = gid * WGM, gsz = (nM - fm) < WGM ? (nM - fm) : WGM;
        u.pm = fm + ((wgid % nig) % gsz); u.pn = (wgid % nig) / gsz; return true;
    }
    __device__ __forceinline__ void a_ready(const Unit&) const {}
    __device__ __forceinline__ void done(const Unit&) const {}
};

__device__ __forceinline__ unsigned cvt_pk_bf16(float lo, float hi) { unsigned r; asm volatile("v_cvt_pk_bf16_f32 %0, %1, %2" : "=v"(r) : "v"(lo), "v"(hi)); return r; }
template <class Epi, class Sched, bool ALIGN_EPI = false, bool SP2 = false, bool F8 = false, bool GATHER = false>
__device__ __forceinline__ void gemm_phase(PG8_LAS unsigned char* lds, const Gemm g, const Sched& S, const Epi& E) {
    const int tid = threadIdx.x, wid = __builtin_amdgcn_readfirstlane(tid >> 6), lane = tid & 63, wr = wid >> 2, wc = wid & 3, fr = lane & 15, fq = lane >> 4;
    const int KB = F8 ? g.K : 2 * g.K  , nt = KB / 128;
    static_assert(!GATHER || (F8 && SP2), "the gather path exists in the fp8 two-super-phase loop only");
    unsigned voffA[2], voffB[2]; int gR[2]; unsigned gC[2];
    unsigned gA0[2], gA1[2], gN0[2], gN1[2]; int gT[4];
#pragma unroll
    for (int i = 0; i < 2; ++i) { int R, C; stage_rc(tid * 16 + i * 8192, R, C); const int Rb = Epi::PERM ? ((R & ~31) + perm32(R & 31)) : R;
        voffA[i] = (unsigned)(R * KB + C * 2); voffB[i] = (unsigned)(Rb * KB + C * 2); gR[i] = R; gC[i] = (unsigned)(C * 2); }
    const size_t kstep = (size_t)(BK * 2);
    const size_t hstep = (size_t)HALF * KB;
    const size_t tstep = 2 * hstep;
    const unsigned ldsw = (unsigned)wid * 1024u;
    const int aoff = lds_byte(wr * 64 + fr, F8 ? fq * 16 : fq * 8), boff = lds_byte(wc * 32 + fr, F8 ? fq * 16 : fq * 8);

#define PG8_SA(b, h) (((b) * 2 + (h)) * HTB)
#define PG8_SB(b, h) ((4 + (b) * 2 + (h)) * HTB)
#define PG8_STAGE(bufoff, gbase, voff) do { if constexpr (F8) { const char* gb_ = (const char*)(gbase); _Pragma("unroll") for (int _i = 0; _i < 2; ++_i) { \
        const unsigned la_ = (unsigned)(size_t)(lds + (bufoff) + ldsw + _i * 8192); \
        asm volatile("s_mov_b32 m0, %2\n\ts_nop 4\n\tglobal_load_lds_dwordx4 %0, %1" :: "v"((voff)[_i]), "s"(gb_), "s"(la_) : "memory", "m0"); } } else { \
        _Pragma("unroll") for (int _i = 0; _i < 2; ++_i) \
        __builtin_amdgcn_global_load_lds((const unsigned*)((const char*)(gbase) + (voff)[_i]), (PG8_LAS unsigned*)(lds + (bufoff) + ldsw + _i * 8192), 16, 0, 0); } } while (0)
#define PG8_STAGE_A(bufoff, base, h, useN) do { if constexpr (GATHER) { unsigned v_[2]; \
        v_[0] = (useN) ? ((h) ? gN1[0] : gN0[0]) : ((h) ? gA1[0] : gA0[0]); v_[1] = (useN) ? ((h) ? gN1[1] : gN0[1]) : ((h) ? gA1[1] : gA0[1]); PG8_STAGE(bufoff, base, v_); } \
        else { PG8_STAGE(bufoff, (base) + (h) * hstep, voffA); } } while (0)
#define PG8_GROWS_ISSUE(u) do { const int* rt_ = S.rowtok + (size_t)(u).pm * 256; \
        asm volatile("global_load_dword %0, %1, off" : "=v"(gT[0]) : "v"(rt_ + gR[0]) : "memory"); asm volatile("global_load_dword %0, %1, off" : "=v"(gT[1]) : "v"(rt_ + gR[1]) : "memory"); \
        asm volatile("global_load_dword %0, %1, off" : "=v"(gT[2]) : "v"(rt_ + 128 + gR[0]) : "memory"); asm volatile("global_load_dword %0, %1, off" : "=v"(gT[3]) : "v"(rt_ + 128 + gR[1]) : "memory"); } while (0)
#define PG8_GROWS_USE(d0, d1) do { asm volatile("" : "+v"(gT[0]), "+v"(gT[1]), "+v"(gT[2]), "+v"(gT[3])); \
        d0[0] = (unsigned)gT[0] * (unsigned)KB + gC[0]; d0[1] = (unsigned)gT[1] * (unsigned)KB + gC[1]; d1[0] = (unsigned)gT[2] * (unsigned)KB + gC[0]; d1[1] = (unsigned)gT[3] * (unsigned)KB + gC[1]; } while (0)
#define PG8_LDA(dst, b, h) do { if constexpr (F8) { _Pragma("unroll") for (int m = 0; m < 4; ++m) dst##8[m] = *(const PG8_LAS i32x8*)(lds + PG8_SA(b, h) + aoff + m * 2048); } else { \
        _Pragma("unroll") for (int m = 0; m < 4; ++m) _Pragma("unroll") for (int k = 0; k < 2; ++k) dst[m][k] = *(const PG8_LAS bf16x8*)(lds + PG8_SA(b, h) + aoff + m * 2048 + k * 1024); } } while (0)
#define PG8_LDB(dst, b, h) do { if constexpr (F8) { _Pragma("unroll") for (int n = 0; n < 2; ++n) dst##8[n] = *(const PG8_LAS i32x8*)(lds + PG8_SB(b, h) + boff + n * 2048); } else { \
        _Pragma("unroll") for (int n = 0; n < 2; ++n) _Pragma("unroll") for (int k = 0; k < 2; ++k) dst[n][k] = *(const PG8_LAS bf16x8*)(lds + PG8_SB(b, h) + boff + n * 2048 + k * 1024); } } while (0)
#define PG8_MMA(ai, bj, At, Bt) do { __builtin_amdgcn_s_setprio(1); if constexpr (F8) { _Pragma("unroll") for (int m = 0; m < 4; ++m) _Pragma("unroll") for (int n = 0; n < 2; ++n) \
        asm volatile("v_mfma_scale_f32_16x16x128_f8f6f4 %0, %1, %2, %0, %3, %3 op_sel_hi:[0,0,0]" : "+v"(acc[ai][bj][m][n]) : "v"(Bt##8[n]), "v"(At##8[m]), "v"(f8scale)); } else {     \
        _Pragma("unroll") for (int m = 0; m < 4; ++m) _Pragma("unroll") for (int n = 0; n < 2; ++n) _Pragma("unroll") for (int k = 0; k < 2; ++k) \
        acc[ai][bj][m][n] = __builtin_amdgcn_mfma_f32_16x16x32_bf16(Bt[n][k], At[m][k], acc[ai][bj][m][n], 0, 0, 0); } __builtin_amdgcn_s_setprio(0); } while (0)
#define PG8_WAIT_V(n) asm volatile("s_waitcnt vmcnt(" #n ")" ::: "memory")
#define PG8_WAIT_L(n) asm volatile("s_waitcnt lgkmcnt(" #n ")" ::: "memory")
#define PG8_BAR __builtin_amdgcn_s_barrier()
#define PG8_SCHED __builtin_amdgcn_sched_barrier(0)
    Unit cur, nxt; int ui = 0;
    if (!S.next(0, cur)) return;
    f32x4 acc[2][2][4][2];
#pragma unroll
    for (int a = 0; a < 2; ++a)
#pragma unroll
        for (int b = 0; b < 2; ++b)
#pragma unroll
            for (int m = 0; m < 4; ++m)
#pragma unroll
                for (int n = 0; n < 2; ++n) acc[a][b][m][n] = (f32x4){0.f, 0.f, 0.f, 0.f};
    const int f8scale = 0x7f7f7f7f;
    bf16x8 At[4][2], B0[2][2], B1[2][2]; i32x8 At8[4], B08[2], B18[2];
    const char* cA = GATHER ? (const char*)g.A : (const char*)g.A + (size_t)cur.pm * tstep; const char* cB = (const char*)g.Bt + (size_t)cur.pn * tstep;
    S.a_ready(cur);
    if constexpr (GATHER) { PG8_GROWS_ISSUE(cur); asm volatile("s_waitcnt vmcnt(0)" ::: "memory"); PG8_GROWS_USE(gA0, gA1); }
    if constexpr (SP2) {
        PG8_STAGE(PG8_SB(0, 0), cB, voffB); PG8_STAGE(PG8_SB(0, 1), cB + hstep, voffB); PG8_STAGE_A(PG8_SA(0, 0), cA, 0, false); PG8_STAGE_A(PG8_SA(0, 1), cA, 1, false);
        if (wr == 1) PG8_BAR;
        PG8_WAIT_V(2); PG8_BAR;
        PG8_STAGE(PG8_SB(1, 0), cB + kstep, voffB); PG8_STAGE_A(PG8_SA(1, 0), cA + kstep, 0, false); PG8_STAGE(PG8_SB(1, 1), cB + hstep + kstep, voffB);
        PG8_WAIT_V(6); PG8_BAR;
    } else {
        PG8_STAGE(PG8_SB(0, 0), cB, voffB); PG8_STAGE(PG8_SA(0, 0), cA, voffA); PG8_STAGE(PG8_SB(0, 1), cB + hstep, voffB); PG8_STAGE(PG8_SA(0, 1), cA + hstep, voffA);
        if (wr == 1) PG8_BAR;
        PG8_WAIT_V(4); PG8_BAR;
        PG8_STAGE(PG8_SB(1, 0), cB + kstep, voffB); PG8_STAGE(PG8_SA(1, 0), cA + kstep, voffA); PG8_STAGE(PG8_SB(1, 1), cB + hstep + kstep, voffB);
        PG8_WAIT_V(6); PG8_BAR;
    }
    for (;;) {
        const bool has_next = S.next(ui + 1, nxt);
        const char* nA = GATHER ? (const char*)g.A : (has_next ? (const char*)g.A + (size_t)nxt.pm * tstep : cA); const char* nB = has_next ? (const char*)g.Bt + (size_t)nxt.pn * tstep : cB;
        if constexpr (GATHER) { if (has_next) PG8_GROWS_ISSUE(nxt); }
        for (int t = 0; t < nt; t += 2) {
            const bool last = (t == nt - 2);
            const char* a1 = cA + (size_t)(t + 1) * kstep;
            const char* a2 = last ? nA : cA + (size_t)(t + 2) * kstep; const char* b2 = last ? nB : cB + (size_t)(t + 2) * kstep;
            const char* a3 = a2 + kstep; const char* b3 = b2 + kstep;
            if (last && has_next) S.a_ready(nxt);
            if constexpr (SP2) {
            PG8_LDB(B0, 0, 0); PG8_LDB(B1, 0, 1); PG8_SCHED; PG8_LDA(At, 0, 0); PG8_STAGE_A(PG8_SA(1, 1), a1, 1, false);
            PG8_WAIT_V(8); PG8_WAIT_L(0);
            if constexpr (GATHER) { if (last) { if (has_next) PG8_GROWS_USE(gN0, gN1); else { gN0[0] = gA0[0]; gN0[1] = gA0[1]; gN1[0] = gA1[0]; gN1[1] = gA1[1]; } } }
            PG8_BAR; PG8_MMA(0, 0, At, B0); PG8_MMA(0, 1, At, B1); PG8_BAR; PG8_SCHED;
            PG8_LDA(At, 0, 1); PG8_STAGE(PG8_SB(0, 0), b2, voffB); PG8_STAGE(PG8_SB(0, 1), b2 + hstep, voffB); PG8_STAGE_A(PG8_SA(0, 0), a2, 0, last);
            PG8_WAIT_V(8); PG8_WAIT_L(0); PG8_BAR; PG8_MMA(1, 0, At, B0); PG8_MMA(1, 1, At, B1); PG8_BAR; PG8_SCHED;
            PG8_LDB(B0, 1, 0); PG8_LDB(B1, 1, 1); PG8_SCHED; PG8_LDA(At, 1, 0); PG8_STAGE_A(PG8_SA(0, 1), a2, 1, last);
            PG8_WAIT_V(8); PG8_WAIT_L(0); PG8_BAR; PG8_MMA(0, 0, At, B0); PG8_MMA(0, 1, At, B1); PG8_BAR; PG8_SCHED;
            PG8_LDA(At, 1, 1); PG8_STAGE(PG8_SB(1, 0), b3, voffB); PG8_STAGE(PG8_SB(1, 1), b3 + hstep, voffB); PG8_STAGE_A(PG8_SA(1, 0), a3, 0, last);
            PG8_WAIT_V(8); PG8_WAIT_L(0); PG8_BAR; PG8_MMA(1, 0, At, B0); PG8_MMA(1, 1, At, B1); PG8_BAR; PG8_SCHED;
            } else {
            PG8_LDB(B0, 0, 0); PG8_SCHED; PG8_LDA(At, 0, 0); PG8_STAGE(PG8_SA(1, 1), a1 + hstep, voffA);
            PG8_WAIT_L(8); PG8_BAR; PG8_WAIT_L(0); PG8_MMA(0, 0, At, B0); PG8_BAR; PG8_SCHED;
            PG8_LDB(B1, 0, 1); PG8_STAGE(PG8_SB(0, 0), b2, voffB);
            PG8_BAR; PG8_WAIT_L(0); PG8_MMA(0, 1, At, B1); PG8_BAR;
            PG8_LDA(At, 0, 1); PG8_STAGE(PG8_SA(0, 0), a2, voffA);
            PG8_BAR; PG8_WAIT_L(0); PG8_MMA(1, 0, At, B0); PG8_BAR; PG8_SCHED;
            PG8_STAGE(PG8_SB(0, 1), b2 + hstep, voffB);
            PG8_WAIT_V(6); PG8_BAR; PG8_MMA(1, 1, At, B1); PG8_BAR;
            PG8_LDB(B0, 1, 0); PG8_SCHED; PG8_LDA(At, 1, 0); PG8_STAGE(PG8_SA(0, 1), a2 + hstep, voffA);
            PG8_WAIT_L(8); PG8_BAR; PG8_WAIT_L(0); PG8_MMA(0, 0, At, B0); PG8_BAR; PG8_SCHED;
            PG8_LDB(B1, 1, 1); PG8_STAGE(PG8_SB(1, 0), b3, voffB);
            PG8_BAR; PG8_WAIT_L(0); PG8_MMA(0, 1, At, B1); PG8_BAR;
            PG8_LDA(At, 1, 1); PG8_STAGE(PG8_SA(1, 0), a3, voffA);
            PG8_BAR; PG8_WAIT_L(0); PG8_MMA(1, 0, At, B0); PG8_BAR; PG8_SCHED;
            PG8_STAGE(PG8_SB(1, 1), b3 + hstep, voffB);
            PG8_WAIT_V(6); PG8_BAR; PG8_MMA(1, 1, At, B1); PG8_BAR;
            }
        }
        if constexpr (ALIGN_EPI) { if (wr == 0) PG8_BAR; }
        if constexpr (F8) asm volatile("s_nop 15\n\ts_nop 7" ::: "memory");
        if constexpr (!Epi::AFTER_DRAIN) {
            int tz_ = threadIdx.x; asm volatile("" : "+v"(tz_)); const int l_ = tz_ & 63, w_ = __builtin_amdgcn_readfirstlane(tz_ >> 6);
            E(acc, cur, w_ >> 2, w_ & 3, l_ & 15, l_ >> 4); S.done(cur); }
        if (!has_next) break;
#pragma unroll
        for (int a = 0; a < 2; ++a)
#pragma unroll
            for (int b = 0; b < 2; ++b)
#pragma unroll
                for (int m = 0; m < 4; ++m)
#pragma unroll
                    for (int n = 0; n < 2; ++n) acc[a][b][m][n] = (f32x4){0.f, 0.f, 0.f, 0.f};
        cur = nxt; cA = nA; cB = nB; ++ui;
        if constexpr (GATHER) { gA0[0] = gN0[0]; gA0[1] = gN0[1]; gA1[0] = gN1[0]; gA1[1] = gN1[1]; }
        if constexpr (ALIGN_EPI) { if (wr == 1) PG8_BAR; }
    }
    PG8_WAIT_V(0);
    if constexpr (!ALIGN_EPI) { if (wr == 0) PG8_BAR; }
    PG8_BAR;
    if constexpr (Epi::AFTER_DRAIN) { E.fused(acc, cur, wr, wc, fr, fq, lds, wid, lane); S.done(cur); }
#undef PG8_SA
#undef PG8_SB
#undef PG8_STAGE
#undef PG8_STAGE_A
#undef PG8_GROWS_ISSUE
#undef PG8_GROWS_USE
#undef PG8_LDA
#undef PG8_LDB
#undef PG8_MMA
#undef PG8_WAIT_V
#undef PG8_WAIT_L
#undef PG8_BAR
#undef PG8_SCHED
}
}
#define LAS __attribute__((address_space(3)))
#define XB_TMO      128
#define XB_XCNT(j)  (256  + 64 * (j))
#define XB_XSUB(j)  (1280 + 64 * (j))
#define XB_XGEN(j)  (2304 + 64 * (j))
#define XB_TOP      3328
#define XB_TOPGEN   3392
#define XCD_BAR_WORDS 3456
#define XB_SPIN_CAP (1u << 18)

__device__ __forceinline__ unsigned xb_ld(unsigned* p)              { return __hip_atomic_load(p, __ATOMIC_RELAXED, __HIP_MEMORY_SCOPE_AGENT); }
__device__ __forceinline__ unsigned xb_add(unsigned* p, unsigned v) { return __hip_atomic_fetch_add(p, v, __ATOMIC_RELAXED, __HIP_MEMORY_SCOPE_AGENT); }
__device__ __forceinline__ unsigned xb_xcc_id() { return (unsigned)__builtin_amdgcn_s_getreg((3 << 11) | 20) & 0xFu; }
#define XB_SPIN(cond, bar) do { unsigned _sp = 0; while (cond) { __builtin_amdgcn_s_sleep(1); \
    if ((++_sp & 255u) == 0u) { if (xb_ld(&(bar)[XB_TMO])) break; if (_sp > XB_SPIN_CAP) { atomicAdd(&(bar)[XB_TMO], 1u); break; } } } } while (0)

struct XcdBarrier {
    unsigned* bar; unsigned x;
    volatile LAS unsigned* st;
    unsigned G;
};

__device__ __forceinline__ XcdBarrier xcd_barrier_post(unsigned* bar, volatile LAS unsigned* st, unsigned G) {
    XcdBarrier b; b.bar = bar; b.x = xb_xcc_id(); b.st = st; b.G = G;
    if (threadIdx.x == 0) (void)xb_add(&bar[XB_XCNT(b.x)], 1u);
    return b;
}
__device__ __forceinline__ void xcd_barrier_complete(unsigned* bar, unsigned x, unsigned& nloc, unsigned& nx, const unsigned G) {
    unsigned sum, cnt, mine, sp = 0u;
    for (;;) {
        sum = 0u; cnt = 0u; mine = 0u;
#pragma unroll
        for (unsigned j = 0; j < 16; ++j) { const unsigned c = xb_ld(&bar[XB_XCNT(j)]); sum += c; cnt += (c > 0u) ? 1u : 0u; mine = (j == x) ? c : mine; }
        if (sum == G) break;
        __builtin_amdgcn_s_sleep(1);
        if ((++sp & 255u) == 0u) { if (xb_ld(&bar[XB_TMO])) break; if (sp > XB_SPIN_CAP) { atomicAdd(&bar[XB_TMO], 1u); break; } }
    }
    nloc = mine > 0u ? mine : 1u; nx = cnt > 0u ? cnt : 1u;
}

__device__ __forceinline__ void xcd_barrier(const XcdBarrier& b) {
    asm volatile("s_waitcnt vmcnt(0)" ::: "memory");
    __syncthreads();
    if (threadIdx.x == 0) {
        unsigned* bar = b.bar;
        __builtin_amdgcn_s_waitcnt(0);
        unsigned nloc = b.st[0], nx = b.st[1];
        if (nloc == 0u) { xcd_barrier_complete(bar, b.x, nloc, nx, b.G); b.st[0] = nloc; b.st[1] = nx; }
        const unsigned old = xb_add(&bar[XB_XSUB(b.x)], 1u);
        const unsigned gen = old / nloc;
        if (old + 1u == (gen + 1u) * nloc) {
            __builtin_amdgcn_fence(__ATOMIC_RELEASE, "agent");
            asm volatile("s_waitcnt vmcnt(0)" ::: "memory");
            const unsigned og = xb_add(&bar[XB_TOP], 1u);
            const unsigned tg = og / nx;
            if (og + 1u == (tg + 1u) * nx) xb_add(&bar[XB_TOPGEN], 1u);
            else XB_SPIN(xb_ld(&bar[XB_TOPGEN]) == tg, bar);
            __builtin_amdgcn_fence(__ATOMIC_ACQUIRE, "agent");
            xb_add(&bar[XB_XGEN(b.x)], 1u);
            asm volatile("s_waitcnt vmcnt(0)" ::: "memory");
        } else {
            XB_SPIN(xb_ld(&bar[XB_XGEN(b.x)]) == gen, bar);
            __builtin_amdgcn_fence(__ATOMIC_ACQUIRE, "agent");
            asm volatile("s_waitcnt vmcnt(0)" ::: "memory");
        }
    }
    __syncthreads();
}
constexpr int D = 2048, SEQ = 8192, NMETA = 16, LEAD = 48, NP = 8256  , MP = 8448  ;
constexpr int NPROJ = 3840, C_Z = 1024, C_X = 2048, C_B = 3072, C_C = 3328, C_DT = 3584, NINPROJ = 3600;
constexpr int NE = 32, DCONV = 1536;
constexpr int RTILES = 160, RPAD = RTILES * 256;
constexpr float EPS = 1e-5f;
constexpr int NWAVES = 8, NPH = 12;
#ifndef WN_WORKERS
#define WN_WORKERS 136
#endif
constexpr int WN = WN_WORKERS;
#ifndef MOE_F8
#define MOE_F8 1
#endif
#ifndef MOE_RB
#define MOE_RB 0
#endif
#ifndef MK_ONE_LAUNCH
#define MK_ONE_LAUNCH 1
#endif

constexpr size_t WS_CTL = 0, CTL_BYTES = 1u << 20;
constexpr size_t WS_HN = CTL_BYTES;
constexpr size_t WS_BT1 = WS_HN + (size_t)MP * D * 2;
constexpr size_t WS_BT2 = WS_BT1 + (size_t)NPROJ * D * 2;
constexpr size_t WS_PROJ = WS_BT2 + (size_t)D * D * 2;
constexpr size_t WS_XT = WS_PROJ + (size_t)MP * NPROJ * 2;
constexpr size_t WS_BTT = WS_XT + (size_t)1024 * NP * 2;
constexpr size_t WS_BC = WS_BTT + (size_t)256 * NP * 2;
constexpr size_t WS_CC = WS_BC + (size_t)NP * 256 * 2;
constexpr size_t WS_DT = WS_CC + (size_t)NP * 256 * 2;
constexpr size_t WS_ST = WS_DT + (size_t)NP * 16 * 4;
constexpr size_t WS_DEC = WS_ST + (size_t)128 * 131072 * 4;
constexpr size_t WS_PREV = WS_DEC + 128 * 16 * 4;
constexpr size_t WS_YCAT = WS_PREV + (size_t)128 * 131072 * 2;
constexpr size_t WS_H2 = WS_YCAT + (size_t)SEQ * D * 2;
constexpr size_t WS_HN2 = WS_H2 + (size_t)SEQ * D * 4;
constexpr size_t WS_WR = WS_HN2 + (size_t)SEQ * D * 2;
constexpr size_t WS_TKE = WS_WR + (size_t)D * NE * 4;
constexpr size_t WS_TKG = WS_TKE + (size_t)SEQ * 16;
constexpr size_t WS_POS = WS_TKG + (size_t)SEQ * 16;
constexpr size_t WS_CNT = WS_POS + (size_t)SEQ * 16;
constexpr size_t WS_TILE = WS_CNT + 256 * 32 * 4;
constexpr size_t WS_XS = WS_TILE + 1024;
constexpr size_t WS_A = WS_XS + (size_t)RPAD * D * 2;
constexpr size_t WS_O = WS_A + (size_t)RPAD * D * 2;
constexpr size_t WS_BTGU = WS_O + (MOE_F8 ? (size_t)RPAD * D * 2 : 0);
constexpr size_t WS_BTD = WS_BTGU + (size_t)NE * 4096 * D * (MOE_F8 ? 1 : 2);
constexpr size_t WS_END = WS_BTD + (size_t)NE * D * D * (MOE_F8 ? 1 : 2);
constexpr int CW_BAR = 4096, CW_BAR2 = 8192;
static_assert((CW_BAR2 + XCD_BAR_WORDS) * 4 <= (int)CTL_BYTES && CW_BAR + XCD_BAR_WORDS <= CW_BAR2, "ctl");

constexpr int RING_BYTES = 131072, SCR_BYTES = 135168, MISC_OFF = SCR_BYTES, LDS_BYTES = 147456;

#define DI __device__ __forceinline__
typedef unsigned short bf16;
typedef unsigned v4u __attribute__((ext_vector_type(4)));
typedef unsigned v2u __attribute__((ext_vector_type(2)));
typedef float f32x4 __attribute__((ext_vector_type(4)));
typedef float f32x16 __attribute__((ext_vector_type(16)));
typedef short bf16x8 __attribute__((ext_vector_type(8)));
#define LDS_WAIT() asm volatile("s_waitcnt lgkmcnt(0)" ::: "memory")
#define MFMA32(a, b, c) __builtin_amdgcn_mfma_f32_32x32x16_bf16((a), (b), (c), 0, 0, 0)
DI float bf_lo(unsigned w) { return __uint_as_float(w << 16); }
DI float bf_hi(unsigned w) { return __uint_as_float(w & 0xffff0000u); }
DI float bf2f(bf16 v) { return __uint_as_float(((unsigned)v) << 16); }
typedef __bf16 bf2v __attribute__((ext_vector_type(2)));
typedef float f2v __attribute__((ext_vector_type(2)));
DI unsigned pk2(float lo, float hi) { const f2v v = {lo, hi}; const bf2v b = __builtin_convertvector(v, bf2v); return __builtin_bit_cast(unsigned, b); }
DI unsigned pk4_f8(float a, float b, float c, float d) { int p = __builtin_amdgcn_cvt_pk_fp8_f32(a, b, 0, false); p = __builtin_amdgcn_cvt_pk_fp8_f32(c, d, p, true); return (unsigned)p; }
DI bf16 f2bf(float f) { return (bf16)(pk2(f, 0.f) & 0xffffu); }
DI float wave_sum(float v) {
#pragma unroll
    for (int o = 1; o < 64; o <<= 1) v += __shfl_xor(v, o);
    return v;
}
DI float wave_incl_scan(float v, int lane) {
#pragma unroll
    for (int o = 1; o < 64; o <<= 1) { const float t = __shfl_up(v, o); if (lane >= o) v += t; }
    return v;
}
DI float silu_f(float x) { return x * __builtin_amdgcn_rcpf(1.f + __expf(-x)); }

struct Frame {
    LAS unsigned char* lds;
    int tid, lane, wave, gw, ngw, bid, nwg;
    const float *x, *meta, *g1, *w_in, *pool_w, *pool_scale, *conv_w, *conv_b, *dt_bias, *a_log, *d_skip, *ssm_g, *w_out, *g2, *router_w, *router_b,
        *w_gate, *b_gate, *w_up, *b_up, *w_down, *b_down, *final_g;
    float* out;
    bf16 *hn, *Bt1, *Bt2, *proj, *xT, *BT, *Bc, *Cc, *prev, *ycat, *hn2, *xs, *abuf, *obuf, *Btgu, *Btd;
    float *dtv, *decay, *Wr, *tkg; bf16 *states, *h2;
    int *tke, *pos, *cnt, *tile;
};

DI int crow16(int reg, int hf) { return (reg & 3) + 8 * (reg >> 2) + 4 * hf; }
DI void p0_norm(Frame& F) {
    const f32x4* gr = (const f32x4*)F.g1 + F.lane;
    for (int P0 = F.gw; P0 < NP; P0 += 2 * F.ngw) {
        f32x4 v[2][8]; bool live[2];
#pragma unroll
        for (int u = 0; u < 2; ++u) { const int P = P0 + u * F.ngw; live[u] = (P >= LEAD && P < NP);
            const int t = live[u] ? P - LEAD : 0;
            const float* src = t < NMETA ? F.meta + (size_t)t * D : F.x + (size_t)(t - NMETA) * D;
            const f32x4* xr = (const f32x4*)src + F.lane;
#pragma unroll
            for (int j = 0; j < 8; ++j) v[u][j] = xr[64 * j]; }
#pragma unroll
        for (int u = 0; u < 2; ++u) { const int P = P0 + u * F.ngw; if (P >= NP) continue;
            unsigned long long* o8 = (unsigned long long*)(F.hn + (size_t)P * D) + F.lane;
            if (!live[u]) {
#pragma unroll
                for (int j = 0; j < 8; ++j) o8[64 * j] = 0ull;
                continue; }
            float s = 0.f;
#pragma unroll
            for (int j = 0; j < 8; ++j) s += (v[u][j].x * v[u][j].x + v[u][j].y * v[u][j].y) + (v[u][j].z * v[u][j].z + v[u][j].w * v[u][j].w);
            const float rstd = rsqrtf(wave_sum(s) * (1.f / D) + EPS);
#pragma unroll
            for (int j = 0; j < 8; ++j) { const f32x4 g = gr[64 * j];
                o8[64 * j] = (unsigned long long)pk2(v[u][j].x * rstd * g.x, v[u][j].y * rstd * g.y) | ((unsigned long long)pk2(v[u][j].z * rstd * g.z, v[u][j].w * rstd * g.w) << 32); }
        }
    }
}
typedef unsigned int bs_u4 __attribute__((__vector_size__(16)));
DI void tr_load(float (&v)[64], const float* W, size_t ldw, int nvalid, int lane) {
    const int r4 = lane >> 4, n4 = lane & 15;
    if (4 * n4 < nvalid) {
        const __amdgpu_buffer_rsrc_t rs = __builtin_amdgcn_make_buffer_rsrc((void*)W, 0, 0x7fffffff, 0x00020000);
        const int voff = (r4 * (int)ldw + 4 * n4) * 4;
#pragma unroll
        for (int u = 0; u < 16; ++u) { const f32x4 q = __builtin_bit_cast(f32x4, __builtin_amdgcn_raw_buffer_load_b128(rs, voff, u * 16 * (int)ldw, 2)); v[4 * u] = q.x; v[4 * u + 1] = q.y; v[4 * u + 2] = q.z; v[4 * u + 3] = q.w; }
    } else {
#pragma unroll
        for (int kk = 0; kk < 64; ++kk) v[kk] = 0.f;
    }
}
DI void tr_to_lds(const float (&v)[64], LAS float* scr, int lane, float scale) {
    const int r4 = lane >> 4, n4 = lane & 15; LAS float* d = scr + r4 * 65 + 4 * n4;
#pragma unroll
    for (int u = 0; u < 16; ++u) {
#pragma unroll
        for (int e = 0; e < 4; ++e) d[(4 * u) * 65 + e] = v[4 * u + e] * scale;
        __builtin_amdgcn_sched_barrier(0); }
}
DI void tr_store(const float (&v)[64], int nvalid, bf16* WT, size_t ldt, LAS float* scr, int lane) {
    tr_to_lds(v, scr, lane, 1.f);
    LDS_WAIT();
    const int c = lane & 7;
    const __amdgpu_buffer_rsrc_t rs = __builtin_amdgcn_make_buffer_rsrc((void*)WT, 0, 0x7fffffff, 0x00020000);
    const int voff = ((lane >> 3) * (int)ldt + 8 * c) * 2;
#pragma unroll
    for (int j = 0; j < 8; ++j) { const int n = (lane >> 3) + 8 * j; const LAS float* s = scr + (8 * c) * 65 + n;
        v4u o; o.x = pk2(s[0], s[65]); o.y = pk2(s[130], s[195]); o.z = pk2(s[260], s[325]); o.w = pk2(s[390], s[455]);
        if (n < nvalid) __builtin_amdgcn_raw_buffer_store_b128(__builtin_bit_cast(bs_u4, o), rs, voff, 16 * j * (int)ldt, 0); __builtin_amdgcn_sched_barrier(0); }
    LDS_WAIT();
}
DI void tr_store8(const float (&v)[64], unsigned char* WT, size_t ldt, LAS float* scr, int lane, float scale) {
    tr_to_lds(v, scr, lane, scale);
    LDS_WAIT();
    const int c = lane & 3;
    const __amdgpu_buffer_rsrc_t rs = __builtin_amdgcn_make_buffer_rsrc((void*)WT, 0, 0x7fffffff, 0x00020000);
    const int voff = (lane >> 2) * (int)ldt + 16 * c;
#pragma unroll
    for (int j = 0; j < 4; ++j) { const int n = (lane >> 2) + 16 * j; const LAS float* s = scr + (16 * c) * 65 + n;
        v4u o; o.x = pk4_f8(s[0], s[65], s[130], s[195]); o.y = pk4_f8(s[260], s[325], s[390], s[455]);
        o.z = pk4_f8(s[520], s[585], s[650], s[715]); o.w = pk4_f8(s[780], s[845], s[910], s[975]);
        __builtin_amdgcn_raw_buffer_store_b128(__builtin_bit_cast(bs_u4, o), rs, voff, 16 * j * (int)ldt, 2); __builtin_amdgcn_sched_barrier(0); }
    LDS_WAIT();
}
struct TrItem { const float* W; bf16* WT; int ldw, nv; };
constexpr int I_IN = 32 * 57, I_OUT = 16 * 32, I_MOE = MOE_RB ? 0 : NE * 3 * 32 * 32, NITEMS = I_IN + I_OUT + I_MOE;
constexpr float W8_SCALE = 1024.f, X8_SCALE = 16.f, A8_SCALE = 4.f, O8_SCALE = 16.f;
DI TrItem tr_get(Frame& F, int it) {
    TrItem t; int r = it;
    if (r < I_MOE) {
        const int nb = r & 31, kb = (r >> 5) & 31, em = r >> 10, mat = em % 3, e = em / 3;
        t.ldw = D; t.nv = 64;
        constexpr int ES = MOE_F8 ? 1 : 2;
        if (mat == 2) { t.W = F.w_down + (size_t)e * D * D + (size_t)(64 * kb) * D + 64 * nb; t.WT = (bf16*)((unsigned char*)F.Btd + (((size_t)e * D + 64 * nb) * D + 64 * kb) * ES); }
        else { t.W = (mat == 0 ? F.w_gate : F.w_up) + (size_t)e * D * D + (size_t)(64 * kb) * D + 64 * nb;
               const int row = 256 * (nb >> 1) + 64 * (nb & 1) + 128 * mat; t.WT = (bf16*)((unsigned char*)F.Btgu + (((size_t)e * 4096 + row) * D + 64 * kb) * ES); }
        return t;
    }
    r -= I_MOE;
    if (r < I_IN) { const int kb = r / 57, nb = r % 57; t.ldw = NINPROJ; t.nv = (nb == 56) ? 16 : 64;
        t.W = F.w_in + (size_t)(64 * kb) * NINPROJ + 64 * nb; t.WT = F.Bt1 + (size_t)(64 * nb) * D + 64 * kb; return t; }
    r -= I_IN;
    { const int kb = r >> 5, nb = r & 31; t.ldw = D; t.nv = 64;
      t.W = F.w_out + (size_t)(1024 + 64 * kb) * D + 64 * nb; t.WT = F.Bt2 + (size_t)(64 * nb) * D + 1024 + 64 * kb; return t; }
}
template <bool MOE>
DI void p0_weights_range(Frame& F, const int it_lo, const int it_hi) {
    LAS float* scr = (LAS float*)(F.lds + F.wave * 16640);
    float va[64], vb[64], vc[64];
    int it = it_lo + F.gw; const int st = F.ngw;
    if (it >= it_hi) return;
#define TR_LOAD(v, t) tr_load(v, (t).W, (t).ldw, MOE ? 64 : (t).nv, F.lane)
#define TR_EMIT(v, t) do { if constexpr (MOE) tr_store8(v, (unsigned char*)(t).WT, D, scr, F.lane, W8_SCALE); else tr_store(v, (t).nv, (t).WT, D, scr, F.lane); } while (0)
    TrItem ta = tr_get(F, it), tb = ta, tc = ta;
    TR_LOAD(va, ta);
    if (it + 4 * st < it_hi) {
        tb = tr_get(F, it + st); TR_LOAD(vb, tb);
        do {
            tc = tr_get(F, it + 2 * st); TR_LOAD(vc, tc); TR_EMIT(va, ta);
            ta = tr_get(F, it + 3 * st); TR_LOAD(va, ta); TR_EMIT(vb, tb);
            tb = tr_get(F, it + 4 * st); TR_LOAD(vb, tb); TR_EMIT(vc, tc);
            it += 3 * st;
        } while (it + 4 * st < it_hi);
    } else if (it + st < it_hi) { tb = tr_get(F, it + st); TR_LOAD(vb, tb); }
    bool hb = it + st < it_hi;
    for (;;) {
        const bool hc = it + 2 * st < it_hi;
        if (hc) { tc = tr_get(F, it + 2 * st); TR_LOAD(vc, tc); }
        TR_EMIT(va, ta);
        if (!hb) break;
        const bool ha = it + 3 * st < it_hi;
        if (ha) { ta = tr_get(F, it + 3 * st); TR_LOAD(va, ta); }
        TR_EMIT(vb, tb);
        if (!hc) break;
        hb = it + 4 * st < it_hi;
        if (hb) { tb = tr_get(F, it + 4 * st); TR_LOAD(vb, tb); }
        TR_EMIT(vc, tc);
        if (!ha) break;
        it += 3 * st;
    }
#undef TR_EMIT
#undef TR_LOAD
}
DI void p0_weff(Frame& F) {
    const int lane = F.lane, li = lane & 31, kh = lane >> 5;
    for (int task = F.gw; task < 2048; task += F.ngw) {
        const int g = task >> 9, rem = task & 511, cb = rem >> 6, nb = rem & 63;
        const float* wo = F.w_out + (size_t)(256 * g + 4 * kh) * D + 32 * nb + li;
        const float* ps = F.pool_scale + 256 * g + 4 * kh;
        const float* pw = F.pool_w + (size_t)(g * 256 + 32 * cb + li) * 256 + 4 * kh;
        f32x16 acc;
#pragma unroll
        for (int i = 0; i < 16; ++i) acc[i] = 0.f;
#pragma unroll 8
        for (int jj = 0; jj < 32; ++jj) {
            const f32x4 b = *(const f32x4*)(pw + 8 * jj), sc = *(const f32x4*)(ps + 8 * jj);
            const float a0 = wo[(size_t)(8 * jj) * D] * sc.x, a1 = wo[(size_t)(8 * jj + 1) * D] * sc.y, a2 = wo[(size_t)(8 * jj + 2) * D] * sc.z, a3 = wo[(size_t)(8 * jj + 3) * D] * sc.w;
            acc = __builtin_amdgcn_mfma_f32_32x32x2f32(a0, b.x, acc, 0, 0, 0);
            acc = __builtin_amdgcn_mfma_f32_32x32x2f32(a1, b.y, acc, 0, 0, 0);
            acc = __builtin_amdgcn_mfma_f32_32x32x2f32(a2, b.z, acc, 0, 0, 0);
            acc = __builtin_amdgcn_mfma_f32_32x32x2f32(a3, b.w, acc, 0, 0, 0);
        }
        bf16* dst = F.Bt2 + (size_t)(32 * nb) * D + 256 * g + 32 * cb + li;
#pragma unroll
        for (int i = 0; i < 16; ++i) dst[(size_t)crow16(i, kh) * D] = f2bf(acc[i]);
    }
}
DI void p0_router_fold(Frame& F) {
    for (int i = F.bid * 512 + F.tid; i < D * NE; i += F.nwg * 512) F.Wr[i] = F.g2[i >> 5] * F.router_w[i];
}

DI void e_conv_tile(Frame& F, int c, int pcol, int cch, bf16* outT, bf16* outR, int rcol) {
    const int lane = F.lane, ch = cch + lane;
    const float w0 = F.conv_w[ch], w1 = F.conv_w[DCONV + ch], w2 = F.conv_w[2 * DCONV + ch], w3 = F.conv_w[3 * DCONV + ch], b = F.conv_b[ch];
    const bf16* src = F.proj + pcol + lane;
    const int P0 = 64 * c;
    bf16 raw[67];
#pragma unroll
    for (int i = 0; i < 3; ++i) raw[i] = (P0 - 3 + i >= 0) ? src[(size_t)(P0 - 3 + i) * NPROJ] : (bf16)0;
#pragma unroll
    for (int i = 0; i < 64; ++i) raw[3 + i] = src[(size_t)(P0 + i) * NPROJ];
#pragma unroll
    for (int sb = 0; sb < 4; ++sb) {
        float o[16];
#pragma unroll
        for (int i = 0; i < 16; ++i) { const int q = 16 * sb + i;
            const float a = b + w0 * bf2f(raw[q]) + w1 * bf2f(raw[q + 1]) + w2 * bf2f(raw[q + 2]) + w3 * bf2f(raw[q + 3]);
            o[i] = (P0 + q >= LEAD) ? silu_f(a) : 0.f; }
        if (outT) { v4u q0, q1;
            q0.x = pk2(o[0], o[1]); q0.y = pk2(o[2], o[3]); q0.z = pk2(o[4], o[5]); q0.w = pk2(o[6], o[7]);
            q1.x = pk2(o[8], o[9]); q1.y = pk2(o[10], o[11]); q1.z = pk2(o[12], o[13]); q1.w = pk2(o[14], o[15]);
            bf16* dst = outT + (size_t)lane * NP + P0 + 16 * sb; *(v4u*)dst = q0; *(v4u*)(dst + 8) = q1; }
        if (outR) {
#pragma unroll
            for (int i = 0; i < 16; ++i) outR[(size_t)(P0 + 16 * sb + i) * 256 + rcol + lane] = f2bf(o[i]); }
    }
}
template <int W> DI void e_pool_tile(Frame& F, int c, int colbase) {
    const int lane = F.lane; const bf16* src = F.proj + colbase + lane; const int P0 = 64 * c;
    bf16 raw[64 + W - 1];
#pragma unroll
    for (int i = 0; i < 64 + W - 1; ++i) raw[i] = src[(size_t)(P0 - (W - 1) + i) * NPROJ];
#pragma unroll
    for (int sb = 0; sb < 4; ++sb) {
#pragma unroll
        for (int i = 0; i < 16; ++i) { const int q = 16 * sb + i; float s = 0.f;
#pragma unroll
            for (int j = 0; j < W; ++j) s += bf2f(raw[q + j]);
            F.ycat[(size_t)(P0 - 64 + q) * D + colbase + lane] = f2bf(s * (1.f / W) - bf2f(raw[q + W - 1])); }
    }
}
DI void e_dt_tile(Frame& F, int c) {
    const int P = 64 * c + F.lane;
    const v4u* src = (const v4u*)(F.proj + (size_t)P * NPROJ + C_DT);
    const v4u r0 = src[0], r1 = src[1];
    const unsigned w[8] = {r0.x, r0.y, r0.z, r0.w, r1.x, r1.y, r1.z, r1.w};
    float o[16];
#pragma unroll
    for (int i = 0; i < 8; ++i) { o[2 * i] = bf_lo(w[i]); o[2 * i + 1] = bf_hi(w[i]); }
#pragma unroll
    for (int h = 0; h < 16; ++h) { const float x = o[h] + F.dt_bias[h]; const float sp = fmaxf(x, 0.f) + log1pf(__expf(-fabsf(x))); o[h] = (P >= LEAD) ? sp : 0.f; }
    f32x4* dst = (f32x4*)(F.dtv + (size_t)P * 16);
#pragma unroll
    for (int q = 0; q < 4; ++q) dst[q] = (f32x4){o[4 * q], o[4 * q + 1], o[4 * q + 2], o[4 * q + 3]};
}
DI void p2_elem(Frame& F) {
    constexpr int NT = 129 * 41;
    for (int task = F.gw; task < NT; task += F.ngw) {
        const int c = task / 41, j = task % 41;
        if (j < 16) { if (c == 0) continue; const int g = j >> 2;
            if (g == 0) e_pool_tile<2>(F, c, 64 * j); else if (g == 1) e_pool_tile<4>(F, c, 64 * j); else if (g == 2) e_pool_tile<8>(F, c, 64 * j); else e_pool_tile<16>(F, c, 64 * j); }
        else if (j < 32) e_conv_tile(F, c, C_X + 64 * (j - 16), 64 * (j - 16), F.xT + (size_t)(64 * (j - 16)) * NP, nullptr, 0);
        else if (j < 36) e_conv_tile(F, c, C_B + 64 * (j - 32), 1024 + 64 * (j - 32), F.BT + (size_t)(64 * (j - 32)) * NP, F.Bc, 64 * (j - 32));
        else if (j < 40) e_conv_tile(F, c, C_C + 64 * (j - 36), 1280 + 64 * (j - 36), nullptr, F.Cc, 64 * (j - 36));
        else e_dt_tile(F, c);
    }
}

DI void p3_states(Frame& F) {
    const int lane = F.lane, r = lane & 31, hf = lane >> 5;
    LAS float* wsm = (LAS float*)(F.lds + F.wave * 256);
    for (int u = F.bid; u < 256; u += F.nwg) {
        const int c = u >> 1, g = u & 1, h = 8 * g + F.wave;
        const float A = -__expf(F.a_log[h]);
        const float dtl = F.dtv[(size_t)(64 * c + lane) * 16 + h];
        const float acs = wave_incl_scan(dtl * A, lane);
        const float tot = __shfl(acs, 63);
        wsm[lane] = dtl * __expf(tot - acs);
        if (lane == 0) F.decay[c * 16 + h] = __expf(tot);
        LDS_WAIT();
        f32x16 acc[2][4];
#pragma unroll
        for (int mt = 0; mt < 2; ++mt)
#pragma unroll
            for (int nt = 0; nt < 4; ++nt)
#pragma unroll
                for (int i = 0; i < 16; ++i) acc[mt][nt][i] = 0.f;
#pragma unroll
        for (int ks = 0; ks < 4; ++ks) {
            const f32x4 wa = *(const LAS f32x4*)(wsm + 16 * ks + 8 * hf), wb = *(const LAS f32x4*)(wsm + 16 * ks + 8 * hf + 4);
            bf16x8 af[2], bfr[4];
#pragma unroll
            for (int mt = 0; mt < 2; ++mt) {
                const v4u raw = *(const v4u*)(F.xT + (size_t)(h * 64 + 32 * mt + r) * NP + 64 * c + 16 * ks + 8 * hf);
                v4u sc; sc.x = pk2(bf_lo(raw.x) * wa.x, bf_hi(raw.x) * wa.y); sc.y = pk2(bf_lo(raw.y) * wa.z, bf_hi(raw.y) * wa.w);
                sc.z = pk2(bf_lo(raw.z) * wb.x, bf_hi(raw.z) * wb.y); sc.w = pk2(bf_lo(raw.w) * wb.z, bf_hi(raw.w) * wb.w);
                af[mt] = __builtin_bit_cast(bf16x8, sc);
            }
#pragma unroll
            for (int nt = 0; nt < 4; ++nt) bfr[nt] = *(const bf16x8*)(F.BT + (size_t)(g * 128 + 32 * nt + r) * NP + 64 * c + 16 * ks + 8 * hf);
#pragma unroll
            for (int mt = 0; mt < 2; ++mt)
#pragma unroll
                for (int nt = 0; nt < 4; ++nt) acc[mt][nt] = MFMA32(af[mt], bfr[nt], acc[mt][nt]);
        }
        bf16* st = F.states + ((size_t)(c * 16 + h) * 64) * 128;
#pragma unroll
        for (int mt = 0; mt < 2; ++mt)
#pragma unroll
            for (int nt = 0; nt < 4; ++nt)
#pragma unroll
                for (int i = 0; i < 16; ++i) st[(32 * mt + crow16(i, hf)) * 128 + 32 * nt + r] = f2bf(acc[mt][nt][i]);
        LDS_WAIT();
    }
}
DI void p4_scan(Frame& F) {
    const unsigned* st2 = (const unsigned*)F.states; unsigned* pv2 = (unsigned*)F.prev;
    for (int e = F.bid * 512 + F.tid; e < 65536; e += F.nwg * 512) {
        const int h = e >> 12; float c0v = 0.f, c1v = 0.f;
        for (int c0 = 0; c0 < 128; c0 += 16) {
            unsigned s[16]; float dc[16];
#pragma unroll
            for (int i = 0; i < 16; ++i) { s[i] = st2[(size_t)(c0 + i) * 65536 + e]; dc[i] = F.decay[(c0 + i) * 16 + h]; }
#pragma unroll
            for (int i = 0; i < 16; ++i) { c0v = c0v * dc[i] + bf_lo(s[i]); c1v = c1v * dc[i] + bf_hi(s[i]); pv2[(size_t)(c0 + i) * 65536 + e] = pk2(c0v, c1v); }
        }
    }
}
DI bf16x8 pack8(const f32x16& x, int s) {
    v4u p; p.x = pk2(x[8 * s], x[8 * s + 1]); p.y = pk2(x[8 * s + 2], x[8 * s + 3]); p.z = pk2(x[8 * s + 4], x[8 * s + 5]); p.w = pk2(x[8 * s + 6], x[8 * s + 7]);
    return __builtin_bit_cast(bf16x8, p);
}
DI void p5_out(Frame& F) {
    const int lane = F.lane, r = lane & 31, hf = lane >> 5;
    LAS float* acs_s = (LAS float*)(F.lds + F.wave * 512);
    LAS float* dt_s = acs_s + 64;
    LAS float* red = (LAS float*)(F.lds + 8192);
    for (int u = F.bid; u < 256; u += F.nwg) {
        const int c = 1 + (u >> 1), g = u & 1, h = 8 * g + F.wave;
        const float A = -__expf(F.a_log[h]), Dh = F.d_skip[h];
        const float dtl = F.dtv[(size_t)(64 * c + lane) * 16 + h];
        const float acs = wave_incl_scan(dtl * A, lane);
        acs_s[lane] = acs; dt_s[lane] = dtl;
        float acs_l[2]; acs_l[0] = __shfl(acs, r); acs_l[1] = __shfl(acs, 32 + r);
        LDS_WAIT();
        f32x16 yT[2][2], sT[3];
#pragma unroll
        for (int i = 0; i < 16; ++i) { yT[0][0][i] = 0.f; yT[0][1][i] = 0.f; yT[1][0][i] = 0.f; yT[1][1][i] = 0.f; sT[0][i] = 0.f; sT[1][i] = 0.f; sT[2][i] = 0.f; }
        const bf16* prevp = F.prev + ((size_t)(c - 1) * 16 + h) * 8192;
#pragma unroll 2
        for (int ks = 0; ks < 8; ++ks) {
            bf16x8 cf[2], pf[2], bg[2];
#pragma unroll
            for (int t = 0; t < 2; ++t) {
                cf[t] = *(const bf16x8*)(F.Cc + (size_t)(64 * c + 32 * t + r) * 256 + g * 128 + 16 * ks + 8 * hf);
                bg[t] = *(const bf16x8*)(F.Bc + (size_t)(64 * c + 32 * t + r) * 256 + g * 128 + 16 * ks + 8 * hf);
                pf[t] = *(const bf16x8*)(prevp + (32 * t + r) * 128 + 16 * ks + 8 * hf);
            }
            yT[0][0] = MFMA32(pf[0], cf[0], yT[0][0]); yT[0][1] = MFMA32(pf[0], cf[1], yT[0][1]);
            yT[1][0] = MFMA32(pf[1], cf[0], yT[1][0]); yT[1][1] = MFMA32(pf[1], cf[1], yT[1][1]);
            sT[0] = MFMA32(bg[0], cf[0], sT[0]); sT[1] = MFMA32(bg[0], cf[1], sT[1]); sT[2] = MFMA32(bg[1], cf[1], sT[2]);
        }
        { const float e0 = __expf(acs_l[0]), e1 = __expf(acs_l[1]);
#pragma unroll
          for (int i = 0; i < 16; ++i) { yT[0][0][i] *= e0; yT[1][0][i] *= e0; yT[0][1][i] *= e1; yT[1][1][i] *= e1; } }
#pragma unroll
        for (int t = 0; t < 3; ++t) {
            const int st = (t == 2) ? 1 : 0, lt = (t == 0) ? 0 : 1;
            const int l = 32 * lt + r;
#pragma unroll
            for (int q = 0; q < 4; ++q) {
                const f32x4 a4 = *(const LAS f32x4*)(acs_s + 32 * st + 8 * q + 4 * hf), d4 = *(const LAS f32x4*)(dt_s + 32 * st + 8 * q + 4 * hf);
#pragma unroll
                for (int e = 0; e < 4; ++e) { const int s = 32 * st + 8 * q + 4 * hf + e;
                    float val = sT[t][4 * q + e] * __expf(acs_l[lt] - a4[e]) * d4[e];
                    val = (s <= l) ? val : 0.f; val = (s == l) ? val + Dh : val;
                    sT[t][4 * q + e] = val; }
            }
        }
#pragma unroll
        for (int st = 0; st < 2; ++st)
#pragma unroll
            for (int sp = 0; sp < 2; ++sp) {
                bf16x8 xa[2];
#pragma unroll
                for (int pt = 0; pt < 2; ++pt) { const bf16* xp = F.xT + (size_t)(h * 64 + 32 * pt + r) * NP + 64 * c + 32 * st + 16 * sp + 4 * hf;
                    const v2u lo = *(const v2u*)xp, hi = *(const v2u*)(xp + 8); v4u w; w.x = lo.x; w.y = lo.y; w.z = hi.x; w.w = hi.y; xa[pt] = __builtin_bit_cast(bf16x8, w); }
                if (st == 0) { const bf16x8 m0 = pack8(sT[0], sp), m1 = pack8(sT[1], sp);
                    yT[0][0] = MFMA32(xa[0], m0, yT[0][0]); yT[1][0] = MFMA32(xa[1], m0, yT[1][0]);
                    yT[0][1] = MFMA32(xa[0], m1, yT[0][1]); yT[1][1] = MFMA32(xa[1], m1, yT[1][1]);
                } else { const bf16x8 m2 = pack8(sT[2], sp);
                    yT[0][1] = MFMA32(xa[0], m2, yT[0][1]); yT[1][1] = MFMA32(xa[1], m2, yT[1][1]); }
            }
        float ss[2] = {0.f, 0.f};
#pragma unroll
        for (int pt = 0; pt < 2; ++pt)
#pragma unroll
            for (int lt = 0; lt < 2; ++lt) {
                const bf16* zp = F.proj + (size_t)(64 * c + 32 * lt + r) * NPROJ + C_Z + h * 64 + 32 * pt + 4 * hf;
#pragma unroll
                for (int q = 0; q < 4; ++q) { const v2u zw = *(const v2u*)(zp + 8 * q);
                    const float z0 = bf_lo(zw.x), z1 = bf_hi(zw.x), z2 = bf_lo(zw.y), z3 = bf_hi(zw.y);
                    float y0 = yT[pt][lt][4 * q] * silu_f(z0), y1 = yT[pt][lt][4 * q + 1] * silu_f(z1), y2 = yT[pt][lt][4 * q + 2] * silu_f(z2), y3 = yT[pt][lt][4 * q + 3] * silu_f(z3);
                    yT[pt][lt][4 * q] = y0; yT[pt][lt][4 * q + 1] = y1; yT[pt][lt][4 * q + 2] = y2; yT[pt][lt][4 * q + 3] = y3;
                    ss[lt] += (y0 * y0 + y1 * y1) + (y2 * y2 + y3 * y3); }
            }
        ss[0] += __shfl_xor(ss[0], 32); ss[1] += __shfl_xor(ss[1], 32);
        if (hf == 0) { red[F.wave * 64 + r] = ss[0]; red[F.wave * 64 + 32 + r] = ss[1]; }
        LDS_WAIT(); __syncthreads();
        float rstd[2];
#pragma unroll
        for (int lt = 0; lt < 2; ++lt) { float t = 0.f;
#pragma unroll
            for (int w = 0; w < 8; ++w) t += red[w * 64 + 32 * lt + r];
            rstd[lt] = rsqrtf(t * (1.f / 512.f) + EPS); }
#pragma unroll
        for (int pt = 0; pt < 2; ++pt)
#pragma unroll
            for (int lt = 0; lt < 2; ++lt) {
                bf16* op = F.ycat + (size_t)(64 * (c - 1) + 32 * lt + r) * D + 1024 + h * 64 + 32 * pt + 4 * hf;
                const float* gp = F.ssm_g + h * 64 + 32 * pt + 4 * hf;
#pragma unroll
                for (int q = 0; q < 4; ++q) { const f32x4 gg = *(const f32x4*)(gp + 8 * q); v2u w;
                    w.x = pk2(yT[pt][lt][4 * q] * rstd[lt] * gg.x, yT[pt][lt][4 * q + 1] * rstd[lt] * gg.y);
                    w.y = pk2(yT[pt][lt][4 * q + 2] * rstd[lt] * gg.z, yT[pt][lt][4 * q + 3] * rstd[lt] * gg.w);
                    *(v2u*)(op + 8 * q) = w; }
            }
        __syncthreads();
    }
}

DI void p7_router(Frame& F) {
    LAS float* rs = (LAS float*)F.lds;
    LAS float* part = rs + 64;
    LAS float* lg = part + 8 * 1024;
    LAS int* hist = (LAS int*)(lg + 32 * 33 + 8);
    const int lane = F.lane, wave = F.wave;
    for (int blk = F.bid; blk < 256; blk += F.nwg) {
        const int r0 = 32 * blk;
        {
            const f32x4* gr = (const f32x4*)F.g2 + lane;
            f32x4 v[4][8];
#pragma unroll
            for (int i = 0; i < 4; ++i) { const v2u* xr = (const v2u*)(F.h2 + (size_t)(r0 + 4 * wave + i) * D) + lane;
#pragma unroll
                for (int j = 0; j < 8; ++j) { const v2u w = xr[64 * j]; v[i][j] = (f32x4){bf_lo(w.x), bf_hi(w.x), bf_lo(w.y), bf_hi(w.y)}; } }
            f32x4 g[8];
#pragma unroll
            for (int j = 0; j < 8; ++j) g[j] = gr[64 * j];
#pragma unroll
            for (int i = 0; i < 4; ++i) { const int rr = r0 + 4 * wave + i; float s = 0.f;
#pragma unroll
                for (int j = 0; j < 8; ++j) s += (v[i][j].x * v[i][j].x + v[i][j].y * v[i][j].y) + (v[i][j].z * v[i][j].z + v[i][j].w * v[i][j].w);
                const float rstd = rsqrtf(wave_sum(s) * (1.f / D) + EPS);
                unsigned long long* o8 = (unsigned long long*)(F.hn2 + (size_t)rr * D) + lane;
                unsigned* o4 = (unsigned*)((unsigned char*)F.hn2 + (size_t)rr * D) + lane;
#pragma unroll
                for (int j = 0; j < 8; ++j) {
                    if (MOE_F8) { const float q = rstd * X8_SCALE; o4[64 * j] = pk4_f8(v[i][j].x * q * g[j].x, v[i][j].y * q * g[j].y, v[i][j].z * q * g[j].z, v[i][j].w * q * g[j].w); }
                    else o8[64 * j] = (unsigned long long)pk2(v[i][j].x * rstd * g[j].x, v[i][j].y * rstd * g[j].y) | ((unsigned long long)pk2(v[i][j].z * rstd * g[j].z, v[i][j].w * rstd * g[j].w) << 32); }
                if (lane == 0) rs[4 * wave + i] = rstd; }
        }
        f32x16 acc;
#pragma unroll
        for (int i = 0; i < 16; ++i) acc[i] = 0.f;
        { const int ri = lane & 31, kh = lane >> 5;
          const bf16* arow = F.h2 + (size_t)(r0 + ri) * D + 256 * wave + 4 * kh;
          const float* wp = F.Wr + (size_t)(256 * wave + 4 * kh) * 32 + ri;
#pragma unroll 8
          for (int jj = 0; jj < 32; ++jj) {
              const v2u aw = *(const v2u*)(arow + 8 * jj); const f32x4 a = {bf_lo(aw.x), bf_hi(aw.x), bf_lo(aw.y), bf_hi(aw.y)};
              const float b0 = wp[(8 * jj) * 32], b1 = wp[(8 * jj + 1) * 32], b2 = wp[(8 * jj + 2) * 32], b3 = wp[(8 * jj + 3) * 32];
              acc = __builtin_amdgcn_mfma_f32_32x32x2f32(a.x, b0, acc, 0, 0, 0);
              acc = __builtin_amdgcn_mfma_f32_32x32x2f32(a.y, b1, acc, 0, 0, 0);
              acc = __builtin_amdgcn_mfma_f32_32x32x2f32(a.z, b2, acc, 0, 0, 0);
              acc = __builtin_amdgcn_mfma_f32_32x32x2f32(a.w, b3, acc, 0, 0, 0);
          }
#pragma unroll
          for (int i = 0; i < 16; ++i) part[wave * 1024 + crow16(i, kh) * 32 + ri] = acc[i];
        }
        if (F.tid < 32) hist[F.tid] = 0;
        LDS_WAIT(); __syncthreads();
        for (int idx = F.tid; idx < 1024; idx += 512) { float s = 0.f;
#pragma unroll
            for (int w = 0; w < 8; ++w) s += part[w * 1024 + idx];
            lg[(idx >> 5) * 33 + (idx & 31)] = s * rs[idx >> 5] + F.router_b[idx & 31]; }
        LDS_WAIT(); __syncthreads();
        if (F.tid < 32) {
            const int i = F.tid; float tv[4]; int te[4];
#pragma unroll
            for (int k = 0; k < 4; ++k) { float best = -3.0e38f; int be = 0;
                for (int e = 0; e < 32; ++e) { const float x = lg[i * 33 + e]; if (x > best) { best = x; be = e; } }
                tv[k] = best; te[k] = be; lg[i * 33 + be] = -3.4e38f; }
            const float e1 = __expf(tv[1] - tv[0]), e2 = __expf(tv[2] - tv[0]), e3 = __expf(tv[3] - tv[0]);
            const float inv = 1.f / (1.f + e1 + e2 + e3);
            *(f32x4*)(F.tkg + (size_t)(r0 + i) * 4) = (f32x4){inv, e1 * inv, e2 * inv, e3 * inv};
            int* tk = F.tke + (size_t)(r0 + i) * 4; tk[0] = te[0]; tk[1] = te[1]; tk[2] = te[2]; tk[3] = te[3];
#pragma unroll
            for (int k = 0; k < 4; ++k) __hip_atomic_fetch_add(hist + te[k], 1, __ATOMIC_RELAXED, __HIP_MEMORY_SCOPE_WORKGROUP);
        }
        LDS_WAIT(); __syncthreads();
        if (F.tid < 32) F.cnt[blk * 32 + F.tid] = hist[F.tid];
        __syncthreads();
    }
}
DI void p8_route(Frame& F) {
    LAS int* tot = (LAS int*)F.lds; LAS int* pre = tot + 32; LAS int* base = tot + 64; LAS int* posl = tot + 128; LAS int* tkl = tot + 256; LAS int* ptot = tot + 512; LAS int* ppre = ptot + 512;
    for (int blk = F.bid; blk < 256; blk += F.nwg) {
        const int r0 = 32 * blk;
        { const int e = F.tid & 31, wq = F.tid >> 5; int t = 0, p = 0;
#pragma unroll
          for (int i = 0; i < 16; ++i) { const int w = wq + 16 * i; const int v = F.cnt[w * 32 + e]; p += (w < blk) ? v : 0; t += v; }
          ptot[wq * 32 + e] = t; ppre[wq * 32 + e] = p; }
        if (F.tid < 128) tkl[F.tid] = F.tke[(size_t)r0 * 4 + F.tid];
        LDS_WAIT(); __syncthreads();
        if (F.tid < 32) { int t = 0, p = 0;
#pragma unroll
            for (int i = 0; i < 16; ++i) { t += ptot[i * 32 + F.tid]; p += ppre[i * 32 + F.tid]; }
            tot[F.tid] = t; pre[F.tid] = p; }
        LDS_WAIT(); __syncthreads();
        if (F.tid < 32) { int accp = 0; for (int e = 0; e < F.tid; ++e) accp += ((tot[e] + 255) >> 8) << 8; base[F.tid] = accp; }
        if (blk == 0 && F.tid == 64) { int nt = 0;
            for (int e = 0; e < 32; ++e) { const int tiles = (tot[e] + 255) >> 8; for (int j = 0; j < tiles; ++j) F.tile[nt + j] = e; nt += tiles; }
            F.tile[255] = nt; }
        LDS_WAIT(); __syncthreads();
        if (F.tid < 128) { const int e = tkl[F.tid]; int q = 0; for (int j = 0; j < F.tid; ++j) q += (tkl[j] == e) ? 1 : 0;
            const int p = base[e] + pre[e] + q; posl[F.tid] = p; F.pos[(size_t)r0 * 4 + F.tid] = p; }
        LDS_WAIT(); __syncthreads();
        if (F.tid < 128) ((int*)F.xs)[posl[F.tid]] = r0 + (F.tid >> 2);
        if (blk == 0 && F.tid < 32) { const int e = F.tid, lo_ = base[e] + tot[e], hi_ = base[e] + (((tot[e] + 255) >> 8) << 8); for (int q = lo_; q < hi_; ++q) ((int*)F.xs)[q] = 0; }
        __syncthreads();
    }
}
DI void p11_final(Frame& F) {
    const int lane = F.lane;
    for (int rr = F.gw; rr < SEQ; rr += F.ngw) {
        const int* pp = F.pos + (size_t)rr * 4; const f32x4 gt = *(const f32x4*)(F.tkg + (size_t)rr * 4);
        const float gk[4] = {gt.x, gt.y, gt.z, gt.w};
        const v2u* xr = (const v2u*)(F.h2 + (size_t)rr * D) + lane;
        f32x4 v[8];
#pragma unroll
        for (int j = 0; j < 8; ++j) { const v2u w = xr[64 * j]; v[j] = (f32x4){bf_lo(w.x), bf_hi(w.x), bf_lo(w.y), bf_hi(w.y)}; }
#pragma unroll
        for (int k = 0; k < 4; ++k) { const int* orow = (const int*)((const unsigned char*)F.obuf + (size_t)pp[k] * D) + lane; const float gq = gk[k] * (1.f / O8_SCALE);
#pragma unroll
            for (int j = 0; j < 8; ++j) { const int w = orow[64 * j];
                v[j].x += gq * __builtin_amdgcn_cvt_f32_fp8(w, 0); v[j].y += gq * __builtin_amdgcn_cvt_f32_fp8(w, 1); v[j].z += gq * __builtin_amdgcn_cvt_f32_fp8(w, 2); v[j].w += gq * __builtin_amdgcn_cvt_f32_fp8(w, 3); } }
        float s = 0.f;
#pragma unroll
        for (int j = 0; j < 8; ++j) s += (v[j].x * v[j].x + v[j].y * v[j].y) + (v[j].z * v[j].z + v[j].w * v[j].w);
        const float rstd = rsqrtf(wave_sum(s) * (1.f / D) + EPS);
        const f32x4* gr = (const f32x4*)F.final_g + lane; f32x4* op = (f32x4*)(F.out + (size_t)rr * D) + lane;
#pragma unroll
        for (int j = 0; j < 8; ++j) { const f32x4 g = gr[64 * j]; __builtin_nontemporal_store((f32x4){v[j].x * rstd * g.x, v[j].y * rstd * g.y, v[j].z * rstd * g.z, v[j].w * rstd * g.w}, &op[64 * j]); }
    }
}

using pg8::Unit; using pg8::HALF; using pg8::BM;
struct EpiProj {
    static constexpr bool PERM = true, AFTER_DRAIN = false;
    bf16* O;
    DI void operator()(const f32x4 (&acc)[2][2][4][2], const Unit& u, int wr, int wc, int fr, int fq) const {
        const int row0 = u.pm * BM + wr * 64 + fr, col0 = u.pn * BM + wc * 32 + 8 * fq;
#pragma unroll
        for (int ai = 0; ai < 2; ++ai)
#pragma unroll
            for (int m = 0; m < 4; ++m) { bf16* rowp = O + (size_t)(row0 + ai * HALF + m * 16) * NPROJ + col0;
#pragma unroll
                for (int bj = 0; bj < 2; ++bj) { const f32x4 v0 = acc[ai][bj][m][0], v1 = acc[ai][bj][m][1];
                    v4u w; w.x = pk2(v0[0], v0[1]); w.y = pk2(v0[2], v0[3]); w.z = pk2(v1[0], v1[1]); w.w = pk2(v1[2], v1[3]);
                    *(v4u*)(rowp + bj * HALF) = w; } }
    }
};
struct EpiH2 {
    static constexpr bool PERM = true, AFTER_DRAIN = false;
    const float* X; bf16* H;
    DI void operator()(const f32x4 (&acc)[2][2][4][2], const Unit& u, int wr, int wc, int fr, int fq) const {
        const int row0 = u.pm * BM + wr * 64 + fr, col0 = u.pn * BM + wc * 32 + 8 * fq;
#pragma unroll
        for (int ai = 0; ai < 2; ++ai)
#pragma unroll
            for (int m = 0; m < 4; ++m) { const size_t off = (size_t)(row0 + ai * HALF + m * 16) * D + col0;
#pragma unroll
                for (int bj = 0; bj < 2; ++bj) { const f32x4 x0 = *(const f32x4*)(X + off + bj * HALF), x1 = *(const f32x4*)(X + off + bj * HALF + 4);
                    const f32x4 v0 = acc[ai][bj][m][0] + x0, v1 = acc[ai][bj][m][1] + x1;
                    v4u w; w.x = pk2(v0[0], v0[1]); w.y = pk2(v0[2], v0[3]); w.z = pk2(v1[0], v1[1]); w.w = pk2(v1[2], v1[3]);
                    *(v4u*)(H + off + bj * HALF) = w; } }
    }
};
DI float swiglu(float g, float u) {
    g = fminf(g, 7.f); u = fminf(fmaxf(u, -7.f), 7.f);
    return (u + 1.f) * g * __builtin_amdgcn_rcpf(1.f + __expf(-1.702f * g));
}
DI f32x4 swiglu4(f32x4 g, f32x4 u, const float S) {
#pragma unroll
    for (int i = 0; i < 4; ++i) { g[i] = fminf(g[i], 7.f); u[i] = fminf(fmaxf(u[i], -7.f), 7.f); }
    const f32x4 t = g * (-1.702f * 1.4426950408889634f);
    f32x4 d;
#pragma unroll
    for (int i = 0; i < 4; ++i) d[i] = __builtin_amdgcn_exp2f(t[i]);
    d = d + 1.f;
#pragma unroll
    for (int i = 0; i < 4; ++i) d[i] = __builtin_amdgcn_rcpf(d[i]);
    return (u * S + S) * g * d;
}
struct EpiGU {
    static constexpr bool PERM = true, AFTER_DRAIN = false;
    bf16* O; const float* bgate; const float* bup;
    DI void operator()(const f32x4 (&acc)[2][2][4][2], const Unit& u, int wr, int wc, int fr, int fq) const {
        const int e = u.pn >> 4, pnl = u.pn & 15;
        const int row0 = u.pm * BM + wr * 64 + fr, colb = 128 * pnl + wc * 32 + 8 * fq;
        f32x4 bg[2], bu[2];
#pragma unroll
        for (int n = 0; n < 2; ++n) { bg[n] = *(const f32x4*)(bgate + e * D + colb + 4 * n); bu[n] = *(const f32x4*)(bup + e * D + colb + 4 * n); }
#pragma unroll
        for (int ai = 0; ai < 2; ++ai)
#pragma unroll
            for (int m = 0; m < 4; ++m) { bf16* rowp = O + (size_t)(row0 + ai * HALF + m * 16) * D + colb;
                const f32x4 g0 = acc[ai][0][m][0] + bg[0], g1 = acc[ai][0][m][1] + bg[1], u0 = acc[ai][1][m][0] + bu[0], u1 = acc[ai][1][m][1] + bu[1];
                v4u w; w.x = pk2(swiglu(g0[0], u0[0]), swiglu(g0[1], u0[1])); w.y = pk2(swiglu(g0[2], u0[2]), swiglu(g0[3], u0[3]));
                w.z = pk2(swiglu(g1[0], u1[0]), swiglu(g1[1], u1[1])); w.w = pk2(swiglu(g1[2], u1[2]), swiglu(g1[3], u1[3]));
                *(v4u*)rowp = w; }
    }
};
struct EpiDown {
    static constexpr bool PERM = true, AFTER_DRAIN = false;
    bf16* O; const float* bias;
    DI void operator()(const f32x4 (&acc)[2][2][4][2], const Unit& u, int wr, int wc, int fr, int fq) const {
        const int e = u.pn >> 3, pnl = u.pn & 7;
        const int row0 = u.pm * BM + wr * 64 + fr, col0 = 256 * pnl + wc * 32 + 8 * fq;
        f32x4 bv[2][2];
#pragma unroll
        for (int bj = 0; bj < 2; ++bj)
#pragma unroll
            for (int n = 0; n < 2; ++n) bv[bj][n] = *(const f32x4*)(bias + e * D + col0 + bj * HALF + 4 * n);
#pragma unroll
        for (int ai = 0; ai < 2; ++ai)
#pragma unroll
            for (int m = 0; m < 4; ++m) { bf16* rowp = O + (size_t)(row0 + ai * HALF + m * 16) * D + col0;
#pragma unroll
                for (int bj = 0; bj < 2; ++bj) { const f32x4 v0 = acc[ai][bj][m][0] + bv[bj][0], v1 = acc[ai][bj][m][1] + bv[bj][1];
                    v4u w; w.x = pk2(v0[0], v0[1]); w.y = pk2(v0[2], v0[3]); w.z = pk2(v1[0], v1[1]); w.w = pk2(v1[2], v1[3]);
                    *(v4u*)(rowp + bj * HALF) = w; } }
    }
};
struct EpiGU8 {
    static constexpr bool PERM = true, AFTER_DRAIN = false;
    unsigned char* O; const float* bgate; const float* bup;
    DI void operator()(const f32x4 (&acc)[2][2][4][2], const Unit& u, int wr, int wc, int fr, int fq) const {
        const int e = u.pn >> 4, pnl = u.pn & 15;
        const int row0 = u.pm * BM + wr * 64 + fr, colb = 128 * pnl + wc * 32 + 8 * fq;
        constexpr float DQ = 1.f / (W8_SCALE * X8_SCALE);
        f32x4 bg[2], bu[2];
#pragma unroll
        for (int n = 0; n < 2; ++n) { bg[n] = *(const f32x4*)(bgate + e * D + colb + 4 * n); bu[n] = *(const f32x4*)(bup + e * D + colb + 4 * n); }
#pragma unroll
        for (int ai = 0; ai < 2; ++ai)
#pragma unroll
            for (int m = 0; m < 4; ++m) { unsigned char* rowp = O + (size_t)(row0 + ai * HALF + m * 16) * D + colb;
                const f32x4 g0 = acc[ai][0][m][0] * DQ + bg[0], g1 = acc[ai][0][m][1] * DQ + bg[1], u0 = acc[ai][1][m][0] * DQ + bu[0], u1 = acc[ai][1][m][1] * DQ + bu[1];
                const f32x4 a0 = swiglu4(g0, u0, A8_SCALE), a1 = swiglu4(g1, u1, A8_SCALE);
                v2u w; w.x = pk4_f8(a0[0], a0[1], a0[2], a0[3]); w.y = pk4_f8(a1[0], a1[1], a1[2], a1[3]);
                *(v2u*)rowp = w; }
    }
};
struct EpiDown8 {
    static constexpr bool PERM = true, AFTER_DRAIN = false;
    unsigned char* O; const float* bias;
    DI void operator()(const f32x4 (&acc)[2][2][4][2], const Unit& u, int wr, int wc, int fr, int fq) const {
        const int e = u.pn >> 3, pnl = u.pn & 7;
        const int row0 = u.pm * BM + wr * 64 + fr, col0 = 256 * pnl + wc * 32 + 8 * fq;
        constexpr float DQ = O8_SCALE / (W8_SCALE * A8_SCALE);
        f32x4 bv[2][2];
#pragma unroll
        for (int bj = 0; bj < 2; ++bj)
#pragma unroll
            for (int n = 0; n < 2; ++n) bv[bj][n] = *(const f32x4*)(bias + e * D + col0 + bj * HALF + 4 * n) * O8_SCALE;
#pragma unroll
        for (int ai = 0; ai < 2; ++ai)
#pragma unroll
            for (int m = 0; m < 4; ++m) { unsigned char* rowp = O + (size_t)(row0 + ai * HALF + m * 16) * D + col0;
#pragma unroll
                for (int bj = 0; bj < 2; ++bj) { const f32x4 v0 = acc[ai][bj][m][0] * DQ + bv[bj][0], v1 = acc[ai][bj][m][1] * DQ + bv[bj][1];
                    v2u w; w.x = pk4_f8(v0[0], v0[1], v0[2], v0[3]); w.y = pk4_f8(v1[0], v1[1], v1[2], v1[3]);
                    *(v2u*)(rowp + bj * HALF) = w; } }
    }
};
struct MoeOrder {
    const LAS int* tile_e; const int* rowtok = nullptr;
    int nM, nN, nwg, G, c;
    DI void init(const LAS int* te, int ntiles, int nN_, int G_, int c_) { tile_e = te; nM = ntiles; nN = nN_; nwg = nM * nN; G = G_; c = c_; }
    DI bool next(int i, Unit& u) const {
        const int L = i * G + c; if (L >= nwg) return false;
        int wgid = L; { const int q = nwg / pg8::NXCD, r = nwg % pg8::NXCD, xcd = wgid % pg8::NXCD, off = wgid / pg8::NXCD; wgid = (xcd < r ? xcd * (q + 1) : r * (q + 1) + (xcd - r) * q) + off; }
        const int nig = pg8::WGM * nN, gid = wgid / nig, fm = gid * pg8::WGM, gsz = (nM - fm) < pg8::WGM ? (nM - fm) : pg8::WGM;
        u.pm = fm + ((wgid % nig) % gsz); const int pnl = (wgid % nig) / gsz;
        u.pn = __builtin_amdgcn_readfirstlane(tile_e[u.pm]) * nN + pnl; return true;
    }
    DI void a_ready(const Unit&) const {}
    DI void done(const Unit&) const {}
};


#if MOE_RB
#define MFMA16(a, b, c) __builtin_amdgcn_mfma_f32_16x16x32_bf16((a), (b), (c), 0, 0, 0)
template <class Epi, class Sched>
DI void gemm_rb(LAS unsigned char* lds, const bf16* A, const Sched& S, const Epi& E) {
    constexpr int K = D, NT = K / 64;
    const int tid = threadIdx.x, wave = __builtin_amdgcn_readfirstlane(tid >> 6), lane = tid & 63, fr = lane & 15, fq = lane >> 4;
    unsigned voffA[2];
#pragma unroll
    for (int i = 0; i < 2; ++i) { int R, C; pg8::stage_rc(tid * 16 + i * 8192, R, C); voffA[i] = (unsigned)(R * K + C) * 2u; }
    const unsigned ldsw = (unsigned)wave * 1024u;
    const int aoff = pg8::lds_byte(fr, fq * 8);
    const unsigned boff = (unsigned)((8 * fq) * K + fr) * 4u;
    Unit u;
    for (int ui = 0; S.next(ui, u); ++ui) {
        const char* cA = (const char*)A + (size_t)u.pm * 256 * K * 2;
        const float *b0, *b1; E.bsrc(u, wave, b0, b1);
        const char* pb0 = (const char*)b0 + boff; const char* pb1 = (const char*)b1 + boff;
        f32x4 acc[16][2];
#pragma unroll
        for (int m = 0; m < 16; ++m) { acc[m][0] = (f32x4){0.f, 0.f, 0.f, 0.f}; acc[m][1] = (f32x4){0.f, 0.f, 0.f, 0.f}; }
        float rb[4][16];
#define RB_DMA(t) do { const int tt_ = (t) < NT ? (t) : NT - 1; const unsigned bo_ = (unsigned)(((t) % 3) * 32768); \
        _Pragma("unroll") for (int h_ = 0; h_ < 2; ++h_) _Pragma("unroll") for (int i_ = 0; i_ < 2; ++i_) \
            __builtin_amdgcn_global_load_lds((const unsigned*)(cA + (size_t)h_ * 128 * K * 2 + (size_t)tt_ * 128 + voffA[i_]), (LAS unsigned*)(lds + bo_ + h_ * 16384 + ldsw + i_ * 8192), 16, 0, 0); } while (0)
#define RB_ISSUE(slot, hs) do { const int he_ = (hs) < 2 * NT ? (hs) : 2 * NT - 1; const char* s0_ = pb0 + (size_t)he_ * 32 * K * 4; const char* s1_ = pb1 + (size_t)he_ * 32 * K * 4; \
        _Pragma("unroll") for (int j_ = 0; j_ < 8; ++j_) { \
            asm volatile("global_load_dword %0, %1, off" : "=v"(rb[slot][j_]) : "v"(s0_ + (size_t)j_ * K * 4) : "memory"); \
            asm volatile("global_load_dword %0, %1, off" : "=v"(rb[slot][8 + j_]) : "v"(s1_ + (size_t)j_ * K * 4) : "memory"); } } while (0)
#define RB_WAITB(slot) asm volatile("s_waitcnt vmcnt(52)" : "+v"(rb[slot][0]), "+v"(rb[slot][1]), "+v"(rb[slot][2]), "+v"(rb[slot][3]), "+v"(rb[slot][4]), "+v"(rb[slot][5]), "+v"(rb[slot][6]), "+v"(rb[slot][7]), \
        "+v"(rb[slot][8]), "+v"(rb[slot][9]), "+v"(rb[slot][10]), "+v"(rb[slot][11]), "+v"(rb[slot][12]), "+v"(rb[slot][13]), "+v"(rb[slot][14]), "+v"(rb[slot][15]) :: "memory")
#define RB_COMPUTE(bufo, ks, slot) do { v4u p0_, p1_; \
        p0_.x = pk2(rb[slot][0], rb[slot][1]); p0_.y = pk2(rb[slot][2], rb[slot][3]); p0_.z = pk2(rb[slot][4], rb[slot][5]); p0_.w = pk2(rb[slot][6], rb[slot][7]); \
        p1_.x = pk2(rb[slot][8], rb[slot][9]); p1_.y = pk2(rb[slot][10], rb[slot][11]); p1_.z = pk2(rb[slot][12], rb[slot][13]); p1_.w = pk2(rb[slot][14], rb[slot][15]); \
        const bf16x8 bf0_ = __builtin_bit_cast(bf16x8, p0_), bf1_ = __builtin_bit_cast(bf16x8, p1_); \
        _Pragma("unroll") for (int mg_ = 0; mg_ < 4; ++mg_) { bf16x8 a_[4]; \
            _Pragma("unroll") for (int q_ = 0; q_ < 4; ++q_) { const int m_ = 4 * mg_ + q_; a_[q_] = *(const LAS bf16x8*)(lds + (bufo) + (m_ >> 3) * 16384 + (m_ & 7) * 2048 + (ks) * 1024 + aoff); } \
            _Pragma("unroll") for (int q_ = 0; q_ < 4; ++q_) { const int m_ = 4 * mg_ + q_; acc[m_][0] = MFMA16(bf0_, a_[q_], acc[m_][0]); acc[m_][1] = MFMA16(bf1_, a_[q_], acc[m_][1]); } \
            __builtin_amdgcn_sched_barrier(0); } } while (0)
        RB_DMA(0); RB_DMA(1);
        RB_ISSUE(0, 0); RB_ISSUE(1, 1); RB_ISSUE(2, 2);
        int bi = 0;
#pragma unroll 1
        for (int t = 0; t < NT; t += 2) {
            const int bo0 = bi * 32768, bi1 = (bi == 2) ? 0 : bi + 1, bo1 = bi1 * 32768;
            asm volatile("s_waitcnt vmcnt(36)" ::: "memory"); __builtin_amdgcn_s_barrier(); asm volatile("" ::: "memory");
            RB_DMA(t + 2);
            RB_ISSUE(3, 2 * t + 3); RB_WAITB(0); RB_COMPUTE(bo0, 0, 0);
            RB_ISSUE(0, 2 * t + 4); RB_WAITB(1); RB_COMPUTE(bo0, 1, 1);
            asm volatile("s_waitcnt vmcnt(36)" ::: "memory"); __builtin_amdgcn_s_barrier(); asm volatile("" ::: "memory");
            RB_DMA(t + 3);
            RB_ISSUE(1, 2 * t + 5); RB_WAITB(2); RB_COMPUTE(bo1, 0, 2);
            RB_ISSUE(2, 2 * t + 6); RB_WAITB(3); RB_COMPUTE(bo1, 1, 3);
            bi = (bi1 == 2) ? 0 : bi1 + 1;
        }
#define RB_KEEP(slot, str) asm volatile(str : "+v"(rb[slot][0]), "+v"(rb[slot][1]), "+v"(rb[slot][2]), "+v"(rb[slot][3]), "+v"(rb[slot][4]), "+v"(rb[slot][5]), "+v"(rb[slot][6]), "+v"(rb[slot][7]), \
        "+v"(rb[slot][8]), "+v"(rb[slot][9]), "+v"(rb[slot][10]), "+v"(rb[slot][11]), "+v"(rb[slot][12]), "+v"(rb[slot][13]), "+v"(rb[slot][14]), "+v"(rb[slot][15]) :: "memory")
        RB_KEEP(0, "s_waitcnt vmcnt(0)"); RB_KEEP(1, ""); RB_KEEP(2, ""); RB_KEEP(3, "");
#undef RB_KEEP
        E(acc, u, wave, fr, fq);
        asm volatile("s_waitcnt vmcnt(0)" ::: "memory"); __builtin_amdgcn_s_barrier(); asm volatile("" ::: "memory");
#undef RB_DMA
#undef RB_ISSUE
#undef RB_WAITB
#undef RB_COMPUTE
    }
}
struct EpiGU2 {
    bf16* O; const float *wg, *wu, *bgate, *bup;
    DI void bsrc(const Unit& u, int wave, const float*& b0, const float*& b1) const {
        const int e = u.pn >> 4, pnl = u.pn & 15; const size_t o = (size_t)e * D * D + 128 * pnl + 16 * wave; b0 = wg + o; b1 = wu + o; }
    DI void operator()(const f32x4 (&acc)[16][2], const Unit& u, int wave, int fr, int fq) const {
        const int e = u.pn >> 4, pnl = u.pn & 15, col = 128 * pnl + 16 * wave + 4 * fq;
        const f32x4 bg = *(const f32x4*)(bgate + e * D + col), bu = *(const f32x4*)(bup + e * D + col);
        bf16* op = O + (size_t)(u.pm * 256 + fr) * D + col;
#pragma unroll
        for (int m = 0; m < 16; ++m) { const f32x4 g = acc[m][0] + bg, uu = acc[m][1] + bu; v2u w;
            w.x = pk2(swiglu(g[0], uu[0]), swiglu(g[1], uu[1])); w.y = pk2(swiglu(g[2], uu[2]), swiglu(g[3], uu[3]));
            *(v2u*)(op + (size_t)(16 * m) * D) = w; }
    }
};
struct EpiDown2 {
    bf16* O; const float *wd, *bias;
    DI void bsrc(const Unit& u, int wave, const float*& b0, const float*& b1) const {
        const int e = u.pn >> 3, pnl = u.pn & 7; b0 = wd + (size_t)e * D * D + 256 * pnl + 32 * wave; b1 = b0 + 16; }
    DI void operator()(const f32x4 (&acc)[16][2], const Unit& u, int wave, int fr, int fq) const {
        const int e = u.pn >> 3, pnl = u.pn & 7, col = 256 * pnl + 32 * wave + 4 * fq;
        const f32x4 v0 = *(const f32x4*)(bias + e * D + col), v1 = *(const f32x4*)(bias + e * D + col + 16);
        bf16* op = O + (size_t)(u.pm * 256 + fr) * D + col;
#pragma unroll
        for (int m = 0; m < 16; ++m) { const f32x4 a = acc[m][0] + v0, b = acc[m][1] + v1; v2u w0, w1;
            w0.x = pk2(a[0], a[1]); w0.y = pk2(a[2], a[3]); w1.x = pk2(b[0], b[1]); w1.y = pk2(b[2], b[3]);
            *(v2u*)(op + (size_t)(16 * m) * D) = w0; *(v2u*)(op + (size_t)(16 * m) * D + 16) = w1; }
    }
};

#endif
struct Args { const float* in[23]; float* out; unsigned char* ws; int ph_lo, ph_hi; };
DI void fill_frame(Frame& F, const Args& args, LAS unsigned char* lds, const int bid, const int nwg) {
    F.lds = lds;
    int tz = threadIdx.x; asm volatile("" : "+v"(tz)); F.tid = tz;
    F.lane = F.tid & 63; F.wave = __builtin_amdgcn_readfirstlane(F.tid >> 6);
    F.bid = bid; F.nwg = nwg; F.gw = bid * NWAVES + F.wave; F.ngw = nwg * NWAVES;
    unsigned char* ws = args.ws;
    F.x = args.in[0]; F.meta = args.in[1]; F.g1 = args.in[2]; F.w_in = args.in[3]; F.pool_w = args.in[4]; F.pool_scale = args.in[5]; F.conv_w = args.in[6]; F.conv_b = args.in[7];
    F.dt_bias = args.in[8]; F.a_log = args.in[9]; F.d_skip = args.in[10]; F.ssm_g = args.in[11]; F.w_out = args.in[12]; F.g2 = args.in[13]; F.router_w = args.in[14]; F.router_b = args.in[15];
    F.w_gate = args.in[16]; F.b_gate = args.in[17]; F.w_up = args.in[18]; F.b_up = args.in[19]; F.w_down = args.in[20]; F.b_down = args.in[21]; F.final_g = args.in[22];
    F.out = args.out;
    F.hn = (bf16*)(ws + WS_HN); F.Bt1 = (bf16*)(ws + WS_BT1); F.Bt2 = (bf16*)(ws + WS_BT2); F.proj = (bf16*)(ws + WS_PROJ); F.xT = (bf16*)(ws + WS_XT); F.BT = (bf16*)(ws + WS_BTT);
    F.Bc = (bf16*)(ws + WS_BC); F.Cc = (bf16*)(ws + WS_CC); F.prev = (bf16*)(ws + WS_PREV); F.ycat = (bf16*)(ws + WS_YCAT); F.hn2 = (bf16*)(ws + WS_HN2); F.xs = (bf16*)(ws + WS_XS);
    F.abuf = (bf16*)(ws + WS_A); F.obuf = (bf16*)(ws + (MOE_F8 ? WS_O : WS_XS)); F.Btgu = (bf16*)(ws + WS_BTGU); F.Btd = (bf16*)(ws + WS_BTD);
    F.dtv = (float*)(ws + WS_DT); F.states = (bf16*)(ws + WS_ST); F.decay = (float*)(ws + WS_DEC); F.h2 = (bf16*)(ws + WS_H2); F.Wr = (float*)(ws + WS_WR); F.tkg = (float*)(ws + WS_TKG);
    F.tke = (int*)(ws + WS_TKE); F.pos = (int*)(ws + WS_POS); F.cnt = (int*)(ws + WS_CNT); F.tile = (int*)(ws + WS_TILE);

}
__global__ void __launch_bounds__(NWAVES * 64, 2) fwd(Args args) {
    extern __shared__ __attribute__((aligned(16))) unsigned char lds_raw[];
    LAS unsigned char* const lds_base = (LAS unsigned char*)lds_raw; unsigned char* ws = args.ws;
    volatile LAS unsigned* MISC = (volatile LAS unsigned*)(lds_base + MISC_OFF);
    if (threadIdx.x < 32) MISC[threadIdx.x] = 0u;
    __syncthreads();
    const int G = (int)gridDim.x, bx = (int)blockIdx.x;
    const bool worker = bx < WN;
    XcdBarrier barA = xcd_barrier_post((unsigned*)(ws + WS_CTL) + CW_BAR, MISC + 8, (unsigned)G);
    XcdBarrier barW; barW.bar = (unsigned*)(ws + WS_CTL) + CW_BAR2; barW.x = 0; barW.st = MISC + 12; barW.G = (unsigned)WN;
    if (worker) barW = xcd_barrier_post((unsigned*)(ws + WS_CTL) + CW_BAR2, MISC + 12, (unsigned)WN);

    { Frame F; fill_frame(F, args, lds_base, bx, G); p0_norm(F); p0_weff(F); p0_router_fold(F); p0_weights_range<false>(F, I_MOE, NITEMS); __syncthreads(); }
    xcd_barrier(barA);
    if (!worker) {
        Frame F; fill_frame(F, args, lds_base, bx - WN, G - WN); p0_weights_range<true>(F, 0, I_MOE); __syncthreads();
    } else {
        { Frame F; fill_frame(F, args, lds_base, bx, WN); pg8::Gemm g{F.hn, F.Bt1, MP, NPROJ, D}; pg8::StaticOrder S; S.init(MP, NPROJ, WN, bx);
          EpiProj E{F.proj}; pg8::gemm_phase<EpiProj, pg8::StaticOrder, true, true>(F.lds, g, S, E); }
        xcd_barrier(barW);
        { Frame F; fill_frame(F, args, lds_base, bx, WN); p2_elem(F); }
        xcd_barrier(barW);
        { Frame F; fill_frame(F, args, lds_base, bx, WN); p3_states(F); }
        xcd_barrier(barW);
        { Frame F; fill_frame(F, args, lds_base, bx, WN); p4_scan(F); }
        xcd_barrier(barW);
        { Frame F; fill_frame(F, args, lds_base, bx, WN); p5_out(F); }
        xcd_barrier(barW);
        { Frame F; fill_frame(F, args, lds_base, bx, WN); pg8::Gemm g{F.ycat, F.Bt2, SEQ, D, D}; pg8::StaticOrder S; S.init(SEQ, D, WN, bx);
          EpiH2 E{F.x, F.h2}; pg8::gemm_phase<EpiH2, pg8::StaticOrder, true, true>(F.lds, g, S, E); }
        xcd_barrier(barW);
        { Frame F; fill_frame(F, args, lds_base, bx, WN); p7_router(F); }
        xcd_barrier(barW);
        { Frame F; fill_frame(F, args, lds_base, bx, WN); p8_route(F); }
    }
    xcd_barrier(barA);
    { Frame F; fill_frame(F, args, lds_base, bx, G); LAS int* tl = (LAS int*)(lds_base + MISC_OFF + 1024);
      if (F.tid < 256) tl[F.tid] = F.tile[F.tid];
      LDS_WAIT(); __syncthreads();
      const int ntiles = __builtin_amdgcn_readfirstlane(tl[255]);
      MoeOrder S; S.init(tl, ntiles, 16, G, bx); S.rowtok = (const int*)F.xs;
      pg8::Gemm g{F.hn2, F.Btgu, SEQ, NE * 4096, D}; EpiGU8 E{(unsigned char*)F.abuf, F.b_gate, F.b_up}; pg8::gemm_phase<EpiGU8, MoeOrder, true, true, true, true>(F.lds, g, S, E); }
    xcd_barrier(barA);
    { Frame F; fill_frame(F, args, lds_base, bx, G); LAS int* tl = (LAS int*)(lds_base + MISC_OFF + 1024);
      if (F.tid < 256) tl[F.tid] = F.tile[F.tid];
      LDS_WAIT(); __syncthreads();
      const int ntiles = __builtin_amdgcn_readfirstlane(tl[255]);
      MoeOrder S; S.init(tl, ntiles, 8, G, bx);
      pg8::Gemm g{F.abuf, F.Btd, RPAD, NE * D, D}; EpiDown8 E{(unsigned char*)F.obuf, F.b_down}; pg8::gemm_phase<EpiDown8, MoeOrder, true, true, true>(F.lds, g, S, E); }
    xcd_barrier(barA);
    { Frame F; fill_frame(F, args, lds_base, bx, G); p11_final(F); }
}

extern "C" void kernel_launch(void* const* d_in, const int* in_sizes, int n_in, void* d_out, int out_size, void* d_ws, size_t ws_size, hipStream_t stream) {
    static int grid = 0;
    if (grid == 0) {
        if (n_in != 23 || out_size != SEQ * D || ws_size < WS_END) { fprintf(stderr, "kernel_launch: unexpected shapes (n_in %d out %d ws %zu need %zu)\n", n_in, out_size, ws_size, (size_t)WS_END); grid = -1; return; }
        int dev = 0, cus = 0, per_cu = 0;
        if (hipGetDevice(&dev) != hipSuccess || hipDeviceGetAttribute(&cus, hipDeviceAttributeMultiprocessorCount, dev) != hipSuccess) { grid = -1; return; }
        if (hipFuncSetAttribute((const void*)fwd, hipFuncAttributeMaxDynamicSharedMemorySize, LDS_BYTES) != hipSuccess) { fprintf(stderr, "kernel_launch: hipFuncSetAttribute failed\n"); grid = -1; return; }
        if (hipOccupancyMaxActiveBlocksPerMultiprocessor(&per_cu, (const void*)fwd, NWAVES * 64, LDS_BYTES) != hipSuccess || per_cu < 1) fprintf(stderr, "kernel_launch: occupancy query says %d\n", per_cu);
        (void)hipGetLastError();
        grid = 256;
        if (cus < 256) { fprintf(stderr, "kernel_launch: needs 256 CUs, device has %d\n", cus); grid = -1; return; }
    }
    if (grid < 0) return;
    Args a{};
    for (int i = 0; i < 23; ++i) a.in[i] = (const float*)d_in[i];
    a.out = (float*)d_out; a.ws = (unsigned char*)d_ws;
    (void)hipMemsetAsync((char*)d_ws + WS_CTL, 0, CTL_BYTES, stream);
    a.ph_lo = 0; a.ph_hi = NPH;
    hipLaunchKernelGGL(fwd, dim3(grid), dim3(NWAVES * 64), LDS_BYTES, stream, a);
}
```

```cpp
#include <hip/hip_runtime.h>
#include <cstdio>
#include <cstdint>
namespace pg8 {
#define PG8_LAS __attribute__((address_space(3)))
typedef unsigned short bf16_t;
typedef short bf16x8 __attribute__((ext_vector_type(8)));
typedef float f32x4 __attribute__((ext_vector_type(4)));
typedef unsigned u32x4 __attribute__((ext_vector_type(4)));
typedef int i32x8 __attribute__((ext_vector_type(8)));
constexpr int BM = 256, BK = 64, HALF = 128, HTB = HALF * BK * 2  , STAGE_BYTES = 8 * HTB, NXCD = 8, WGM = 8;

__host__ __device__ __forceinline__ int lds_byte(int r, int c) { const int st = (r >> 4) * 2 + (c >> 5), rr = r & 15, cc = c & 31, ob = rr * 64 + cc * 2; return st * 1024 + (ob ^ (((ob >> 9) & 1) << 5)); }
__host__ __device__ __forceinline__ void stage_rc(int b, int& R, int& C) { const int st = b / 1024, sb = b % 1024, swz = sb ^ (((sb >> 9) & 1) << 5); R = (st >> 1) * 16 + swz / 64; C = (st & 1) * 32 + (swz % 64) / 2; }
__host__ __device__ __forceinline__ int perm32(int rho) { const int n = rho >> 4, i = rho & 15; return 8 * (i >> 2) + 4 * n + (i & 3); }

struct Unit { int pm, pn; };
struct Gemm { const bf16_t* A; const bf16_t* Bt; int M, N, K; };

struct StaticOrder {
    int nM, nN, nwg, G, c;
    __host__ __device__ void init(int M, int N, int G_, int c_) { nM = M / BM; nN = N / BM; nwg = nM * nN; G = G_; c = c_; }
    __host__ __device__ bool next(int i, Unit& u) const {
        const long L = (long)i * G + c; if (L >= nwg) return false;
        int wgid = (int)L; { const int q = nwg / NXCD, r = nwg % NXCD, xcd = wgid % NXCD, off = wgid / NXCD; wgid = (xcd < r ? xcd * (q + 1) : r * (q + 1) + (xcd - r) * q) + off; }
        const int nig = WGM * nN, gid = wgid / nig, fm = gid * WGM, gsz = (nM - fm) < WGM ? (nM - fm) : WGM;
        u.pm = fm + ((wgid % nig) % gsz); u.pn = (wgid % nig) / gsz; return true;
    }
    __device__ __forceinline__ void a_ready(const Unit&) const {}
    __device__ __forceinline__ void done(const Unit&) const {}
};

__device__ __forceinline__ unsigned cvt_pk_bf16(float lo, float hi) { unsigned r; asm volatile("v_cvt_pk_bf16_f32 %0, %1, %2" : "=v"(r) : "v"(lo), "v"(hi)); return r; }
template <class Epi, class Sched, bool ALIGN_EPI = false, bool SP2 = false, bool F8 = false, bool GATHER = false>
__device__ __forceinline__ void gemm_phase(PG8_LAS unsigned char* lds, const Gemm g, const Sched& S, const Epi& E) {
    const int tid = threadIdx.x, wid = __builtin_amdgcn_readfirstlane(tid >> 6), lane = tid & 63, wr = wid >> 2, wc = wid & 3, fr = lane & 15, fq = lane >> 4;
    const int KB = F8 ? g.K : 2 * g.K  , nt = KB / 128;
    static_assert(!GATHER || (F8 && SP2), "the gather path exists in the fp8 two-super-phase loop only");
    unsigned voffA[2], voffB[2]; int gR[2]; unsigned gC[2];
    unsigned gA0[2], gA1[2], gN0[2], gN1[2]; int gT[4];
#pragma unroll
    for (int i = 0; i < 2; ++i) { int R, C; stage_rc(tid * 16 + i * 8192, R, C); const int Rb = Epi::PERM ? ((R & ~31) + perm32(R & 31)) : R;
        voffA[i] = (unsigned)(R * KB + C * 2); voffB[i] = (unsigned)(Rb * KB + C * 2); gR[i] = R; gC[i] = (unsigned)(C * 2); }
    const size_t kstep = (size_t)(BK * 2);
    const size_t hstep = (size_t)HALF * KB;
    const size_t tstep = 2 * hstep;
    const unsigned ldsw = (unsigned)wid * 1024u;
    const int aoff = lds_byte(wr * 64 + fr, F8 ? fq * 16 : fq * 8), boff = lds_byte(wc * 32 + fr, F8 ? fq * 16 : fq * 8);

#define PG8_SA(b, h) (((b) * 2 + (h)) * HTB)
#define PG8_SB(b, h) ((4 + (b) * 2 + (h)) * HTB)
#define PG8_STAGE(bufoff, gbase, voff) do { if constexpr (F8) { const char* gb_ = (const char*)(gbase); _Pragma("unroll") for (int _i = 0; _i < 2; ++_i) { \
        const unsigned la_ = (unsigned)(size_t)(lds + (bufoff) + ldsw + _i * 8192); \
        asm volatile("s_mov_b32 m0, %2\n\ts_nop 4\n\tglobal_load_lds_dwordx4 %0, %1" :: "v"((voff)[_i]), "s"(gb_), "s"(la_) : "memory", "m0"); } } else { \
        _Pragma("unroll") for (int _i = 0; _i < 2; ++_i) \
        __builtin_amdgcn_global_load_lds((const unsigned*)((const char*)(gbase) + (voff)[_i]), (PG8_LAS unsigned*)(lds + (bufoff) + ldsw + _i * 8192), 16, 0, 0); } } while (0)
#define PG8_STAGE_A(bufoff, base, h, useN) do { if constexpr (GATHER) { unsigned v_[2]; \
        v_[0] = (useN) ? ((h) ? gN1[0] : gN0[0]) : ((h) ? gA1[0] : gA0[0]); v_[1] = (useN) ? ((h) ? gN1[1] : gN0[1]) : ((h) ? gA1[1] : gA0[1]); PG8_STAGE(bufoff, base, v_); } \
        else { PG8_STAGE(bufoff, (base) + (h) * hstep, voffA); } } while (0)
#define PG8_GROWS_ISSUE(u) do { const int* rt_ = S.rowtok + (size_t)(u).pm * 256; \
        asm volatile("global_load_dword %0, %1, off" : "=v"(gT[0]) : "v"(rt_ + gR[0]) : "memory"); asm volatile("global_load_dword %0, %1, off" : "=v"(gT[1]) : "v"(rt_ + gR[1]) : "memory"); \
        asm volatile("global_load_dword %0, %1, off" : "=v"(gT[2]) : "v"(rt_ + 128 + gR[0]) : "memory"); asm volatile("global_load_dword %0, %1, off" : "=v"(gT[3]) : "v"(rt_ + 128 + gR[1]) : "memory"); } while (0)
#define PG8_GROWS_USE(d0, d1) do { asm volatile("" : "+v"(gT[0]), "+v"(gT[1]), "+v"(gT[2]), "+v"(gT[3])); \
        d0[0] = (unsigned)gT[0] * (unsigned)KB + gC[0]; d0[1] = (unsigned)gT[1] * (unsigned)KB + gC[1]; d1[0] = (unsigned)gT[2] * (unsigned)KB + gC[0]; d1[1] = (unsigned)gT[3] * (unsigned)KB + gC[1]; } while (0)
#define PG8_LDA(dst, b, h) do { if constexpr (F8) { _Pragma("unroll") for (int m = 0; m < 4; ++m) dst##8[m] = *(const PG8_LAS i32x8*)(lds + PG8_SA(b, h) + aoff + m * 2048); } else { \
        _Pragma("unroll") for (int m = 0; m < 4; ++m) _Pragma("unroll") for (int k = 0; k < 2; ++k) dst[m][k] = *(const PG8_LAS bf16x8*)(lds + PG8_SA(b, h) + aoff + m * 2048 + k * 1024); } } while (0)
#define PG8_LDB(dst, b, h) do { if constexpr (F8) { _Pragma("unroll") for (int n = 0; n < 2; ++n) dst##8[n] = *(const PG8_LAS i32x8*)(lds + PG8_SB(b, h) + boff + n * 2048); } else { \
        _Pragma("unroll") for (int n = 0; n < 2; ++n) _Pragma("unroll") for (int k = 0; k < 2; ++k) dst[n][k] = *(const PG8_LAS bf16x8*)(lds + PG8_SB(b, h) + boff + n * 2048 + k * 1024); } } while (0)
#define PG8_MMA(ai, bj, At, Bt) do { __builtin_amdgcn_s_setprio(1); if constexpr (F8) { _Pragma("unroll") for (int m = 0; m < 4; ++m) _Pragma("unroll") for (int n = 0; n < 2; ++n) \
        asm volatile("v_mfma_scale_f32_16x16x128_f8f6f4 %0, %1, %2, %0, %3, %3 op_sel_hi:[0,0,0]" : "+v"(acc[ai][bj][m][n]) : "v"(Bt##8[n]), "v"(At##8[m]), "v"(f8scale)); } else {     \
        _Pragma("unroll") for (int m = 0; m < 4; ++m) _Pragma("unroll") for (int n = 0; n < 2; ++n) _Pragma("unroll") for (int k = 0; k < 2; ++k) \
        acc[ai][bj][m][n] = __builtin_amdgcn_mfma_f32_16x16x32_bf16(Bt[n][k], At[m][k], acc[ai][bj][m][n], 0, 0, 0); } __builtin_amdgcn_s_setprio(0); } while (0)
#define PG8_WAIT_V(n) asm volatile("s_waitcnt vmcnt(" #n ")" ::: "memory")
#define PG8_WAIT_L(n) asm volatile("s_waitcnt lgkmcnt(" #n ")" ::: "memory")
#define PG8_BAR __builtin_amdgcn_s_barrier()
#define PG8_SCHED __builtin_amdgcn_sched_barrier(0)
    Unit cur, nxt; int ui = 0;
    if (!S.next(0, cur)) return;
    f32x4 acc[2][2][4][2];
#pragma unroll
    for (int a = 0; a < 2; ++a)
#pragma unroll
        for (int b = 0; b < 2; ++b)
#pragma unroll
            for (int m = 0; m < 4; ++m)
#pragma unroll
                for (int n = 0; n < 2; ++n) acc[a][b][m][n] = (f32x4){0.f, 0.f, 0.f, 0.f};
    const int f8scale = 0x7f7f7f7f;
    bf16x8 At[4][2], B0[2][2], B1[2][2]; i32x8 At8[4], B08[2], B18[2];
    const char* cA = GATHER ? (const char*)g.A : (const char*)g.A + (size_t)cur.pm * tstep; const char* cB = (const char*)g.Bt + (size_t)cur.pn * tstep;
    S.a_ready(cur);
    if constexpr (GATHER) { PG8_GROWS_ISSUE(cur); asm volatile("s_waitcnt vmcnt(0)" ::: "memory"); PG8_GROWS_USE(gA0, gA1); }
    if constexpr (SP2) {
        PG8_STAGE(PG8_SB(0, 0), cB, voffB); PG8_STAGE(PG8_SB(0, 1), cB + hstep, voffB); PG8_STAGE_A(PG8_SA(0, 0), cA, 0, false); PG8_STAGE_A(PG8_SA(0, 1), cA, 1, false);
        if (wr == 1) PG8_BAR;
        PG8_WAIT_V(2); PG8_BAR;
        PG8_STAGE(PG8_SB(1, 0), cB + kstep, voffB); PG8_STAGE_A(PG8_SA(1, 0), cA + kstep, 0, false); PG8_STAGE(PG8_SB(1, 1), cB + hstep + kstep, voffB);
        PG8_WAIT_V(6); PG8_BAR;
    } else {
        PG8_STAGE(PG8_SB(0, 0), cB, voffB); PG8_STAGE(PG8_SA(0, 0), cA, voffA); PG8_STAGE(PG8_SB(0, 1), cB + hstep, voffB); PG8_STAGE(PG8_SA(0, 1), cA + hstep, voffA);
        if (wr == 1) PG8_BAR;
        PG8_WAIT_V(4); PG8_BAR;
        PG8_STAGE(PG8_SB(1, 0), cB + kstep, voffB); PG8_STAGE(PG8_SA(1, 0), cA + kstep, voffA); PG8_STAGE(PG8_SB(1, 1), cB + hstep + kstep, voffB);
        PG8_WAIT_V(6); PG8_BAR;
    }
    for (;;) {
        const bool has_next = S.next(ui + 1, nxt);
        const char* nA = GATHER ? (const char*)g.A : (has_next ? (const char*)g.A + (size_t)nxt.pm * tstep : cA); const char* nB = has_next ? (const char*)g.Bt + (size_t)nxt.pn * tstep : cB;
        if constexpr (GATHER) { if (has_next) PG8_GROWS_ISSUE(nxt); }
        for (int t = 0; t < nt; t += 2) {
            const bool last = (t == nt - 2);
            const char* a1 = cA + (size_t)(t + 1) * kstep;
            const char* a2 = last ? nA : cA + (size_t)(t + 2) * kstep; const char* b2 = last ? nB : cB + (size_t)(t + 2) * kstep;
            const char* a3 = a2 + kstep; const char* b3 = b2 + kstep;
            if (last && has_next) S.a_ready(nxt);
            if constexpr (SP2) {
            PG8_LDB(B0, 0, 0); PG8_LDB(B1, 0, 1); PG8_SCHED; PG8_LDA(At, 0, 0); PG8_STAGE_A(PG8_SA(1, 1), a1, 1, false);
            PG8_WAIT_V(8); PG8_WAIT_L(0);
            if constexpr (GATHER) { if (last) { if (has_next) PG8_GROWS_USE(gN0, gN1); else { gN0[0] = gA0[0]; gN0[1] = gA0[1]; gN1[0] = gA1[0]; gN1[1] = gA1[1]; } } }
            PG8_BAR; PG8_MMA(0, 0, At, B0); PG8_MMA(0, 1, At, B1); PG8_BAR; PG8_SCHED;
            PG8_LDA(At, 0, 1); PG8_STAGE(PG8_SB(0, 0), b2, voffB); PG8_STAGE(PG8_SB(0, 1), b2 + hstep, voffB); PG8_STAGE_A(PG8_SA(0, 0), a2, 0, last);
            PG8_WAIT_V(8); PG8_WAIT_L(0); PG8_BAR; PG8_MMA(1, 0, At, B0); PG8_MMA(1, 1, At, B1); PG8_BAR; PG8_SCHED;
            PG8_LDB(B0, 1, 0); PG8_LDB(B1, 1, 1); PG8_SCHED; PG8_LDA(At, 1, 0); PG8_STAGE_A(PG8_SA(0, 1), a2, 1, last);
            PG8_WAIT_V(8); PG8_WAIT_L(0); PG8_BAR; PG8_MMA(0, 0, At, B0); PG8_MMA(0, 1, At, B1); PG8_BAR; PG8_SCHED;
            PG8_LDA(At, 1, 1); PG8_STAGE(PG8_SB(1, 0), b3, voffB); PG8_STAGE(PG8_SB(1, 1), b3 + hstep, voffB); PG8_STAGE_A(PG8_SA(1, 0), a3, 0, last);
            PG8_WAIT_V(8); PG8_WAIT_L(0); PG8_BAR; PG8_MMA(1, 0, At, B0); PG8_MMA(1, 1, At, B1); PG8_BAR; PG8_SCHED;
            } else {
            PG8_LDB(B0, 0, 0); PG8_SCHED; PG8_LDA(At, 0, 0); PG8_STAGE(PG8_SA(1, 1), a1 + hstep, voffA);
            PG8_WAIT_L(8); PG8_BAR; PG8_WAIT_L(0); PG8_MMA(0, 0, At, B0); PG8_BAR; PG8_SCHED;
            PG8_LDB(B1, 0, 1); PG8_STAGE(PG8_SB(0, 0), b2, voffB);
            PG8_BAR; PG8_WAIT_L(0); PG8_MMA(0, 1, At, B1); PG8_BAR;
            PG8_LDA(At, 0, 1); PG8_STAGE(PG8_SA(0, 0), a2, voffA);
            PG8_BAR; PG8_WAIT_L(0); PG8_MMA(1, 0, At, B0); PG8_BAR; PG8_SCHED;
            PG8_STAGE(PG8_SB(0, 1), b2 + hstep, voffB);
            PG8_WAIT_V(6); PG8_BAR; PG8_MMA(1, 1, At, B1); PG8_BAR;
            PG8_LDB(B0, 1, 0); PG8_SCHED; PG8_LDA(At, 1, 0); PG8_STAGE(PG8_SA(0, 1), a2 + hstep, voffA);
            PG8_WAIT_L(8); PG8_BAR; PG8_WAIT_L(0); PG8_MMA(0, 0, At, B0); PG8_BAR; PG8_SCHED;
            PG8_LDB(B1, 1, 1); PG8_STAGE(PG8_SB(1, 0), b3, voffB);
            PG8_BAR; PG8_WAIT_L(0); PG8_MMA(0, 1, At, B1); PG8_BAR;
            PG8_LDA(At, 1, 1); PG8_STAGE(PG8_SA(1, 0), a3, voffA);
            PG8_BAR; PG8_WAIT_L(0); PG8_MMA(1, 0, At, B0); PG8_BAR; PG8_SCHED;
            PG8_STAGE(PG8_SB(1, 1), b3 + hstep, voffB);
            PG8_WAIT_V(6); PG8_BAR; PG8_MMA(1, 1, At, B1); PG8_BAR;
            }
        }
        if constexpr (ALIGN_EPI) { if (wr == 0) PG8_BAR; }
        if constexpr (F8) asm volatile("s_nop 15\n\ts_nop 7" ::: "memory");
        if constexpr (!Epi::AFTER_DRAIN) {
            int tz_ = threadIdx.x; asm volatile("" : "+v"(tz_)); const int l_ = tz_ & 63, w_ = __builtin_amdgcn_readfirstlane(tz_ >> 6);
            E(acc, cur, w_ >> 2, w_ & 3, l_ & 15, l_ >> 4); S.done(cur); }
        if (!has_next) break;
#pragma unroll
        for (int a = 0; a < 2; ++a)
#pragma unroll
            for (int b = 0; b < 2; ++b)
#pragma unroll
                for (int m = 0; m < 4; ++m)
#pragma unroll
                    for (int n = 0; n < 2; ++n) acc[a][b][m][n] = (f32x4){0.f, 0.f, 0.f, 0.f};
        cur = nxt; cA = nA; cB = nB; ++ui;
        if constexpr (GATHER) { gA0[0] = gN0[0]; gA0[1] = gN0[1]; gA1[0] = gN1[0]; gA1[1] = gN1[1]; }
        if constexpr (ALIGN_EPI) { if (wr == 1) PG8_BAR; }
    }
    PG8_WAIT_V(0);
    if constexpr (!ALIGN_EPI) { if (wr == 0) PG8_BAR; }
    PG8_BAR;
    if constexpr (Epi::AFTER_DRAIN) { E.fused(acc, cur, wr, wc, fr, fq, lds, wid, lane); S.done(cur); }
#undef PG8_SA
#undef PG8_SB
#undef PG8_STAGE
#undef PG8_STAGE_A
#undef PG8_GROWS_ISSUE
#undef PG8_GROWS_USE
#undef PG8_LDA
#undef PG8_LDB
#undef PG8_MMA
#undef PG8_WAIT_V
#undef PG8_WAIT_L
#undef PG8_BAR
#undef PG8_SCHED
}
}
#define LAS __attribute__((address_space(3)))
#define XB_TMO      128
#define XB_XCNT(j)  (256  + 64 * (j))
#define XB_XSUB(j)  (1280 + 64 * (j))
#define XB_XGEN(j)  (2304 + 64 * (j))
#define XB_TOP      3328
#define XB_TOPGEN   3392
#define XCD_BAR_WORDS 3456
#define XB_SPIN_CAP (1u << 18)

__device__ __forceinline__ unsigned xb_ld(unsigned* p)              { return __hip_atomic_load(p, __ATOMIC_RELAXED, __HIP_MEMORY_SCOPE_AGENT); }
__device__ __forceinline__ unsigned xb_add(unsigned* p, unsigned v) { return __hip_atomic_fetch_add(p, v, __ATOMIC_RELAXED, __HIP_MEMORY_SCOPE_AGENT); }
__device__ __forceinline__ unsigned xb_xcc_id() { return (unsigned)__builtin_amdgcn_s_getreg((3 << 11) | 20) & 0xFu; }
#define XB_SPIN(cond, bar) do { unsigned _sp = 0; while (cond) { __builtin_amdgcn_s_sleep(1); \
    if ((++_sp & 255u) == 0u) { if (xb_ld(&(bar)[XB_TMO])) break; if (_sp > XB_SPIN_CAP) { atomicAdd(&(bar)[XB_TMO], 1u); break; } } } } while (0)

struct XcdBarrier {
    unsigned* bar; unsigned x;
    volatile LAS unsigned* st;
    unsigned G;
};

__device__ __forceinline__ XcdBarrier xcd_barrier_post(unsigned* bar, volatile LAS unsigned* st, unsigned G) {
    XcdBarrier b; b.bar = bar; b.x = xb_xcc_id(); b.st = st; b.G = G;
    if (threadIdx.x == 0) (void)xb_add(&bar[XB_XCNT(b.x)], 1u);
    return b;
}
__device__ __forceinline__ void xcd_barrier_complete(unsigned* bar, unsigned x, unsigned& nloc, unsigned& nx, const unsigned G) {
    unsigned sum, cnt, mine, sp = 0u;
    for (;;) {
        sum = 0u; cnt = 0u; mine = 0u;
#pragma unroll
        for (unsigned j = 0; j < 16; ++j) { const unsigned c = xb_ld(&bar[XB_XCNT(j)]); sum += c; cnt += (c > 0u) ? 1u : 0u; mine = (j == x) ? c : mine; }
        if (sum == G) break;
        __builtin_amdgcn_s_sleep(1);
        if ((++sp & 255u) == 0u) { if (xb_ld(&bar[XB_TMO])) break; if (sp > XB_SPIN_CAP) { atomicAdd(&bar[XB_TMO], 1u); break; } }
    }
    nloc = mine > 0u ? mine : 1u; nx = cnt > 0u ? cnt : 1u;
}

__device__ __forceinline__ void xcd_barrier(const XcdBarrier& b) {
    asm volatile("s_waitcnt vmcnt(0)" ::: "memory");
    __syncthreads();
    if (threadIdx.x == 0) {
        unsigned* bar = b.bar;
        __builtin_amdgcn_s_waitcnt(0);
        unsigned nloc = b.st[0], nx = b.st[1];
        if (nloc == 0u) { xcd_barrier_complete(bar, b.x, nloc, nx, b.G); b.st[0] = nloc; b.st[1] = nx; }
        const unsigned old = xb_add(&bar[XB_XSUB(b.x)], 1u);
        const unsigned gen = old / nloc;
        if (old + 1u == (gen + 1u) * nloc) {
            __builtin_amdgcn_fence(__ATOMIC_RELEASE, "agent");
            asm volatile("s_waitcnt vmcnt(0)" ::: "memory");
            const unsigned og = xb_add(&bar[XB_TOP], 1u);
            const unsigned tg = og / nx;
            if (og + 1u == (tg + 1u) * nx) xb_add(&bar[XB_TOPGEN], 1u);
            else XB_SPIN(xb_ld(&bar[XB_TOPGEN]) == tg, bar);
            __builtin_amdgcn_fence(__ATOMIC_ACQUIRE, "agent");
            xb_add(&bar[XB_XGEN(b.x)], 1u);
            asm volatile("s_waitcnt vmcnt(0)" ::: "memory");
        } else {
            XB_SPIN(xb_ld(&bar[XB_XGEN(b.x)]) == gen, bar);
            __builtin_amdgcn_fence(__ATOMIC_ACQUIRE, "agent");
            asm volatile("s_waitcnt vmcnt(0)" ::: "memory");
        }
    }
    __syncthreads();
}
constexpr int D = 2048, SEQ = 8192, NMETA = 16, LEAD = 48, NP = 8256  , MP = 8448  ;
constexpr int NPROJ = 3840, C_Z = 1024, C_X = 2048, C_B = 3072, C_C = 3328, C_DT = 3584, NINPROJ = 3600;
constexpr int NE = 32, DCONV = 1536;
constexpr int RTILES = 160, RPAD = RTILES * 256;
constexpr float EPS = 1e-5f;
constexpr int NWAVES = 8, NPH = 12;
#ifndef WN_WORKERS
#define WN_WORKERS 136
#endif
constexpr int WN = WN_WORKERS;
#ifndef MOE_F8
#define MOE_F8 1
#endif
#ifndef MOE_RB
#define MOE_RB 0
#endif
#ifndef MK_ONE_LAUNCH
#define MK_ONE_LAUNCH 1
#endif

constexpr size_t WS_CTL = 0, CTL_BYTES = 1u << 20;
constexpr size_t WS_HN = CTL_BYTES;
constexpr size_t WS_BT1 = WS_HN + (size_t)MP * D * 2;
constexpr size_t WS_BT2 = WS_BT1 + (size_t)NPROJ * D * 2;
constexpr size_t WS_PROJ = WS_BT2 + (size_t)D * D * 2;
constexpr size_t WS_XT = WS_PROJ + (size_t)MP * NPROJ * 2;
constexpr size_t WS_BTT = WS_XT + (size_t)1024 * NP * 2;
constexpr size_t WS_BC = WS_BTT + (size_t)256 * NP * 2;
constexpr size_t WS_CC = WS_BC + (size_t)NP * 256 * 2;
constexpr size_t WS_DT = WS_CC + (size_t)NP * 256 * 2;
constexpr size_t WS_ST = WS_DT + (size_t)NP * 16 * 4;
constexpr size_t WS_DEC = WS_ST + (size_t)128 * 131072 * 4;
constexpr size_t WS_PREV = WS_DEC + 128 * 16 * 4;
constexpr size_t WS_YCAT = WS_PREV + (size_t)128 * 131072 * 2;
constexpr size_t WS_H2 = WS_YCAT + (size_t)SEQ * D * 2;
constexpr size_t WS_HN2 = WS_H2 + (size_t)SEQ * D * 4;
constexpr size_t WS_WR = WS_HN2 + (size_t)SEQ * D * 2;
constexpr size_t WS_TKE = WS_WR + (size_t)D * NE * 4;
constexpr size_t WS_TKG = WS_TKE + (size_t)SEQ * 16;
constexpr size_t WS_POS = WS_TKG + (size_t)SEQ * 16;
constexpr size_t WS_CNT = WS_POS + (size_t)SEQ * 16;
constexpr size_t WS_TILE = WS_CNT + 256 * 32 * 4;
constexpr size_t WS_XS = WS_TILE + 1024;
constexpr size_t WS_A = WS_XS + (size_t)RPAD * D * 2;
constexpr size_t WS_O = WS_A + (size_t)RPAD * D * 2;
constexpr size_t WS_BTGU = WS_O + (MOE_F8 ? (size_t)RPAD * D * 2 : 0);
constexpr size_t WS_BTD = WS_BTGU + (size_t)NE * 4096 * D * (MOE_F8 ? 1 : 2);
constexpr size_t WS_END = WS_BTD + (size_t)NE * D * D * (MOE_F8 ? 1 : 2);
constexpr int CW_BAR = 4096, CW_BAR2 = 8192;
static_assert((CW_BAR2 + XCD_BAR_WORDS) * 4 <= (int)CTL_BYTES && CW_BAR + XCD_BAR_WORDS <= CW_BAR2, "ctl");

constexpr int RING_BYTES = 131072, SCR_BYTES = 135168, MISC_OFF = SCR_BYTES, LDS_BYTES = 147456;

#define DI __device__ __forceinline__
typedef unsigned short bf16;
typedef unsigned v4u __attribute__((ext_vector_type(4)));
typedef unsigned v2u __attribute__((ext_vector_type(2)));
typedef float f32x4 __attribute__((ext_vector_type(4)));
typedef float f32x16 __attribute__((ext_vector_type(16)));
typedef short bf16x8 __attribute__((ext_vector_type(8)));
#define LDS_WAIT() asm volatile("s_waitcnt lgkmcnt(0)" ::: "memory")
#define MFMA32(a, b, c) __builtin_amdgcn_mfma_f32_32x32x16_bf16((a), (b), (c), 0, 0, 0)
DI float bf_lo(unsigned w) { return __uint_as_float(w << 16); }
DI float bf_hi(unsigned w) { return __uint_as_float(w & 0xffff0000u); }
DI float bf2f(bf16 v) { return __uint_as_float(((unsigned)v) << 16); }
typedef __bf16 bf2v __attribute__((ext_vector_type(2)));
typedef float f2v __attribute__((ext_vector_type(2)));
DI unsigned pk2(float lo, float hi) { const f2v v = {lo, hi}; const bf2v b = __builtin_convertvector(v, bf2v); return __builtin_bit_cast(unsigned, b); }
DI unsigned pk4_f8(float a, float b, float c, float d) { int p = __builtin_amdgcn_cvt_pk_fp8_f32(a, b, 0, false); p = __builtin_amdgcn_cvt_pk_fp8_f32(c, d, p, true); return (unsigned)p; }
DI bf16 f2bf(float f) { return (bf16)(pk2(f, 0.f) & 0xffffu); }
DI float wave_sum(float v) {
#pragma unroll
    for (int o = 1; o < 64; o <<= 1) v += __shfl_xor(v, o);
    return v;
}
DI float wave_incl_scan(float v, int lane) {
#pragma unroll
    for (int o = 1; o < 64; o <<= 1) { const float t = __shfl_up(v, o); if (lane >= o) v += t; }
    return v;
}
DI float silu_f(float x) { return x * __builtin_amdgcn_rcpf(1.f + __expf(-x)); }

struct Frame {
    LAS unsigned char* lds;
    int tid, lane, wave, gw, ngw, bid, nwg;
    const float *x, *meta, *g1, *w_in, *pool_w, *pool_scale, *conv_w, *conv_b, *dt_bias, *a_log, *d_skip, *ssm_g, *w_out, *g2, *router_w, *router_b,
        *w_gate, *b_gate, *w_up, *b_up, *w_down, *b_down, *final_g;
    float* out;
    bf16 *hn, *Bt1, *Bt2, *proj, *xT, *BT, *Bc, *Cc, *prev, *ycat, *hn2, *xs, *abuf, *obuf, *Btgu, *Btd;
    float *dtv, *decay, *Wr, *tkg; bf16 *states, *h2;
    int *tke, *pos, *cnt, *tile;
};

DI int crow16(int reg, int hf) { return (reg & 3) + 8 * (reg >> 2) + 4 * hf; }
DI void p0_norm(Frame& F) {
    const f32x4* gr = (const f32x4*)F.g1 + F.lane;
    for (int P0 = F.gw; P0 < NP; P0 += 2 * F.ngw) {
        f32x4 v[2][8]; bool live[2];
#pragma unroll
        for (int u = 0; u < 2; ++u) { const int P = P0 + u * F.ngw; live[u] = (P >= LEAD && P < NP);
            const int t = live[u] ? P - LEAD : 0;
            const float* src = t < NMETA ? F.meta + (size_t)t * D : F.x + (size_t)(t - NMETA) * D;
            const f32x4* xr = (const f32x4*)src + F.lane;
#pragma unroll
            for (int j = 0; j < 8; ++j) v[u][j] = xr[64 * j]; }
#pragma unroll
        for (int u = 0; u < 2; ++u) { const int P = P0 + u * F.ngw; if (P >= NP) continue;
            unsigned long long* o8 = (unsigned long long*)(F.hn + (size_t)P * D) + F.lane;
            if (!live[u]) {
#pragma unroll
                for (int j = 0; j < 8; ++j) o8[64 * j] = 0ull;
                continue; }
            float s = 0.f;
#pragma unroll
            for (int j = 0; j < 8; ++j) s += (v[u][j].x * v[u][j].x + v[u][j].y * v[u][j].y) + (v[u][j].z * v[u][j].z + v[u][j].w * v[u][j].w);
            const float rstd = rsqrtf(wave_sum(s) * (1.f / D) + EPS);
#pragma unroll
            for (int j = 0; j < 8; ++j) { const f32x4 g = gr[64 * j];
                o8[64 * j] = (unsigned long long)pk2(v[u][j].x * rstd * g.x, v[u][j].y * rstd * g.y) | ((unsigned long long)pk2(v[u][j].z * rstd * g.z, v[u][j].w * rstd * g.w) << 32); }
        }
    }
}
typedef unsigned int bs_u4 __attribute__((__vector_size__(16)));
DI void tr_load(float (&v)[64], const float* W, size_t ldw, int nvalid, int lane) {
    const int r4 = lane >> 4, n4 = lane & 15;
    if (4 * n4 < nvalid) {
        const __amdgpu_buffer_rsrc_t rs = __builtin_amdgcn_make_buffer_rsrc((void*)W, 0, 0x7fffffff, 0x00020000);
        const int voff = (r4 * (int)ldw + 4 * n4) * 4;
#pragma unroll
        for (int u = 0; u < 16; ++u) { const f32x4 q = __builtin_bit_cast(f32x4, __builtin_amdgcn_raw_buffer_load_b128(rs, voff, u * 16 * (int)ldw, 2)); v[4 * u] = q.x; v[4 * u + 1] = q.y; v[4 * u + 2] = q.z; v[4 * u + 3] = q.w; }
    } else {
#pragma unroll
        for (int kk = 0; kk < 64; ++kk) v[kk] = 0.f;
    }
}
DI void tr_to_lds(const float (&v)[64], LAS float* scr, int lane, float scale) {
    const int r4 = lane >> 4, n4 = lane & 15; LAS float* d = scr + r4 * 65 + 4 * n4;
#pragma unroll
    for (int u = 0; u < 16; ++u) {
#pragma unroll
        for (int e = 0; e < 4; ++e) d[(4 * u) * 65 + e] = v[4 * u + e] * scale;
        __builtin_amdgcn_sched_barrier(0); }
}
DI void tr_store(const float (&v)[64], int nvalid, bf16* WT, size_t ldt, LAS float* scr, int lane) {
    tr_to_lds(v, scr, lane, 1.f);
    LDS_WAIT();
    const int c = lane & 7;
    const __amdgpu_buffer_rsrc_t rs = __builtin_amdgcn_make_buffer_rsrc((void*)WT, 0, 0x7fffffff, 0x00020000);
    const int voff = ((lane >> 3) * (int)ldt + 8 * c) * 2;
#pragma unroll
    for (int j = 0; j < 8; ++j) { const int n = (lane >> 3) + 8 * j; const LAS float* s = scr + (8 * c) * 65 + n;
        v4u o; o.x = pk2(s[0], s[65]); o.y = pk2(s[130], s[195]); o.z = pk2(s[260], s[325]); o.w = pk2(s[390], s[455]);
        if (n < nvalid) __builtin_amdgcn_raw_buffer_store_b128(__builtin_bit_cast(bs_u4, o), rs, voff, 16 * j * (int)ldt, 0); __builtin_amdgcn_sched_barrier(0); }
    LDS_WAIT();
}
DI void tr_store8(const float (&v)[64], unsigned char* WT, size_t ldt, LAS float* scr, int lane, float scale) {
    tr_to_lds(v, scr, lane, scale);
    LDS_WAIT();
    const int c = lane & 3;
    const __amdgpu_buffer_rsrc_t rs = __builtin_amdgcn_make_buffer_rsrc((void*)WT, 0, 0x7fffffff, 0x00020000);
    const int voff = (lane >> 2) * (int)ldt + 16 * c;
#pragma unroll
    for (int j = 0; j < 4; ++j) { const int n = (lane >> 2) + 16 * j; const LAS float* s = scr + (16 * c) * 65 + n;
        v4u o; o.x = pk4_f8(s[0], s[65], s[130], s[195]); o.y = pk4_f8(s[260], s[325], s[390], s[455]);
        o.z = pk4_f8(s[520], s[585], s[650], s[715]); o.w = pk4_f8(s[780], s[845], s[910], s[975]);
        __builtin_amdgcn_raw_buffer_store_b128(__builtin_bit_cast(bs_u4, o), rs, voff, 16 * j * (int)ldt, 2); __builtin_amdgcn_sched_barrier(0); }
    LDS_WAIT();
}
struct TrItem { const float* W; bf16* WT; int ldw, nv; };
constexpr int I_IN = 32 * 57, I_OUT = 16 * 32, I_MOE = MOE_RB ? 0 : NE * 3 * 32 * 32, NITEMS = I_IN + I_OUT + I_MOE;
constexpr float W8_SCALE = 1024.f, X8_SCALE = 16.f, A8_SCALE = 4.f, O8_SCALE = 16.f;
DI TrItem tr_get(Frame& F, int it) {
    TrItem t; int r = it;
    if (r < I_MOE) {
        const int nb = r & 31, kb = (r >> 5) & 31, em = r >> 10, mat = em % 3, e = em / 3;
        t.ldw = D; t.nv = 64;
        constexpr int ES = MOE_F8 ? 1 : 2;
        if (mat == 2) { t.W = F.w_down + (size_t)e * D * D + (size_t)(64 * kb) * D + 64 * nb; t.WT = (bf16*)((unsigned char*)F.Btd + (((size_t)e * D + 64 * nb) * D + 64 * kb) * ES); }
        else { t.W = (mat == 0 ? F.w_gate : F.w_up) + (size_t)e * D * D + (size_t)(64 * kb) * D + 64 * nb;
               const int row = 256 * (nb >> 1) + 64 * (nb & 1) + 128 * mat; t.WT = (bf16*)((unsigned char*)F.Btgu + (((size_t)e * 4096 + row) * D + 64 * kb) * ES); }
        return t;
    }
    r -= I_MOE;
    if (r < I_IN) { const int kb = r / 57, nb = r % 57; t.ldw = NINPROJ; t.nv = (nb == 56) ? 16 : 64;
        t.W = F.w_in + (size_t)(64 * kb) * NINPROJ + 64 * nb; t.WT = F.Bt1 + (size_t)(64 * nb) * D + 64 * kb; return t; }
    r -= I_IN;
    { const int kb = r >> 5, nb = r & 31; t.ldw = D; t.nv = 64;
      t.W = F.w_out + (size_t)(1024 + 64 * kb) * D + 64 * nb; t.WT = F.Bt2 + (size_t)(64 * nb) * D + 1024 + 64 * kb; return t; }
}
template <bool MOE>
DI void p0_weights_range(Frame& F, const int it_lo, const int it_hi) {
    LAS float* scr = (LAS float*)(F.lds + F.wave * 16640);
    float va[64], vb[64], vc[64];
    int it = it_lo + F.gw; const int st = F.ngw;
    if (it >= it_hi) return;
#define TR_LOAD(v, t) tr_load(v, (t).W, (t).ldw, MOE ? 64 : (t).nv, F.lane)
#define TR_EMIT(v, t) do { if constexpr (MOE) tr_store8(v, (unsigned char*)(t).WT, D, scr, F.lane, W8_SCALE); else tr_store(v, (t).nv, (t).WT, D, scr, F.lane); } while (0)
    TrItem ta = tr_get(F, it), tb = ta, tc = ta;
    TR_LOAD(va, ta);
    if (it + 4 * st < it_hi) {
        tb = tr_get(F, it + st); TR_LOAD(vb, tb);
        do {
            tc = tr_get(F, it + 2 * st); TR_LOAD(vc, tc); TR_EMIT(va, ta);
            ta = tr_get(F, it + 3 * st); TR_LOAD(va, ta); TR_EMIT(vb, tb);
            tb = tr_get(F, it + 4 * st); TR_LOAD(vb, tb); TR_EMIT(vc, tc);
            it += 3 * st;
        } while (it + 4 * st < it_hi);
    } else if (it + st < it_hi) { tb = tr_get(F, it + st); TR_LOAD(vb, tb); }
    bool hb = it + st < it_hi;
    for (;;) {
        const bool hc = it + 2 * st < it_hi;
        if (hc) { tc = tr_get(F, it + 2 * st); TR_LOAD(vc, tc); }
        TR_EMIT(va, ta);
        if (!hb) break;
        const bool ha = it + 3 * st < it_hi;
        if (ha) { ta = tr_get(F, it + 3 * st); TR_LOAD(va, ta); }
        TR_EMIT(vb, tb);
        if (!hc) break;
        hb = it + 4 * st < it_hi;
        if (hb) { tb = tr_get(F, it + 4 * st); TR_LOAD(vb, tb); }
        TR_EMIT(vc, tc);
        if (!ha) break;
        it += 3 * st;
    }
#undef TR_EMIT
#undef TR_LOAD
}
DI void p0_weff(Frame& F) {
    const int lane = F.lane, li = lane & 31, kh = lane >> 5;
    for (int task = F.gw; task < 2048; task += F.ngw) {
        const int g = task >> 9, rem = task & 511, cb = rem >> 6, nb = rem & 63;
        const float* wo = F.w_out + (size_t)(256 * g + 4 * kh) * D + 32 * nb + li;
        const float* ps = F.pool_scale + 256 * g + 4 * kh;
        const float* pw = F.pool_w + (size_t)(g * 256 + 32 * cb + li) * 256 + 4 * kh;
        f32x16 acc;
#pragma unroll
        for (int i = 0; i < 16; ++i) acc[i] = 0.f;
#pragma unroll 8
        for (int jj = 0; jj < 32; ++jj) {
            const f32x4 b = *(const f32x4*)(pw + 8 * jj), sc = *(const f32x4*)(ps + 8 * jj);
            const float a0 = wo[(size_t)(8 * jj) * D] * sc.x, a1 = wo[(size_t)(8 * jj + 1) * D] * sc.y, a2 = wo[(size_t)(8 * jj + 2) * D] * sc.z, a3 = wo[(size_t)(8 * jj + 3) * D] * sc.w;
            acc = __builtin_amdgcn_mfma_f32_32x32x2f32(a0, b.x, acc, 0, 0, 0);
            acc = __builtin_amdgcn_mfma_f32_32x32x2f32(a1, b.y, acc, 0, 0, 0);
            acc = __builtin_amdgcn_mfma_f32_32x32x2f32(a2, b.z, acc, 0, 0, 0);
            acc = __builtin_amdgcn_mfma_f32_32x32x2f32(a3, b.w, acc, 0, 0, 0);
        }
        bf16* dst = F.Bt2 + (size_t)(32 * nb) * D + 256 * g + 32 * cb + li;
#pragma unroll
        for (int i = 0; i < 16; ++i) dst[(size_t)crow16(i, kh) * D] = f2bf(acc[i]);
    }
}
DI void p0_router_fold(Frame& F) {
    for (int i = F.bid * 512 + F.tid; i < D * NE; i += F.nwg * 512) F.Wr[i] = F.g2[i >> 5] * F.router_w[i];
}

DI void e_conv_tile(Frame& F, int c, int pcol, int cch, bf16* outT, bf16* outR, int rcol) {
    const int lane = F.lane, ch = cch + lane;
    const float w0 = F.conv_w[ch], w1 = F.conv_w[DCONV + ch], w2 = F.conv_w[2 * DCONV + ch], w3 = F.conv_w[3 * DCONV + ch], b = F.conv_b[ch];
    const bf16* src = F.proj + pcol + lane;
    const int P0 = 64 * c;
    bf16 raw[67];
#pragma unroll
    for (int i = 0; i < 3; ++i) raw[i] = (P0 - 3 + i >= 0) ? src[(size_t)(P0 - 3 + i) * NPROJ] : (bf16)0;
#pragma unroll
    for (int i = 0; i < 64; ++i) raw[3 + i] = src[(size_t)(P0 + i) * NPROJ];
#pragma unroll
    for (int sb = 0; sb < 4; ++sb) {
        float o[16];
#pragma unroll
        for (int i = 0; i < 16; ++i) { const int q = 16 * sb + i;
            const float a = b + w0 * bf2f(raw[q]) + w1 * bf2f(raw[q + 1]) + w2 * bf2f(raw[q + 2]) + w3 * bf2f(raw[q + 3]);
            o[i] = (P0 + q >= LEAD) ? silu_f(a) : 0.f; }
        if (outT) { v4u q0, q1;
            q0.x = pk2(o[0], o[1]); q0.y = pk2(o[2], o[3]); q0.z = pk2(o[4], o[5]); q0.w = pk2(o[6], o[7]);
            q1.x = pk2(o[8], o[9]); q1.y = pk2(o[10], o[11]); q1.z = pk2(o[12], o[13]); q1.w = pk2(o[14], o[15]);
            bf16* dst = outT + (size_t)lane * NP + P0 + 16 * sb; *(v4u*)dst = q0; *(v4u*)(dst + 8) = q1; }
        if (outR) {
#pragma unroll
            for (int i = 0; i < 16; ++i) outR[(size_t)(P0 + 16 * sb + i) * 256 + rcol + lane] = f2bf(o[i]); }
    }
}
template <int W> DI void e_pool_tile(Frame& F, int c, int colbase) {
    const int lane = F.lane; const bf16* src = F.proj + colbase + lane; const int P0 = 64 * c;
    bf16 raw[64 + W - 1];
#pragma unroll
    for (int i = 0; i < 64 + W - 1; ++i) raw[i] = src[(size_t)(P0 - (W - 1) + i) * NPROJ];
#pragma unroll
    for (int sb = 0; sb < 4; ++sb) {
#pragma unroll
        for (int i = 0; i < 16; ++i) { const int q = 16 * sb + i; float s = 0.f;
#pragma unroll
            for (int j = 0; j < W; ++j) s += bf2f(raw[q + j]);
            F.ycat[(size_t)(P0 - 64 + q) * D + colbase + lane] = f2bf(s * (1.f / W) - bf2f(raw[q + W - 1])); }
    }
}
DI void e_dt_tile(Frame& F, int c) {
    const int P = 64 * c + F.lane;
    const v4u* src = (const v4u*)(F.proj + (size_t)P * NPROJ + C_DT);
    const v4u r0 = src[0], r1 = src[1];
    const unsigned w[8] = {r0.x, r0.y, r0.z, r0.w, r1.x, r1.y, r1.z, r1.w};
    float o[16];
#pragma unroll
    for (int i = 0; i < 8; ++i) { o[2 * i] = bf_lo(w[i]); o[2 * i + 1] = bf_hi(w[i]); }
#pragma unroll
    for (int h = 0; h < 16; ++h) { const float x = o[h] + F.dt_bias[h]; const float sp = fmaxf(x, 0.f) + log1pf(__expf(-fabsf(x))); o[h] = (P >= LEAD) ? sp : 0.f; }
    f32x4* dst = (f32x4*)(F.dtv + (size_t)P * 16);
#pragma unroll
    for (int q = 0; q < 4; ++q) dst[q] = (f32x4){o[4 * q], o[4 * q + 1], o[4 * q + 2], o[4 * q + 3]};
}
DI void p2_elem(Frame& F) {
    constexpr int NT = 129 * 41;
    for (int task = F.gw; task < NT; task += F.ngw) {
        const int c = task / 41, j = task % 41;
        if (j < 16) { if (c == 0) continue; const int g = j >> 2;
            if (g == 0) e_pool_tile<2>(F, c, 64 * j); else if (g == 1) e_pool_tile<4>(F, c, 64 * j); else if (g == 2) e_pool_tile<8>(F, c, 64 * j); else e_pool_tile<16>(F, c, 64 * j); }
        else if (j < 32) e_conv_tile(F, c, C_X + 64 * (j - 16), 64 * (j - 16), F.xT + (size_t)(64 * (j - 16)) * NP, nullptr, 0);
        else if (j < 36) e_conv_tile(F, c, C_B + 64 * (j - 32), 1024 + 64 * (j - 32), F.BT + (size_t)(64 * (j - 32)) * NP, F.Bc, 64 * (j - 32));
        else if (j < 40) e_conv_tile(F, c, C_C + 64 * (j - 36), 1280 + 64 * (j - 36), nullptr, F.Cc, 64 * (j - 36));
        else e_dt_tile(F, c);
    }
}

DI void p3_states(Frame& F) {
    const int lane = F.lane, r = lane & 31, hf = lane >> 5;
    LAS float* wsm = (LAS float*)(F.lds + F.wave * 256);
    for (int u = F.bid; u < 256; u += F.nwg) {
        const int c = u >> 1, g = u & 1, h = 8 * g + F.wave;
        const float A = -__expf(F.a_log[h]);
        const float dtl = F.dtv[(size_t)(64 * c + lane) * 16 + h];
        const float acs = wave_incl_scan(dtl * A, lane);
        const float tot = __shfl(acs, 63);
        wsm[lane] = dtl * __expf(tot - acs);
        if (lane == 0) F.decay[c * 16 + h] = __expf(tot);
        LDS_WAIT();
        f32x16 acc[2][4];
#pragma unroll
        for (int mt = 0; mt < 2; ++mt)
#pragma unroll
            for (int nt = 0; nt < 4; ++nt)
#pragma unroll
                for (int i = 0; i < 16; ++i) acc[mt][nt][i] = 0.f;
#pragma unroll
        for (int ks = 0; ks < 4; ++ks) {
            const f32x4 wa = *(const LAS f32x4*)(wsm + 16 * ks + 8 * hf), wb = *(const LAS f32x4*)(wsm + 16 * ks + 8 * hf + 4);
            bf16x8 af[2], bfr[4];
#pragma unroll
            for (int mt = 0; mt < 2; ++mt) {
                const v4u raw = *(const v4u*)(F.xT + (size_t)(h * 64 + 32 * mt + r) * NP + 64 * c + 16 * ks + 8 * hf);
                v4u sc; sc.x = pk2(bf_lo(raw.x) * wa.x, bf_hi(raw.x) * wa.y); sc.y = pk2(bf_lo(raw.y) * wa.z, bf_hi(raw.y) * wa.w);
                sc.z = pk2(bf_lo(raw.z) * wb.x, bf_hi(raw.z) * wb.y); sc.w = pk2(bf_lo(raw.w) * wb.z, bf_hi(raw.w) * wb.w);
                af[mt] = __builtin_bit_cast(bf16x8, sc);
            }
#pragma unroll
            for (int nt = 0; nt < 4; ++nt) bfr[nt] = *(const bf16x8*)(F.BT + (size_t)(g * 128 + 32 * nt + r) * NP + 64 * c + 16 * ks + 8 * hf);
#pragma unroll
            for (int mt = 0; mt < 2; ++mt)
#pragma unroll
                for (int nt = 0; nt < 4; ++nt) acc[mt][nt] = MFMA32(af[mt], bfr[nt], acc[mt][nt]);
        }
        bf16* st = F.states + ((size_t)(c * 16 + h) * 64) * 128;
#pragma unroll
        for (int mt = 0; mt < 2; ++mt)
#pragma unroll
            for (int nt = 0; nt < 4; ++nt)
#pragma unroll
                for (int i = 0; i < 16; ++i) st[(32 * mt + crow16(i, hf)) * 128 + 32 * nt + r] = f2bf(acc[mt][nt][i]);
        LDS_WAIT();
    }
}
DI void p4_scan(Frame& F) {
    const unsigned* st2 = (const unsigned*)F.states; unsigned* pv2 = (unsigned*)F.prev;
    for (int e = F.bid * 512 + F.tid; e < 65536; e += F.nwg * 512) {
        const int h = e >> 12; float c0v = 0.f, c1v = 0.f;
        for (int c0 = 0; c0 < 128; c0 += 16) {
            unsigned s[16]; float dc[16];
#pragma unroll
            for (int i = 0; i < 16; ++i) { s[i] = st2[(size_t)(c0 + i) * 65536 + e]; dc[i] = F.decay[(c0 + i) * 16 + h]; }
#pragma unroll
            for (int i = 0; i < 16; ++i) { c0v = c0v * dc[i] + bf_lo(s[i]); c1v = c1v * dc[i] + bf_hi(s[i]); pv2[(size_t)(c0 + i) * 65536 + e] = pk2(c0v, c1v); }
        }
    }
}
DI bf16x8 pack8(const f32x16& x, int s) {
    v4u p; p.x = pk2(x[8 * s], x[8 * s + 1]); p.y = pk2(x[8 * s + 2], x[8 * s + 3]); p.z = pk2(x[8 * s + 4], x[8 * s + 5]); p.w = pk2(x[8 * s + 6], x[8 * s + 7]);
    return __builtin_bit_cast(bf16x8, p);
}
DI void p5_out(Frame& F) {
    const int lane = F.lane, r = lane & 31, hf = lane >> 5;
    LAS float* acs_s = (LAS float*)(F.lds + F.wave * 512);
    LAS float* dt_s = acs_s + 64;
    LAS float* red = (LAS float*)(F.lds + 8192);
    for (int u = F.bid; u < 256; u += F.nwg) {
        const int c = 1 + (u >> 1), g = u & 1, h = 8 * g + F.wave;
        const float A = -__expf(F.a_log[h]), Dh = F.d_skip[h];
        const float dtl = F.dtv[(size_t)(64 * c + lane) * 16 + h];
        const float acs = wave_incl_scan(dtl * A, lane);
        acs_s[lane] = acs; dt_s[lane] = dtl;
        float acs_l[2]; acs_l[0] = __shfl(acs, r); acs_l[1] = __shfl(acs, 32 + r);
        LDS_WAIT();
        f32x16 yT[2][2], sT[3];
#pragma unroll
        for (int i = 0; i < 16; ++i) { yT[0][0][i] = 0.f; yT[0][1][i] = 0.f; yT[1][0][i] = 0.f; yT[1][1][i] = 0.f; sT[0][i] = 0.f; sT[1][i] = 0.f; sT[2][i] = 0.f; }
        const bf16* prevp = F.prev + ((size_t)(c - 1) * 16 + h) * 8192;
#pragma unroll 2
        for (int ks = 0; ks < 8; ++ks) {
            bf16x8 cf[2], pf[2], bg[2];
#pragma unroll
            for (int t = 0; t < 2; ++t) {
                cf[t] = *(const bf16x8*)(F.Cc + (size_t)(64 * c + 32 * t + r) * 256 + g * 128 + 16 * ks + 8 * hf);
                bg[t] = *(const bf16x8*)(F.Bc + (size_t)(64 * c + 32 * t + r) * 256 + g * 128 + 16 * ks + 8 * hf);
                pf[t] = *(const bf16x8*)(prevp + (32 * t + r) * 128 + 16 * ks + 8 * hf);
            }
            yT[0][0] = MFMA32(pf[0], cf[0], yT[0][0]); yT[0][1] = MFMA32(pf[0], cf[1], yT[0][1]);
            yT[1][0] = MFMA32(pf[1], cf[0], yT[1][0]); yT[1][1] = MFMA32(pf[1], cf[1], yT[1][1]);
            sT[0] = MFMA32(bg[0], cf[0], sT[0]); sT[1] = MFMA32(bg[0], cf[1], sT[1]); sT[2] = MFMA32(bg[1], cf[1], sT[2]);
        }
        { const float e0 = __expf(acs_l[0]), e1 = __expf(acs_l[1]);
#pragma unroll
          for (int i = 0; i < 16; ++i) { yT[0][0][i] *= e0; yT[1][0][i] *= e0; yT[0][1][i] *= e1; yT[1][1][i] *= e1; } }
#pragma unroll
        for (int t = 0; t < 3; ++t) {
            const int st = (t == 2) ? 1 : 0, lt = (t == 0) ? 0 : 1;
            const int l = 32 * lt + r;
#pragma unroll
            for (int q = 0; q < 4; ++q) {
                const f32x4 a4 = *(const LAS f32x4*)(acs_s + 32 * st + 8 * q + 4 * hf), d4 = *(const LAS f32x4*)(dt_s + 32 * st + 8 * q + 4 * hf);
#pragma unroll
                for (int e = 0; e < 4; ++e) { const int s = 32 * st + 8 * q + 4 * hf + e;
                    float val = sT[t][4 * q + e] * __expf(acs_l[lt] - a4[e]) * d4[e];
                    val = (s <= l) ? val : 0.f; val = (s == l) ? val + Dh : val;
                    sT[t][4 * q + e] = val; }
            }
        }
#pragma unroll
        for (int st = 0; st < 2; ++st)
#pragma unroll
            for (int sp = 0; sp < 2; ++sp) {
                bf16x8 xa[2];
#pragma unroll
                for (int pt = 0; pt < 2; ++pt) { const bf16* xp = F.xT + (size_t)(h * 64 + 32 * pt + r) * NP + 64 * c + 32 * st + 16 * sp + 4 * hf;
                    const v2u lo = *(const v2u*)xp, hi = *(const v2u*)(xp + 8); v4u w; w.x = lo.x; w.y = lo.y; w.z = hi.x; w.w = hi.y; xa[pt] = __builtin_bit_cast(bf16x8, w); }
                if (st == 0) { const bf16x8 m0 = pack8(sT[0], sp), m1 = pack8(sT[1], sp);
                    yT[0][0] = MFMA32(xa[0], m0, yT[0][0]); yT[1][0] = MFMA32(xa[1], m0, yT[1][0]);
                    yT[0][1] = MFMA32(xa[0], m1, yT[0][1]); yT[1][1] = MFMA32(xa[1], m1, yT[1][1]);
                } else { const bf16x8 m2 = pack8(sT[2], sp);
                    yT[0][1] = MFMA32(xa[0], m2, yT[0][1]); yT[1][1] = MFMA32(xa[1], m2, yT[1][1]); }
            }
        float ss[2] = {0.f, 0.f};
#pragma unroll
        for (int pt = 0; pt < 2; ++pt)
#pragma unroll
            for (int lt = 0; lt < 2; ++lt) {
                const bf16* zp = F.proj + (size_t)(64 * c + 32 * lt + r) * NPROJ + C_Z + h * 64 + 32 * pt + 4 * hf;
#pragma unroll
                for (int q = 0; q < 4; ++q) { const v2u zw = *(const v2u*)(zp + 8 * q);
                    const float z0 = bf_lo(zw.x), z1 = bf_hi(zw.x), z2 = bf_lo(zw.y), z3 = bf_hi(zw.y);
                    float y0 = yT[pt][lt][4 * q] * silu_f(z0), y1 = yT[pt][lt][4 * q + 1] * silu_f(z1), y2 = yT[pt][lt][4 * q + 2] * silu_f(z2), y3 = yT[pt][lt][4 * q + 3] * silu_f(z3);
                    yT[pt][lt][4 * q] = y0; yT[pt][lt][4 * q + 1] = y1; yT[pt][lt][4 * q + 2] = y2; yT[pt][lt][4 * q + 3] = y3;
                    ss[lt] += (y0 * y0 + y1 * y1) + (y2 * y2 + y3 * y3); }
            }
        ss[0] += __shfl_xor(ss[0], 32); ss[1] += __shfl_xor(ss[1], 32);
        if (hf == 0) { red[F.wave * 64 + r] = ss[0]; red[F.wave * 64 + 32 + r] = ss[1]; }
        LDS_WAIT(); __syncthreads();
        float rstd[2];
#pragma unroll
        for (int lt = 0; lt < 2; ++lt) { float t = 0.f;
#pragma unroll
            for (int w = 0; w < 8; ++w) t += red[w * 64 + 32 * lt + r];
            rstd[lt] = rsqrtf(t * (1.f / 512.f) + EPS); }
#pragma unroll
        for (int pt = 0; pt < 2; ++pt)
#pragma unroll
            for (int lt = 0; lt < 2; ++lt) {
                bf16* op = F.ycat + (size_t)(64 * (c - 1) + 32 * lt + r) * D + 1024 + h * 64 + 32 * pt + 4 * hf;
                const float* gp = F.ssm_g + h * 64 + 32 * pt + 4 * hf;
#pragma unroll
                for (int q = 0; q < 4; ++q) { const f32x4 gg = *(const f32x4*)(gp + 8 * q); v2u w;
                    w.x = pk2(yT[pt][lt][4 * q] * rstd[lt] * gg.x, yT[pt][lt][4 * q + 1] * rstd[lt] * gg.y);
                    w.y = pk2(yT[pt][lt][4 * q + 2] * rstd[lt] * gg.z, yT[pt][lt][4 * q + 3] * rstd[lt] * gg.w);
                    *(v2u*)(op + 8 * q) = w; }
            }
        __syncthreads();
    }
}

DI void p7_router(Frame& F) {
    LAS float* rs = (LAS float*)F.lds;
    LAS float* part = rs + 64;
    LAS float* lg = part + 8 * 1024;
    LAS int* hist = (LAS int*)(lg + 32 * 33 + 8);
    const int lane = F.lane, wave = F.wave;
    for (int blk = F.bid; blk < 256; blk += F.nwg) {
        const int r0 = 32 * blk;
        {
            const f32x4* gr = (const f32x4*)F.g2 + lane;
            f32x4 v[4][8];
#pragma unroll
            for (int i = 0; i < 4; ++i) { const v2u* xr = (const v2u*)(F.h2 + (size_t)(r0 + 4 * wave + i) * D) + lane;
#pragma unroll
                for (int j = 0; j < 8; ++j) { const v2u w = xr[64 * j]; v[i][j] = (f32x4){bf_lo(w.x), bf_hi(w.x), bf_lo(w.y), bf_hi(w.y)}; } }
            f32x4 g[8];
#pragma unroll
            for (int j = 0; j < 8; ++j) g[j] = gr[64 * j];
#pragma unroll
            for (int i = 0; i < 4; ++i) { const int rr = r0 + 4 * wave + i; float s = 0.f;
#pragma unroll
                for (int j = 0; j < 8; ++j) s += (v[i][j].x * v[i][j].x + v[i][j].y * v[i][j].y) + (v[i][j].z * v[i][j].z + v[i][j].w * v[i][j].w);
                const float rstd = rsqrtf(wave_sum(s) * (1.f / D) + EPS);
                unsigned long long* o8 = (unsigned long long*)(F.hn2 + (size_t)rr * D) + lane;
                unsigned* o4 = (unsigned*)((unsigned char*)F.hn2 + (size_t)rr * D) + lane;
#pragma unroll
                for (int j = 0; j < 8; ++j) {
                    if (MOE_F8) { const float q = rstd * X8_SCALE; o4[64 * j] = pk4_f8(v[i][j].x * q * g[j].x, v[i][j].y * q * g[j].y, v[i][j].z * q * g[j].z, v[i][j].w * q * g[j].w); }
                    else o8[64 * j] = (unsigned long long)pk2(v[i][j].x * rstd * g[j].x, v[i][j].y * rstd * g[j].y) | ((unsigned long long)pk2(v[i][j].z * rstd * g[j].z, v[i][j].w * rstd * g[j].w) << 32); }
                if (lane == 0) rs[4 * wave + i] = rstd; }
        }
        f32x16 acc;
#pragma unroll
        for (int i = 0; i < 16; ++i) acc[i] = 0.f;
        { const int ri = lane & 31, kh = lane >> 5;
          const bf16* arow = F.h2 + (size_t)(r0 + ri) * D + 256 * wave + 4 * kh;
          const float* wp = F.Wr + (size_t)(256 * wave + 4 * kh) * 32 + ri;
#pragma unroll 8
          for (int jj = 0; jj < 32; ++jj) {
              const v2u aw = *(const v2u*)(arow + 8 * jj); const f32x4 a = {bf_lo(aw.x), bf_hi(aw.x), bf_lo(aw.y), bf_hi(aw.y)};
              const float b0 = wp[(8 * jj) * 32], b1 = wp[(8 * jj + 1) * 32], b2 = wp[(8 * jj + 2) * 32], b3 = wp[(8 * jj + 3) * 32];
              acc = __builtin_amdgcn_mfma_f32_32x32x2f32(a.x, b0, acc, 0, 0, 0);
              acc = __builtin_amdgcn_mfma_f32_32x32x2f32(a.y, b1, acc, 0, 0, 0);
              acc = __builtin_amdgcn_mfma_f32_32x32x2f32(a.z, b2, acc, 0, 0, 0);
              acc = __builtin_amdgcn_mfma_f32_32x32x2f32(a.w, b3, acc, 0, 0, 0);
          }
#pragma unroll
          for (int i = 0; i < 16; ++i) part[wave * 1024 + crow16(i, kh) * 32 + ri] = acc[i];
        }
        if (F.tid < 32) hist[F.tid] = 0;
        LDS_WAIT(); __syncthreads();
        for (int idx = F.tid; idx < 1024; idx += 512) { float s = 0.f;
#pragma unroll
            for (int w = 0; w < 8; ++w) s += part[w * 1024 + idx];
            lg[(idx >> 5) * 33 + (idx & 31)] = s * rs[idx >> 5] + F.router_b[idx & 31]; }
        LDS_WAIT(); __syncthreads();
        if (F.tid < 32) {
            const int i = F.tid; float tv[4]; int te[4];
#pragma unroll
            for (int k = 0; k < 4; ++k) { float best = -3.0e38f; int be = 0;
                for (int e = 0; e < 32; ++e) { const float x = lg[i * 33 + e]; if (x > best) { best = x; be = e; } }
                tv[k] = best; te[k] = be; lg[i * 33 + be] = -3.4e38f; }
            const float e1 = __expf(tv[1] - tv[0]), e2 = __expf(tv[2] - tv[0]), e3 = __expf(tv[3] - tv[0]);
            const float inv = 1.f / (1.f + e1 + e2 + e3);
            *(f32x4*)(F.tkg + (size_t)(r0 + i) * 4) = (f32x4){inv, e1 * inv, e2 * inv, e3 * inv};
            int* tk = F.tke + (size_t)(r0 + i) * 4; tk[0] = te[0]; tk[1] = te[1]; tk[2] = te[2]; tk[3] = te[3];
#pragma unroll
            for (int k = 0; k < 4; ++k) __hip_atomic_fetch_add(hist + te[k], 1, __ATOMIC_RELAXED, __HIP_MEMORY_SCOPE_WORKGROUP);
        }
        LDS_WAIT(); __syncthreads();
        if (F.tid < 32) F.cnt[blk * 32 + F.tid] = hist[F.tid];
        __syncthreads();
    }
}
DI void p8_route(Frame& F) {
    LAS int* tot = (LAS int*)F.lds; LAS int* pre = tot + 32; LAS int* base = tot + 64; LAS int* posl = tot + 128; LAS int* tkl = tot + 256; LAS int* ptot = tot + 512; LAS int* ppre = ptot + 512;
    for (int blk = F.bid; blk < 256; blk += F.nwg) {
        const int r0 = 32 * blk;
        { const int e = F.tid & 31, wq = F.tid >> 5; int t = 0, p = 0;
#pragma unroll
          for (int i = 0; i < 16; ++i) { const int w = wq + 16 * i; const int v = F.cnt[w * 32 + e]; p += (w < blk) ? v : 0; t += v; }
          ptot[wq * 32 + e] = t; ppre[wq * 32 + e] = p; }
        if (F.tid < 128) tkl[F.tid] = F.tke[(size_t)r0 * 4 + F.tid];
        LDS_WAIT(); __syncthreads();
        if (F.tid < 32) { int t = 0, p = 0;
#pragma unroll
            for (int i = 0; i < 16; ++i) { t += ptot[i * 32 + F.tid]; p += ppre[i * 32 + F.tid]; }
            tot[F.tid] = t; pre[F.tid] = p; }
        LDS_WAIT(); __syncthreads();
        if (F.tid < 32) { int accp = 0; for (int e = 0; e < F.tid; ++e) accp += ((tot[e] + 255) >> 8) << 8; base[F.tid] = accp; }
        if (blk == 0 && F.tid == 64) { int nt = 0;
            for (int e = 0; e < 32; ++e) { const int tiles = (tot[e] + 255) >> 8; for (int j = 0; j < tiles; ++j) F.tile[nt + j] = e; nt += tiles; }
            F.tile[255] = nt; }
        LDS_WAIT(); __syncthreads();
        if (F.tid < 128) { const int e = tkl[F.tid]; int q = 0; for (int j = 0; j < F.tid; ++j) q += (tkl[j] == e) ? 1 : 0;
            const int p = base[e] + pre[e] + q; posl[F.tid] = p; F.pos[(size_t)r0 * 4 + F.tid] = p; }
        LDS_WAIT(); __syncthreads();
        if (F.tid < 128) ((int*)F.xs)[posl[F.tid]] = r0 + (F.tid >> 2);
        if (blk == 0 && F.tid < 32) { const int e = F.tid, lo_ = base[e] + tot[e], hi_ = base[e] + (((tot[e] + 255) >> 8) << 8); for (int q = lo_; q < hi_; ++q) ((int*)F.xs)[q] = 0; }
        __syncthreads();
    }
}
DI void p11_final(Frame& F) {
    const int lane = F.lane;
    constexpr int NR = SEQ / (256 * NWAVES);
    static_assert(NR * 256 * NWAVES == SEQ, "rows per wave");
    int ppv[NR][4]; float gkv[NR][4];
#pragma unroll
    for (int i = 0; i < NR; ++i) { const int rr = F.gw + i * F.ngw;
        const v4u pq = *(const v4u*)(F.pos + (size_t)rr * 4); const f32x4 gt = *(const f32x4*)(F.tkg + (size_t)rr * 4);
#pragma unroll
        for (int k = 0; k < 4; ++k) { ppv[i][k] = __builtin_amdgcn_readfirstlane((int)pq[k]); gkv[i][k] = __uint_as_float((unsigned)__builtin_amdgcn_readfirstlane((int)__float_as_uint(gt[k]))); } }
    v2u hraw[2][8]; int oraw[2][4][8]; f32x4 gv[8];
#pragma unroll
    for (int j = 0; j < 8; ++j) gv[j] = ((const f32x4*)F.final_g + lane)[64 * j];
#define P11_FETCH(i, b) do { const int rr_ = F.gw + (i) * F.ngw; const v2u* xr_ = (const v2u*)(F.h2 + (size_t)rr_ * D) + lane; \
        _Pragma("unroll") for (int j = 0; j < 8; ++j) hraw[b][j] = xr_[64 * j]; \
        _Pragma("unroll") for (int k = 0; k < 4; ++k) { const int* orow_ = (const int*)((const unsigned char*)F.obuf + (size_t)ppv[i][k] * D) + lane; \
            _Pragma("unroll") for (int j = 0; j < 8; ++j) oraw[b][k][j] = orow_[64 * j]; } } while (0)
    P11_FETCH(0, 0);
#pragma unroll
    for (int i = 0; i < NR; ++i) {
        const int b = i & 1, rr = F.gw + i * F.ngw;
        if (i + 1 < NR) P11_FETCH(i + 1, (i + 1) & 1);
        f32x4 v[8];
#pragma unroll
        for (int j = 0; j < 8; ++j) { const v2u w = hraw[b][j]; v[j] = (f32x4){bf_lo(w.x), bf_hi(w.x), bf_lo(w.y), bf_hi(w.y)}; }
#pragma unroll
        for (int k = 0; k < 4; ++k) { const float gq = gkv[i][k] * (1.f / O8_SCALE);
#pragma unroll
            for (int j = 0; j < 8; ++j) { const int w = oraw[b][k][j];
                v[j].x += gq * __builtin_amdgcn_cvt_f32_fp8(w, 0); v[j].y += gq * __builtin_amdgcn_cvt_f32_fp8(w, 1); v[j].z += gq * __builtin_amdgcn_cvt_f32_fp8(w, 2); v[j].w += gq * __builtin_amdgcn_cvt_f32_fp8(w, 3); } }
        float s = 0.f;
#pragma unroll
        for (int j = 0; j < 8; ++j) s += (v[j].x * v[j].x + v[j].y * v[j].y) + (v[j].z * v[j].z + v[j].w * v[j].w);
        const float rstd = rsqrtf(wave_sum(s) * (1.f / D) + EPS);
        f32x4* op = (f32x4*)(F.out + (size_t)rr * D) + lane;
#pragma unroll
        for (int j = 0; j < 8; ++j) { const f32x4 g = gv[j]; __builtin_nontemporal_store((f32x4){v[j].x * rstd * g.x, v[j].y * rstd * g.y, v[j].z * rstd * g.z, v[j].w * rstd * g.w}, &op[64 * j]); }
    }
#undef P11_FETCH
}

using pg8::Unit; using pg8::HALF; using pg8::BM;
struct EpiProj {
    static constexpr bool PERM = true, AFTER_DRAIN = false;
    bf16* O;
    DI void operator()(const f32x4 (&acc)[2][2][4][2], const Unit& u, int wr, int wc, int fr, int fq) const {
        const int row0 = u.pm * BM + wr * 64 + fr, col0 = u.pn * BM + wc * 32 + 8 * fq;
#pragma unroll
        for (int ai = 0; ai < 2; ++ai)
#pragma unroll
            for (int m = 0; m < 4; ++m) { bf16* rowp = O + (size_t)(row0 + ai * HALF + m * 16) * NPROJ + col0;
#pragma unroll
                for (int bj = 0; bj < 2; ++bj) { const f32x4 v0 = acc[ai][bj][m][0], v1 = acc[ai][bj][m][1];
                    v4u w; w.x = pk2(v0[0], v0[1]); w.y = pk2(v0[2], v0[3]); w.z = pk2(v1[0], v1[1]); w.w = pk2(v1[2], v1[3]);
                    *(v4u*)(rowp + bj * HALF) = w; } }
    }
};
struct EpiH2 {
    static constexpr bool PERM = true, AFTER_DRAIN = false;
    const float* X; bf16* H;
    DI void operator()(const f32x4 (&acc)[2][2][4][2], const Unit& u, int wr, int wc, int fr, int fq) const {
        const int row0 = u.pm * BM + wr * 64 + fr, col0 = u.pn * BM + wc * 32 + 8 * fq;
#pragma unroll
        for (int ai = 0; ai < 2; ++ai)
#pragma unroll
            for (int m = 0; m < 4; ++m) { const size_t off = (size_t)(row0 + ai * HALF + m * 16) * D + col0;
#pragma unroll
                for (int bj = 0; bj < 2; ++bj) { const f32x4 x0 = *(const f32x4*)(X + off + bj * HALF), x1 = *(const f32x4*)(X + off + bj * HALF + 4);
                    const f32x4 v0 = acc[ai][bj][m][0] + x0, v1 = acc[ai][bj][m][1] + x1;
                    v4u w; w.x = pk2(v0[0], v0[1]); w.y = pk2(v0[2], v0[3]); w.z = pk2(v1[0], v1[1]); w.w = pk2(v1[2], v1[3]);
                    *(v4u*)(H + off + bj * HALF) = w; } }
    }
};
DI float swiglu(float g, float u) {
    g = fminf(g, 7.f); u = fminf(fmaxf(u, -7.f), 7.f);
    return (u + 1.f) * g * __builtin_amdgcn_rcpf(1.f + __expf(-1.702f * g));
}
DI f32x4 swiglu4(f32x4 g, f32x4 u, const float S) {
#pragma unroll
    for (int i = 0; i < 4; ++i) { g[i] = fminf(g[i], 7.f); u[i] = fminf(fmaxf(u[i], -7.f), 7.f); }
    const f32x4 t = g * (-1.702f * 1.4426950408889634f);
    f32x4 d;
#pragma unroll
    for (int i = 0; i < 4; ++i) d[i] = __builtin_amdgcn_exp2f(t[i]);
    d = d + 1.f;
#pragma unroll
    for (int i = 0; i < 4; ++i) d[i] = __builtin_amdgcn_rcpf(d[i]);
    return (u * S + S) * g * d;
}
struct EpiGU {
    static constexpr bool PERM = true, AFTER_DRAIN = false;
    bf16* O; const float* bgate; const float* bup;
    DI void operator()(const f32x4 (&acc)[2][2][4][2], const Unit& u, int wr, int wc, int fr, int fq) const {
        const int e = u.pn >> 4, pnl = u.pn & 15;
        const int row0 = u.pm * BM + wr * 64 + fr, colb = 128 * pnl + wc * 32 + 8 * fq;
        f32x4 bg[2], bu[2];
#pragma unroll
        for (int n = 0; n < 2; ++n) { bg[n] = *(const f32x4*)(bgate + e * D + colb + 4 * n); bu[n] = *(const f32x4*)(bup + e * D + colb + 4 * n); }
#pragma unroll
        for (int ai = 0; ai < 2; ++ai)
#pragma unroll
            for (int m = 0; m < 4; ++m) { bf16* rowp = O + (size_t)(row0 + ai * HALF + m * 16) * D + colb;
                const f32x4 g0 = acc[ai][0][m][0] + bg[0], g1 = acc[ai][0][m][1] + bg[1], u0 = acc[ai][1][m][0] + bu[0], u1 = acc[ai][1][m][1] + bu[1];
                v4u w; w.x = pk2(swiglu(g0[0], u0[0]), swiglu(g0[1], u0[1])); w.y = pk2(swiglu(g0[2], u0[2]), swiglu(g0[3], u0[3]));
                w.z = pk2(swiglu(g1[0], u1[0]), swiglu(g1[1], u1[1])); w.w = pk2(swiglu(g1[2], u1[2]), swiglu(g1[3], u1[3]));
                *(v4u*)rowp = w; }
    }
};
struct EpiDown {
    static constexpr bool PERM = true, AFTER_DRAIN = false;
    bf16* O; const float* bias;
    DI void operator()(const f32x4 (&acc)[2][2][4][2], const Unit& u, int wr, int wc, int fr, int fq) const {
        const int e = u.pn >> 3, pnl = u.pn & 7;
        const int row0 = u.pm * BM + wr * 64 + fr, col0 = 256 * pnl + wc * 32 + 8 * fq;
        f32x4 bv[2][2];
#pragma unroll
        for (int bj = 0; bj < 2; ++bj)
#pragma unroll
            for (int n = 0; n < 2; ++n) bv[bj][n] = *(const f32x4*)(bias + e * D + col0 + bj * HALF + 4 * n);
#pragma unroll
        for (int ai = 0; ai < 2; ++ai)
#pragma unroll
            for (int m = 0; m < 4; ++m) { bf16* rowp = O + (size_t)(row0 + ai * HALF + m * 16) * D + col0;
#pragma unroll
                for (int bj = 0; bj < 2; ++bj) { const f32x4 v0 = acc[ai][bj][m][0] + bv[bj][0], v1 = acc[ai][bj][m][1] + bv[bj][1];
                    v4u w; w.x = pk2(v0[0], v0[1]); w.y = pk2(v0[2], v0[3]); w.z = pk2(v1[0], v1[1]); w.w = pk2(v1[2], v1[3]);
                    *(v4u*)(rowp + bj * HALF) = w; } }
    }
};
struct EpiGU8 {
    static constexpr bool PERM = true, AFTER_DRAIN = false;
    unsigned char* O; const float* bgate; const float* bup;
    DI void operator()(const f32x4 (&acc)[2][2][4][2], const Unit& u, int wr, int wc, int fr, int fq) const {
        const int e = u.pn >> 4, pnl = u.pn & 15;
        const int row0 = u.pm * BM + wr * 64 + fr, colb = 128 * pnl + wc * 32 + 8 * fq;
        constexpr float DQ = 1.f / (W8_SCALE * X8_SCALE);
        f32x4 bg[2], bu[2];
#pragma unroll
        for (int n = 0; n < 2; ++n) { bg[n] = *(const f32x4*)(bgate + e * D + colb + 4 * n); bu[n] = *(const f32x4*)(bup + e * D + colb + 4 * n); }
#pragma unroll
        for (int ai = 0; ai < 2; ++ai)
#pragma unroll
            for (int m = 0; m < 4; ++m) { unsigned char* rowp = O + (size_t)(row0 + ai * HALF + m * 16) * D + colb;
                const f32x4 g0 = acc[ai][0][m][0] * DQ + bg[0], g1 = acc[ai][0][m][1] * DQ + bg[1], u0 = acc[ai][1][m][0] * DQ + bu[0], u1 = acc[ai][1][m][1] * DQ + bu[1];
                const f32x4 a0 = swiglu4(g0, u0, A8_SCALE), a1 = swiglu4(g1, u1, A8_SCALE);
                v2u w; w.x = pk4_f8(a0[0], a0[1], a0[2], a0[3]); w.y = pk4_f8(a1[0], a1[1], a1[2], a1[3]);
                *(v2u*)rowp = w; }
    }
};
struct EpiDown8 {
    static constexpr bool PERM = true, AFTER_DRAIN = false;
    unsigned char* O; const float* bias;
    DI void operator()(const f32x4 (&acc)[2][2][4][2], const Unit& u, int wr, int wc, int fr, int fq) const {
        const int e = u.pn >> 3, pnl = u.pn & 7;
        const int row0 = u.pm * BM + wr * 64 + fr, col0 = 256 * pnl + wc * 32 + 8 * fq;
        constexpr float DQ = O8_SCALE / (W8_SCALE * A8_SCALE);
        f32x4 bv[2][2];
#pragma unroll
        for (int bj = 0; bj < 2; ++bj)
#pragma unroll
            for (int n = 0; n < 2; ++n) bv[bj][n] = *(const f32x4*)(bias + e * D + col0 + bj * HALF + 4 * n) * O8_SCALE;
#pragma unroll
        for (int ai = 0; ai < 2; ++ai)
#pragma unroll
            for (int m = 0; m < 4; ++m) { unsigned char* rowp = O + (size_t)(row0 + ai * HALF + m * 16) * D + col0;
#pragma unroll
                for (int bj = 0; bj < 2; ++bj) { const f32x4 v0 = acc[ai][bj][m][0] * DQ + bv[bj][0], v1 = acc[ai][bj][m][1] * DQ + bv[bj][1];
                    v2u w; w.x = pk4_f8(v0[0], v0[1], v0[2], v0[3]); w.y = pk4_f8(v1[0], v1[1], v1[2], v1[3]);
                    *(v2u*)(rowp + bj * HALF) = w; } }
    }
};
struct MoeOrder {
    const LAS int* tile_e; const int* rowtok = nullptr;
    int nM, nN, nwg, G, c;
    DI void init(const LAS int* te, int ntiles, int nN_, int G_, int c_) { tile_e = te; nM = ntiles; nN = nN_; nwg = nM * nN; G = G_; c = c_; }
    DI bool next(int i, Unit& u) const {
        const int L = i * G + c; if (L >= nwg) return false;
        int wgid = L; { const int q = nwg / pg8::NXCD, r = nwg % pg8::NXCD, xcd = wgid % pg8::NXCD, off = wgid / pg8::NXCD; wgid = (xcd < r ? xcd * (q + 1) : r * (q + 1) + (xcd - r) * q) + off; }
        const int nig = pg8::WGM * nN, gid = wgid / nig, fm = gid * pg8::WGM, gsz = (nM - fm) < pg8::WGM ? (nM - fm) : pg8::WGM;
        u.pm = fm + ((wgid % nig) % gsz); const int pnl = (wgid % nig) / gsz;
        u.pn = __builtin_amdgcn_readfirstlane(tile_e[u.pm]) * nN + pnl; return true;
    }
    DI void a_ready(const Unit&) const {}
    DI void done(const Unit&) const {}
};


#if MOE_RB
#define MFMA16(a, b, c) __builtin_amdgcn_mfma_f32_16x16x32_bf16((a), (b), (c), 0, 0, 0)
template <class Epi, class Sched>
DI void gemm_rb(LAS unsigned char* lds, const bf16* A, const Sched& S, const Epi& E) {
    constexpr int K = D, NT = K / 64;
    const int tid = threadIdx.x, wave = __builtin_amdgcn_readfirstlane(tid >> 6), lane = tid & 63, fr = lane & 15, fq = lane >> 4;
    unsigned voffA[2];
#pragma unroll
    for (int i = 0; i < 2; ++i) { int R, C; pg8::stage_rc(tid * 16 + i * 8192, R, C); voffA[i] = (unsigned)(R * K + C) * 2u; }
    const unsigned ldsw = (unsigned)wave * 1024u;
    const int aoff = pg8::lds_byte(fr, fq * 8);
    const unsigned boff = (unsigned)((8 * fq) * K + fr) * 4u;
    Unit u;
    for (int ui = 0; S.next(ui, u); ++ui) {
        const char* cA = (const char*)A + (size_t)u.pm * 256 * K * 2;
        const float *b0, *b1; E.bsrc(u, wave, b0, b1);
        const char* pb0 = (const char*)b0 + boff; const char* pb1 = (const char*)b1 + boff;
        f32x4 acc[16][2];
#pragma unroll
        for (int m = 0; m < 16; ++m) { acc[m][0] = (f32x4){0.f, 0.f, 0.f, 0.f}; acc[m][1] = (f32x4){0.f, 0.f, 0.f, 0.f}; }
        float rb[4][16];
#define RB_DMA(t) do { const int tt_ = (t) < NT ? (t) : NT - 1; const unsigned bo_ = (unsigned)(((t) % 3) * 32768); \
        _Pragma("unroll") for (int h_ = 0; h_ < 2; ++h_) _Pragma("unroll") for (int i_ = 0; i_ < 2; ++i_) \
            __builtin_amdgcn_global_load_lds((const unsigned*)(cA + (size_t)h_ * 128 * K * 2 + (size_t)tt_ * 128 + voffA[i_]), (LAS unsigned*)(lds + bo_ + h_ * 16384 + ldsw + i_ * 8192), 16, 0, 0); } while (0)
#define RB_ISSUE(slot, hs) do { const int he_ = (hs) < 2 * NT ? (hs) : 2 * NT - 1; const char* s0_ = pb0 + (size_t)he_ * 32 * K * 4; const char* s1_ = pb1 + (size_t)he_ * 32 * K * 4; \
        _Pragma("unroll") for (int j_ = 0; j_ < 8; ++j_) { \
            asm volatile("global_load_dword %0, %1, off" : "=v"(rb[slot][j_]) : "v"(s0_ + (size_t)j_ * K * 4) : "memory"); \
            asm volatile("global_load_dword %0, %1, off" : "=v"(rb[slot][8 + j_]) : "v"(s1_ + (size_t)j_ * K * 4) : "memory"); } } while (0)
#define RB_WAITB(slot) asm volatile("s_waitcnt vmcnt(52)" : "+v"(rb[slot][0]), "+v"(rb[slot][1]), "+v"(rb[slot][2]), "+v"(rb[slot][3]), "+v"(rb[slot][4]), "+v"(rb[slot][5]), "+v"(rb[slot][6]), "+v"(rb[slot][7]), \
        "+v"(rb[slot][8]), "+v"(rb[slot][9]), "+v"(rb[slot][10]), "+v"(rb[slot][11]), "+v"(rb[slot][12]), "+v"(rb[slot][13]), "+v"(rb[slot][14]), "+v"(rb[slot][15]) :: "memory")
#define RB_COMPUTE(bufo, ks, slot) do { v4u p0_, p1_; \
        p0_.x = pk2(rb[slot][0], rb[slot][1]); p0_.y = pk2(rb[slot][2], rb[slot][3]); p0_.z = pk2(rb[slot][4], rb[slot][5]); p0_.w = pk2(rb[slot][6], rb[slot][7]); \
        p1_.x = pk2(rb[slot][8], rb[slot][9]); p1_.y = pk2(rb[slot][10], rb[slot][11]); p1_.z = pk2(rb[slot][12], rb[slot][13]); p1_.w = pk2(rb[slot][14], rb[slot][15]); \
        const bf16x8 bf0_ = __builtin_bit_cast(bf16x8, p0_), bf1_ = __builtin_bit_cast(bf16x8, p1_); \
        _Pragma("unroll") for (int mg_ = 0; mg_ < 4; ++mg_) { bf16x8 a_[4]; \
            _Pragma("unroll") for (int q_ = 0; q_ < 4; ++q_) { const int m_ = 4 * mg_ + q_; a_[q_] = *(const LAS bf16x8*)(lds + (bufo) + (m_ >> 3) * 16384 + (m_ & 7) * 2048 + (ks) * 1024 + aoff); } \
            _Pragma("unroll") for (int q_ = 0; q_ < 4; ++q_) { const int m_ = 4 * mg_ + q_; acc[m_][0] = MFMA16(bf0_, a_[q_], acc[m_][0]); acc[m_][1] = MFMA16(bf1_, a_[q_], acc[m_][1]); } \
            __builtin_amdgcn_sched_barrier(0); } } while (0)
        RB_DMA(0); RB_DMA(1);
        RB_ISSUE(0, 0); RB_ISSUE(1, 1); RB_ISSUE(2, 2);
        int bi = 0;
#pragma unroll 1
        for (int t = 0; t < NT; t += 2) {
            const int bo0 = bi * 32768, bi1 = (bi == 2) ? 0 : bi + 1, bo1 = bi1 * 32768;
            asm volatile("s_waitcnt vmcnt(36)" ::: "memory"); __builtin_amdgcn_s_barrier(); asm volatile("" ::: "memory");
            RB_DMA(t + 2);
            RB_ISSUE(3, 2 * t + 3); RB_WAITB(0); RB_COMPUTE(bo0, 0, 0);
            RB_ISSUE(0, 2 * t + 4); RB_WAITB(1); RB_COMPUTE(bo0, 1, 1);
            asm volatile("s_waitcnt vmcnt(36)" ::: "memory"); __builtin_amdgcn_s_barrier(); asm volatile("" ::: "memory");
            RB_DMA(t + 3);
            RB_ISSUE(1, 2 * t + 5); RB_WAITB(2); RB_COMPUTE(bo1, 0, 2);
            RB_ISSUE(2, 2 * t + 6); RB_WAITB(3); RB_COMPUTE(bo1, 1, 3);
            bi = (bi1 == 2) ? 0 : bi1 + 1;
        }
#define RB_KEEP(slot, str) asm volatile(str : "+v"(rb[slot][0]), "+v"(rb[slot][1]), "+v"(rb[slot][2]), "+v"(rb[slot][3]), "+v"(rb[slot][4]), "+v"(rb[slot][5]), "+v"(rb[slot][6]), "+v"(rb[slot][7]), \
        "+v"(rb[slot][8]), "+v"(rb[slot][9]), "+v"(rb[slot][10]), "+v"(rb[slot][11]), "+v"(rb[slot][12]), "+v"(rb[slot][13]), "+v"(rb[slot][14]), "+v"(rb[slot][15]) :: "memory")
        RB_KEEP(0, "s_waitcnt vmcnt(0)"); RB_KEEP(1, ""); RB_KEEP(2, ""); RB_KEEP(3, "");
#undef RB_KEEP
        E(acc, u, wave, fr, fq);
        asm volatile("s_waitcnt vmcnt(0)" ::: "memory"); __builtin_amdgcn_s_barrier(); asm volatile("" ::: "memory");
#undef RB_DMA
#undef RB_ISSUE
#undef RB_WAITB
#undef RB_COMPUTE
    }
}
struct EpiGU2 {
    bf16* O; const float *wg, *wu, *bgate, *bup;
    DI void bsrc(const Unit& u, int wave, const float*& b0, const float*& b1) const {
        const int e = u.pn >> 4, pnl = u.pn & 15; const size_t o = (size_t)e * D * D + 128 * pnl + 16 * wave; b0 = wg + o; b1 = wu + o; }
    DI void operator()(const f32x4 (&acc)[16][2], const Unit& u, int wave, int fr, int fq) const {
        const int e = u.pn >> 4, pnl = u.pn & 15, col = 128 * pnl + 16 * wave + 4 * fq;
        const f32x4 bg = *(const f32x4*)(bgate + e * D + col), bu = *(const f32x4*)(bup + e * D + col);
        bf16* op = O + (size_t)(u.pm * 256 + fr) * D + col;
#pragma unroll
        for (int m = 0; m < 16; ++m) { const f32x4 g = acc[m][0] + bg, uu = acc[m][1] + bu; v2u w;
            w.x = pk2(swiglu(g[0], uu[0]), swiglu(g[1], uu[1])); w.y = pk2(swiglu(g[2], uu[2]), swiglu(g[3], uu[3]));
            *(v2u*)(op + (size_t)(16 * m) * D) = w; }
    }
};
struct EpiDown2 {
    bf16* O; const float *wd, *bias;
    DI void bsrc(const Unit& u, int wave, const float*& b0, const float*& b1) const {
        const int e = u.pn >> 3, pnl = u.pn & 7; b0 = wd + (size_t)e * D * D + 256 * pnl + 32 * wave; b1 = b0 + 16; }
    DI void operator()(const f32x4 (&acc)[16][2], const Unit& u, int wave, int fr, int fq) const {
        const int e = u.pn >> 3, pnl = u.pn & 7, col = 256 * pnl + 32 * wave + 4 * fq;
        const f32x4 v0 = *(const f32x4*)(bias + e * D + col), v1 = *(const f32x4*)(bias + e * D + col + 16);
        bf16* op = O + (size_t)(u.pm * 256 + fr) * D + col;
#pragma unroll
        for (int m = 0; m < 16; ++m) { const f32x4 a = acc[m][0] + v0, b = acc[m][1] + v1; v2u w0, w1;
            w0.x = pk2(a[0], a[1]); w0.y = pk2(a[2], a[3]); w1.x = pk2(b[0], b[1]); w1.y = pk2(b[2], b[3]);
            *(v2u*)(op + (size_t)(16 * m) * D) = w0; *(v2u*)(op + (size_t)(16 * m) * D + 16) = w1; }
    }
};

#endif
struct Args { const float* in[23]; float* out; unsigned char* ws; int ph_lo, ph_hi; };
DI void fill_frame(Frame& F, const Args& args, LAS unsigned char* lds, const int bid, const int nwg) {
    F.lds = lds;
    int tz = threadIdx.x; asm volatile("" : "+v"(tz)); F.tid = tz;
    F.lane = F.tid & 63; F.wave = __builtin_amdgcn_readfirstlane(F.tid >> 6);
    F.bid = bid; F.nwg = nwg; F.gw = bid * NWAVES + F.wave; F.ngw = nwg * NWAVES;
    unsigned char* ws = args.ws;
    F.x = args.in[0]; F.meta = args.in[1]; F.g1 = args.in[2]; F.w_in = args.in[3]; F.pool_w = args.in[4]; F.pool_scale = args.in[5]; F.conv_w = args.in[6]; F.conv_b = args.in[7];
    F.dt_bias = args.in[8]; F.a_log = args.in[9]; F.d_skip = args.in[10]; F.ssm_g = args.in[11]; F.w_out = args.in[12]; F.g2 = args.in[13]; F.router_w = args.in[14]; F.router_b = args.in[15];
    F.w_gate = args.in[16]; F.b_gate = args.in[17]; F.w_up = args.in[18]; F.b_up = args.in[19]; F.w_down = args.in[20]; F.b_down = args.in[21]; F.final_g = args.in[22];
    F.out = args.out;
    F.hn = (bf16*)(ws + WS_HN); F.Bt1 = (bf16*)(ws + WS_BT1); F.Bt2 = (bf16*)(ws + WS_BT2); F.proj = (bf16*)(ws + WS_PROJ); F.xT = (bf16*)(ws + WS_XT); F.BT = (bf16*)(ws + WS_BTT);
    F.Bc = (bf16*)(ws + WS_BC); F.Cc = (bf16*)(ws + WS_CC); F.prev = (bf16*)(ws + WS_PREV); F.ycat = (bf16*)(ws + WS_YCAT); F.hn2 = (bf16*)(ws + WS_HN2); F.xs = (bf16*)(ws + WS_XS);
    F.abuf = (bf16*)(ws + WS_A); F.obuf = (bf16*)(ws + (MOE_F8 ? WS_O : WS_XS)); F.Btgu = (bf16*)(ws + WS_BTGU); F.Btd = (bf16*)(ws + WS_BTD);
    F.dtv = (float*)(ws + WS_DT); F.states = (bf16*)(ws + WS_ST); F.decay = (float*)(ws + WS_DEC); F.h2 = (bf16*)(ws + WS_H2); F.Wr = (float*)(ws + WS_WR); F.tkg = (float*)(ws + WS_TKG);
    F.tke = (int*)(ws + WS_TKE); F.pos = (int*)(ws + WS_POS); F.cnt = (int*)(ws + WS_CNT); F.tile = (int*)(ws + WS_TILE);

}
__global__ void __launch_bounds__(NWAVES * 64, 2) fwd(Args args) {
    extern __shared__ __attribute__((aligned(16))) unsigned char lds_raw[];
    LAS unsigned char* const lds_base = (LAS unsigned char*)lds_raw; unsigned char* ws = args.ws;
    volatile LAS unsigned* MISC = (volatile LAS unsigned*)(lds_base + MISC_OFF);
    if (threadIdx.x < 32) MISC[threadIdx.x] = 0u;
    __syncthreads();
    const int G = (int)gridDim.x, bx = (int)blockIdx.x;
    const bool worker = bx < WN;
    XcdBarrier barA = xcd_barrier_post((unsigned*)(ws + WS_CTL) + CW_BAR, MISC + 8, (unsigned)G);
    XcdBarrier barW; barW.bar = (unsigned*)(ws + WS_CTL) + CW_BAR2; barW.x = 0; barW.st = MISC + 12; barW.G = (unsigned)WN;
    if (worker) barW = xcd_barrier_post((unsigned*)(ws + WS_CTL) + CW_BAR2, MISC + 12, (unsigned)WN);

    { Frame F; fill_frame(F, args, lds_base, bx, G); p0_norm(F); p0_weff(F); p0_router_fold(F); p0_weights_range<false>(F, I_MOE, NITEMS); __syncthreads(); }
    xcd_barrier(barA);
    if (!worker) {
        Frame F; fill_frame(F, args, lds_base, bx - WN, G - WN); p0_weights_range<true>(F, 0, I_MOE); __syncthreads();
    } else {
        { Frame F; fill_frame(F, args, lds_base, bx, WN); pg8::Gemm g{F.hn, F.Bt1, MP, NPROJ, D}; pg8::StaticOrder S; S.init(MP, NPROJ, WN, bx);
          EpiProj E{F.proj}; pg8::gemm_phase<EpiProj, pg8::StaticOrder, true, true>(F.lds, g, S, E); }
        xcd_barrier(barW);
        { Frame F; fill_frame(F, args, lds_base, bx, WN); p2_elem(F); }
        xcd_barrier(barW);
        { Frame F; fill_frame(F, args, lds_base, bx, WN); p3_states(F); }
        xcd_barrier(barW);
        { Frame F; fill_frame(F, args, lds_base, bx, WN); p4_scan(F); }
        xcd_barrier(barW);
        { Frame F; fill_frame(F, args, lds_base, bx, WN); p5_out(F); }
        xcd_barrier(barW);
        { Frame F; fill_frame(F, args, lds_base, bx, WN); pg8::Gemm g{F.ycat, F.Bt2, SEQ, D, D}; pg8::StaticOrder S; S.init(SEQ, D, WN, bx);
          EpiH2 E{F.x, F.h2}; pg8::gemm_phase<EpiH2, pg8::StaticOrder, true, true>(F.lds, g, S, E); }
        xcd_barrier(barW);
        { Frame F; fill_frame(F, args, lds_base, bx, WN); p7_router(F); }
        xcd_barrier(barW);
        { Frame F; fill_frame(F, args, lds_base, bx, WN); p8_route(F); }
    }
    xcd_barrier(barA);
    { Frame F; fill_frame(F, args, lds_base, bx, G); LAS int* tl = (LAS int*)(lds_base + MISC_OFF + 1024);
      if (F.tid < 256) tl[F.tid] = F.tile[F.tid];
      LDS_WAIT(); __syncthreads();
      const int ntiles = __builtin_amdgcn_readfirstlane(tl[255]);
      MoeOrder S; S.init(tl, ntiles, 16, G, bx); S.rowtok = (const int*)F.xs;
      pg8::Gemm g{F.hn2, F.Btgu, SEQ, NE * 4096, D}; EpiGU8 E{(unsigned char*)F.abuf, F.b_gate, F.b_up}; pg8::gemm_phase<EpiGU8, MoeOrder, true, true, true, true>(F.lds, g, S, E); }
    xcd_barrier(barA);
    { Frame F; fill_frame(F, args, lds_base, bx, G); LAS int* tl = (LAS int*)(lds_base + MISC_OFF + 1024);
      if (F.tid < 256) tl[F.tid] = F.tile[F.tid];
      LDS_WAIT(); __syncthreads();
      const int ntiles = __builtin_amdgcn_readfirstlane(tl[255]);
      MoeOrder S; S.init(tl, ntiles, 8, G, bx);
      pg8::Gemm g{F.abuf, F.Btd, RPAD, NE * D, D}; EpiDown8 E{(unsigned char*)F.obuf, F.b_down}; pg8::gemm_phase<EpiDown8, MoeOrder, true, true, true>(F.lds, g, S, E); }
    xcd_barrier(barA);
    { Frame F; fill_frame(F, args, lds_base, bx, G); p11_final(F); }
}

extern "C" void kernel_launch(void* const* d_in, const int* in_sizes, int n_in, void* d_out, int out_size, void* d_ws, size_t ws_size, hipStream_t stream) {
    static int grid = 0;
    if (grid == 0) {
        if (n_in != 23 || out_size != SEQ * D || ws_size < WS_END) { fprintf(stderr, "kernel_launch: unexpected shapes (n_in %d out %d ws %zu need %zu)\n", n_in, out_size, ws_size, (size_t)WS_END); grid = -1; return; }
        int dev = 0, cus = 0, per_cu = 0;
        if (hipGetDevice(&dev) != hipSuccess || hipDeviceGetAttribute(&cus, hipDeviceAttributeMultiprocessorCount, dev) != hipSuccess) { grid = -1; return; }
        if (hipFuncSetAttribute((const void*)fwd, hipFuncAttributeMaxDynamicSharedMemorySize, LDS_BYTES) != hipSuccess) { fprintf(stderr, "kernel_launch: hipFuncSetAttribute failed\n"); grid = -1; return; }
        if (hipOccupancyMaxActiveBlocksPerMultiprocessor(&per_cu, (const void*)fwd, NWAVES * 64, LDS_BYTES) != hipSuccess || per_cu < 1) fprintf(stderr, "kernel_launch: occupancy query says %d\n", per_cu);
        (void)hipGetLastError();
        grid = 256;
        if (cus < 256) { fprintf(stderr, "kernel_launch: needs 256 CUs, device has %d\n", cus); grid = -1; return; }
    }
    if (grid < 0) return;
    Args a{};
    for (int i = 0; i < 23; ++i) a.in[i] = (const float*)d_in[i];
    a.out = (float*)d_out; a.ws = (unsigned char*)d_ws;
    (void)hipMemsetAsync((char*)d_ws + WS_CTL, 0, CTL_BYTES, stream);
    a.ph_lo = 0; a.ph_hi = NPH;
    hipLaunchKernelGGL(fwd, dim3(grid), dim3(NWAVES * 64), LDS_BYTES, stream, a);
}
```
